# Optimizing an MI355X kernel written in HIP

```python
import math
import jax, jax.numpy as jnp
from jax import lax
import numpy as np

D_MODEL = 1024
BATCH = 8
SEQ = 8192
DEPTH = 1

CONV_WIDTH = D_MODEL // 2
CONV_K = 3
N_HEADS = 8
HEAD_DIM = 64
ATTN_WIDTH = N_HEADS * HEAD_DIM
MOBA_BLOCK = 256
MOBA_TOPK = 3
QUERY_CHUNK = 32
N_BUCKETS = 32
MAX_DISTANCE = 1024
D_FF = 4 * D_MODEL
RMS_EPS = 1e-6
N_IN = 3 * CONV_WIDTH + 3 * ATTN_WIDTH + 2 * D_MODEL
NEG = -1e30

kernel_name = "hybrid_shortconv_moba_sqrelu_block"


def rms_norm(x, g):
    x32 = x.astype(jnp.float32)
    y = x32 * lax.rsqrt(jnp.mean(jnp.square(x32), axis=-1, keepdims=True) + RMS_EPS)
    return (y * g.astype(jnp.float32)).astype(x.dtype)


def t5_causal_bucket(rel):
    n = jnp.maximum(rel, 0)
    max_exact = N_BUCKETS // 2
    nf = jnp.maximum(n, max_exact).astype(jnp.float32)
    large = max_exact + (jnp.log(nf / max_exact) / math.log(MAX_DISTANCE / max_exact)
                         * (N_BUCKETS - max_exact)).astype(jnp.int32)
    large = jnp.minimum(large, N_BUCKETS - 1)
    return jnp.where(n < max_exact, n, large)


def short_conv(u, w):
    return lax.conv_general_dilated(
        u, w[:, None, :], window_strides=(1,), padding=[(CONV_K - 1, 0)],
        dimension_numbers=("NWC", "WIO", "NWC"), feature_group_count=u.shape[-1])


def moba_attention(q, k, v, rel_bias):
    b, s, h, d = q.shape
    n_blocks = max(-(-s // MOBA_BLOCK), MOBA_TOPK)
    s_pad = n_blocks * MOBA_BLOCK
    q = q.transpose(0, 2, 1, 3)
    pad = ((0, 0), (0, 0), (0, s_pad - s), (0, 0))
    k = jnp.pad(k.transpose(0, 2, 1, 3), pad)
    v = jnp.pad(v.transpose(0, 2, 1, 3), pad)
    k_blocks = k.reshape(b, h, n_blocks, MOBA_BLOCK, d)
    v_blocks = v.reshape(b, h, n_blocks, MOBA_BLOCK, d)
    k_mean = jnp.mean(k_blocks, axis=3)
    scale = HEAD_DIM ** -0.5
    bi = jnp.arange(b)[:, None, None, None]
    hi = jnp.arange(h)[None, :, None, None]
    blk_ids = jnp.arange(n_blocks)
    offs = jnp.arange(MOBA_BLOCK)
    n_sel = MOBA_TOPK * MOBA_BLOCK

    def chunk(c):
        start = c * QUERY_CHUNK
        blk = start // MOBA_BLOCK
        qc = lax.dynamic_slice_in_dim(q, start, QUERY_CHUNK, axis=2)
        qpos = start + jnp.arange(QUERY_CHUNK)
        gate = jnp.einsum('bhqd,bhnd->bhqn', qc, k_mean).astype(jnp.float32)
        gate = jnp.where(blk_ids < blk, gate, NEG)
        _, sel = lax.top_k(gate, MOBA_TOPK)
        sel_valid = sel < blk
        kg = k_blocks[bi, hi, sel]
        vg = v_blocks[bi, hi, sel]
        kpos = sel[..., None] * MOBA_BLOCK + offs
        rel = qpos[None, None, :, None, None] - kpos
        bias_past = rel_bias[hi[..., None], t5_causal_bucket(rel)]
        s_past = jnp.einsum('bhqd,bhqjkd->bhqjk', qc, kg).astype(jnp.float32) * scale + bias_past
        s_past = jnp.where(sel_valid[..., None], s_past, NEG).reshape(b, h, QUERY_CHUNK, n_sel)
        kb = lax.dynamic_slice_in_dim(k, blk * MOBA_BLOCK, MOBA_BLOCK, axis=2)
        vb = lax.dynamic_slice_in_dim(v, blk * MOBA_BLOCK, MOBA_BLOCK, axis=2)
        rel_own = qpos[:, None] - (blk * MOBA_BLOCK + offs)[None, :]
        bias_own = rel_bias[:, t5_causal_bucket(rel_own)]
        s_own = jnp.einsum('bhqd,bhkd->bhqk', qc, kb).astype(jnp.float32) * scale + bias_own
        s_own = jnp.where(rel_own >= 0, s_own, NEG)
        p = jax.nn.softmax(jnp.concatenate([s_past, s_own], axis=-1), axis=-1).astype(v.dtype)
        p_past = p[..., :n_sel].reshape(b, h, QUERY_CHUNK, MOBA_TOPK, MOBA_BLOCK)
        p_own = p[..., n_sel:]
        return (jnp.einsum('bhqjk,bhqjkd->bhqd', p_past, vg)
                + jnp.einsum('bhqk,bhkd->bhqd', p_own, vb))

    outs = lax.map(chunk, jnp.arange(s // QUERY_CHUNK))
    return outs.transpose(1, 0, 3, 2, 4).reshape(b, s, h * d)


def setup_inputs(seed: int = 0) -> dict:
    key = jax.random.key(seed)
    ks = jax.random.split(key, 14)
    nrm = jax.random.normal
    f32 = jnp.float32

    def gain(k):
        return 1.0 + 0.02 * nrm(k, (DEPTH, D_MODEL), f32)

    return {
        "x": nrm(ks[0], (BATCH, SEQ, D_MODEL), f32),
        "ln_mix_pre": gain(ks[1]),
        "w_in": nrm(ks[2], (DEPTH, D_MODEL, N_IN), f32) * D_MODEL ** -0.5,
        "conv_w": nrm(ks[3], (DEPTH, CONV_K, CONV_WIDTH), f32) * CONV_K ** -0.5,
        "w_conv_out": nrm(ks[4], (DEPTH, CONV_WIDTH, D_MODEL), f32) * CONV_WIDTH ** -0.5,
        "w_attn_out": nrm(ks[5], (DEPTH, ATTN_WIDTH, D_MODEL), f32) * ATTN_WIDTH ** -0.5,
        "rel_bias": 0.2 * nrm(ks[6], (N_HEADS, N_BUCKETS), f32),
        "w_o": nrm(ks[7], (DEPTH, D_MODEL, D_MODEL), f32) * D_MODEL ** -0.5,
        "ln_mix_post": gain(ks[8]),
        "ln_mlp_pre": gain(ks[9]),
        "w_mlp_in": nrm(ks[10], (DEPTH, D_MODEL, D_FF), f32) * D_MODEL ** -0.5,
        "w_mlp_out": nrm(ks[11], (DEPTH, D_FF, D_MODEL), f32) * D_FF ** -0.5,
        "ln_mlp_post": gain(ks[12]),
    }


def reference(x, ln_mix_pre, w_in, conv_w, w_conv_out, w_attn_out, rel_bias, w_o,
              ln_mix_post, ln_mlp_pre, w_mlp_in, w_mlp_out, ln_mlp_post):
    b, s, _ = x.shape
    c, a, dm = CONV_WIDTH, ATTN_WIDTH, D_MODEL
    splits = [c, 2 * c, 3 * c, 3 * c + a, 3 * c + 2 * a, 3 * c + 3 * a, 3 * c + 3 * a + dm]
    for l in range(DEPTH):
        h = rms_norm(x, ln_mix_pre[l])
        proj = h @ w_in[l]
        xin, gb, gc, q, k, v, g_conv, g_attn = jnp.split(proj, splits, axis=-1)
        y_c = (gb * short_conv(gc * xin, conv_w[l])) @ w_conv_out[l]
        att = moba_attention(q.reshape(b, s, N_HEADS, HEAD_DIM),
                             k.reshape(b, s, N_HEADS, HEAD_DIM),
                             v.reshape(b, s, N_HEADS, HEAD_DIM), rel_bias)
        y_a = att @ w_attn_out[l]
        m = jax.nn.sigmoid(g_conv) * y_c + jax.nn.sigmoid(g_attn) * y_a
        x = x + rms_norm(m @ w_o[l], ln_mix_post[l])
        h = rms_norm(x, ln_mlp_pre[l])
        f = jnp.square(jax.nn.relu(h @ w_mlp_in[l])) @ w_mlp_out[l]
        x = x + rms_norm(f, ln_mlp_post[l])
    return x
```

```cpp
#include <hip/hip_runtime.h>
#include <cstdio>
#include <cstdint>
namespace pg8 {
#define PG8_LAS __attribute__((address_space(3)))
typedef unsigned short bf16_t;
typedef short bf16x8 __attribute__((ext_vector_type(8)));
typedef float f32x4 __attribute__((ext_vector_type(4)));
typedef unsigned u32x4 __attribute__((ext_vector_type(4)));
constexpr int BM = 256, BK = 64, HALF = 128, HTB = HALF * BK * 2  , STAGE_BYTES = 8 * HTB, NXCD = 8, WGM = 8;

__host__ __device__ __forceinline__ int lds_byte(int r, int c) { const int st = (r >> 4) * 2 + (c >> 5), rr = r & 15, cc = c & 31, ob = rr * 64 + cc * 2; return st * 1024 + (ob ^ (((ob >> 9) & 1) << 5)); }
__host__ __device__ __forceinline__ void stage_rc(int b, int& R, int& C) { const int st = b / 1024, sb = b % 1024, swz = sb ^ (((sb >> 9) & 1) << 5); R = (st >> 1) * 16 + swz / 64; C = (st & 1) * 32 + (swz % 64) / 2; }
__host__ __device__ __forceinline__ int perm32(int rho) { const int n = rho >> 4, i = rho & 15; return 8 * (i >> 2) + 4 * n + (i & 3); }

struct Unit { int pm, pn; };
struct Gemm { const bf16_t* A; const bf16_t* Bt; int M, N, K; };

struct StaticOrder {
    int nM, nN, nwg, G, c;
    __host__ __device__ void init(int M, int N, int G_, int c_) { nM = M / BM; nN = N / BM; nwg = nM * nN; G = G_; c = c_; }
    __host__ __device__ bool next(int i, Unit& u) const {
        const long L = (long)i * G + c; if (L >= nwg) return false;
        int wgid = (int)L; { const int q = nwg / NXCD, r = nwg % NXCD, xcd = wgid % NXCD, off = wgid / NXCD; wgid = (xcd < r ? xcd * (q + 1) : r * (q + 1) + (xcd - r) * q) + off; }
        const int nig = WGM * nN, gid = wgid / nig, fm = gid * WGM, gsz = (nM - fm) < WGM ? (nM - fm) : WGM;
        u.pm = fm + ((wgid % nig) % gsz); u.pn = (wgid % nig) / gsz; return true;
    }
    __device__ __forceinline__ void a_ready(const Unit&) const {}
    __device__ __forceinline__ void done(const Unit&) const {}
};

__device__ __forceinline__ unsigned cvt_pk_bf16(float lo, float hi) { unsigned r; asm volatile("v_cvt_pk_bf16_f32 %0, %1, %2" : "=v"(r) : "v"(lo), "v"(hi)); return r; }
typedef float f32x2 __attribute__((ext_vector_type(2)));
__device__ __forceinline__ float bf_lo(unsigned w) { return __uint_as_float(w << 16); }
__device__ __forceinline__ float bf_hi(unsigned w) { return __uint_as_float(w & 0xffff0000u); }
constexpr float QSCALE = 0.125f * 1.4426950408889634f;
enum { EM_PROJ = 0, EM_GATE = 1, EM_GATEADD = 2, EM_PLAIN = 3, EM_RELU2 = 4, EM_GATE2 = 5 };
template <int MODE> struct EpiB {
    static constexpr bool PERM = true, AFTER_DRAIN = false, HAS_MID = (MODE == EM_GATE2), ROWS = (MODE == EM_PROJ || MODE == EM_RELU2), PREFETCH = (MODE == EM_GATE2);
    bf16_t* O; int ldc; const bf16_t* G; int ldg; int goff; int goff2 = 0; float* KMp = nullptr; const float* rowscale = nullptr; int otile = 0;
    __device__ __forceinline__ void operator()(f32x4 (&acc)[2][2][4][2], const Unit& u, int wr, int wc, int fr, int fq, const PG8_LAS float* rsl = nullptr) const {
        const int row0 = u.pm * BM + wr * 64 + fr, col0 = u.pn * BM + wc * 32 + 8 * fq;
        float rsq[2][4];
        if (MODE == EM_PROJ) {
#pragma unroll
            for (int ai = 0; ai < 2; ++ai)
#pragma unroll
                for (int m = 0; m < 4; ++m) { const float r_ = rsl[wr * 64 + fr + ai * HALF + m * 16];
#pragma unroll
                    for (int bj = 0; bj < 2; ++bj) { acc[ai][bj][m][0] = acc[ai][bj][m][0] * r_; acc[ai][bj][m][1] = acc[ai][bj][m][1] * r_; } } }
        if (MODE == EM_RELU2) {
#pragma unroll
            for (int ai = 0; ai < 2; ++ai)
#pragma unroll
                for (int m = 0; m < 4; ++m) { const float r_ = rsl[wr * 64 + fr + ai * HALF + m * 16]; rsq[ai][m] = r_ * r_; } }
        u32x4 gpre[2][4][2];
        if (MODE == EM_GATE2) {
#pragma unroll
            for (int ai = 0; ai < 2; ++ai)
#pragma unroll
                for (int m = 0; m < 4; ++m)
#pragma unroll
                    for (int bj = 0; bj < 2; ++bj) gpre[ai][m][bj] = *(const u32x4*)(G + (((((((size_t)u.pm * 8 + (2 * u.pn + bj)) * 2 + 1) * 2 + ai) * 4 + m) * 8 + (wr * 4 + wc)) * 64 + (fq * 16 + fr)) * 8); }
        int pmode = 0; if (MODE == EM_PROJ) { pmode = (u.pn >= 12) ? 2 : ((u.pn == 6 || u.pn == 7) ? 1 : (u.pn < 4 ? 3 : 0)); }
        if (MODE == EM_PROJ) { if (u.pn == 8 || u.pn == 9) {
            float cs[2][2][4];
#pragma unroll
            for (int bj = 0; bj < 2; ++bj)
#pragma unroll
                for (int n = 0; n < 2; ++n)
#pragma unroll
                    for (int e = 0; e < 4; ++e) { float t = 0.f;
#pragma unroll
                        for (int ai = 0; ai < 2; ++ai)
#pragma unroll
                            for (int m = 0; m < 4; ++m) t += acc[ai][bj][m][n][e];
                        t += __shfl_xor(t, 1); t += __shfl_xor(t, 2); t += __shfl_xor(t, 4); t += __shfl_xor(t, 8); cs[bj][n][e] = t; }
            if (fr == 0) { float* kp = KMp + (size_t)u.pm * 512 + (u.pn - 8) * BM + wc * 32 + 8 * fq;
#pragma unroll
                for (int bj = 0; bj < 2; ++bj)
#pragma unroll
                    for (int n = 0; n < 2; ++n)
#pragma unroll
                        for (int e = 0; e < 4; ++e) atomicAdd(kp + bj * HALF + 4 * n + e, cs[bj][n][e]); }
        } }
#pragma unroll
        for (int ai = 0; ai < 2; ++ai)
#pragma unroll
            for (int m = 0; m < 4; ++m) { const size_t row = (size_t)(row0 + ai * HALF + m * 16);
#pragma unroll
                for (int bj = 0; bj < 2; ++bj) { f32x4 v0 = acc[ai][bj][m][0], v1 = acc[ai][bj][m][1]; const int col = col0 + bj * HALF;
                    if (MODE == EM_PROJ) {
                        if (pmode == 3) { if (bj == 1) continue; v0 = v0 * acc[ai][1][m][0]; v1 = v1 * acc[ai][1][m][1]; }
                        if (pmode == 1) { v0 = v0 * QSCALE; v1 = v1 * QSCALE; }
                        else if (pmode == 2) {
                            const f32x4 a0 = acc[ai][1][m][0], a1 = acc[ai][1][m][1];
#pragma unroll
                            for (int e = 0; e < 4; ++e) {
                                const float ea0 = 1.0f + __builtin_amdgcn_exp2f(-1.4426950408889634f * a0[e]), ea1 = 1.0f + __builtin_amdgcn_exp2f(-1.4426950408889634f * a1[e]);
                                if (bj == 0) { v0[e] = ea0 * __builtin_amdgcn_rcpf(1.0f + __builtin_amdgcn_exp2f(-1.4426950408889634f * v0[e])); v1[e] = ea1 * __builtin_amdgcn_rcpf(1.0f + __builtin_amdgcn_exp2f(-1.4426950408889634f * v1[e])); }
                                else { v0[e] = __builtin_amdgcn_rcpf(ea0); v1[e] = __builtin_amdgcn_rcpf(ea1); } }
                        }
                    }
                    if (MODE == EM_RELU2) {
#pragma unroll
                        for (int e = 0; e < 4; ++e) { float a, b; asm("v_max_f32 %0, 0, %1" : "=v"(a) : "v"(v0[e])); asm("v_max_f32 %0, 0, %1" : "=v"(b) : "v"(v1[e])); v0[e] = a * a * rsq[ai][m]; v1[e] = b * b * rsq[ai][m]; }
                    }
                    if (MODE == EM_GATE || MODE == EM_GATEADD || MODE == EM_GATE2) {
                        const u32x4 g = (MODE == EM_GATE2) ? gpre[ai][m][bj] : *(const u32x4*)(G + row * (size_t)ldg + (goff + col));
                        v0[0] *= bf_lo(g.x); v0[1] *= bf_hi(g.x); v0[2] *= bf_lo(g.y); v0[3] *= bf_hi(g.y);
                        v1[0] *= bf_lo(g.z); v1[1] *= bf_hi(g.z); v1[2] *= bf_lo(g.w); v1[3] *= bf_hi(g.w);
                        if (MODE == EM_GATEADD) { const u32x4 o = *(const u32x4*)(O + row * (size_t)ldc + col);
                            v0[0] += bf_lo(o.x); v0[1] += bf_hi(o.x); v0[2] += bf_lo(o.y); v0[3] += bf_hi(o.y);
                            v1[0] += bf_lo(o.z); v1[1] += bf_hi(o.z); v1[2] += bf_lo(o.w); v1[3] += bf_hi(o.w); }
                    }
                    u32x4 w; w.x = cvt_pk_bf16(v0[0], v0[1]); w.y = cvt_pk_bf16(v0[2], v0[3]); w.z = cvt_pk_bf16(v1[0], v1[1]); w.w = cvt_pk_bf16(v1[2], v1[3]);
                    if (MODE == EM_PROJ && pmode == 2) {
                        const size_t vi = ((((((size_t)u.pm * 8 + (u.pn - 12)) * 2 + bj) * 2 + ai) * 4 + m) * 8 + (wr * 4 + wc)) * 64 + (fq * 16 + fr);
                        *(u32x4*)((bf16_t*)G + vi * 8) = w;
                    } else if (otile > 0) {
                        *(u32x4*)(O + ((size_t)u.pm * otile + u.pn) * 65536 + (size_t)(row - (size_t)u.pm * BM) * 256 + (col - u.pn * BM)) = w;
                    } else
                    *(u32x4*)(O + row * (size_t)ldc + ((MODE == EM_PROJ && pmode == 3) ? (HALF * u.pn + wc * 32 + 8 * fq) : col)) = w; }
                if (MODE == EM_GATE || MODE == EM_GATEADD) asm volatile("" ::: "memory"); }
    }
    __device__ __forceinline__ void prefetch(const Unit& u, int s_, PG8_LAS unsigned char* dump, int wid, int lane) const {
        { s_ &= 31;
          const int kind = s_ >> 4, ai = (s_ >> 3) & 1, m = (s_ >> 1) & 3, bj = s_ & 1;
            const bf16_t* src = G + (((((((size_t)u.pm * 8 + (2 * u.pn + bj)) * 2 + kind) * 2 + ai) * 4 + m) * 8 + wid) * 64 + lane) * 8;
            __builtin_amdgcn_global_load_lds((const unsigned*)src, (PG8_LAS unsigned*)dump, 16, 0, 0); }
    }
    __device__ __forceinline__ void mid(f32x4 (&acc)[2][2][4][2], const Unit& u, int wr, int wc, int fr, int fq) const {
        const bf16_t* gp = G + ((((size_t)u.pm * 8 + 2 * u.pn) * 2 * 2 * 4 * 8 + (wr * 4 + wc)) * 64 + (fq * 16 + fr)) * 8;
#pragma unroll
        for (int ai = 0; ai < 2; ++ai) {
            asm volatile("" : "+v"(gp));
            u32x4 g1[4][2];
#pragma unroll
            for (int m = 0; m < 4; ++m)
#pragma unroll
                for (int bj = 0; bj < 2; ++bj) g1[m][bj] = *(const u32x4*)(gp + ((size_t)bj * (2 * 2 * 4 * 8) + (ai * 4 + m) * 8) * 64 * 8);
#pragma unroll
            for (int m = 0; m < 4; ++m)
#pragma unroll
                for (int bj = 0; bj < 2; ++bj) { const u32x4 g = g1[m][bj];
                    f32x4& v0 = acc[ai][bj][m][0]; f32x4& v1 = acc[ai][bj][m][1];
                    v0[0] *= bf_lo(g.x); v0[1] *= bf_hi(g.x); v0[2] *= bf_lo(g.y); v0[3] *= bf_hi(g.y);
                    v1[0] *= bf_lo(g.z); v1[1] *= bf_hi(g.z); v1[2] *= bf_lo(g.w); v1[3] *= bf_hi(g.w); }
            asm volatile("" ::: "memory"); }
    }
};
template <class Epi, class Sched, bool ALIGN_EPI = false, bool SP2 = false, bool ATILE = false>
__device__ __forceinline__ void gemm_phase(PG8_LAS unsigned char* lds, const Gemm g, const Sched& S, const Epi& E) {
    const int tid = threadIdx.x, wid = __builtin_amdgcn_readfirstlane(tid >> 6), lane = tid & 63, wr = wid >> 2, wc = wid & 3, fr = lane & 15, fq = lane >> 4;
    const int K = g.K, nt = K / BK;
    unsigned voffA[2], voffB[2];
#pragma unroll
    for (int i = 0; i < 2; ++i) { int R, C; stage_rc(tid * 16 + i * 8192, R, C); const int Rb = Epi::PERM ? ((R & ~31) + perm32(R & 31)) : R;
        voffA[i] = (unsigned)(R * (ATILE ? 256 : K) + C) * 2u; voffB[i] = (unsigned)(Rb * K + C) * 2u; }
    const size_t kstep = (size_t)(BK * 2);
    const size_t hstep = (size_t)HALF * K * 2;
    const size_t tstep = 2 * hstep;
    const size_t hstepA = ATILE ? (size_t)HALF * 256 * 2 : hstep;
#define PG8_AK(t_) (ATILE ? ((size_t)((t_) >> 2) * 131072 + (size_t)((t_) & 3) * 128) : (size_t)(t_) * kstep)
    const unsigned ldsw = (unsigned)wid * 1024u;
    const int aoff = lds_byte(wr * 64 + fr, fq * 8), boff = lds_byte(wc * 32 + fr, fq * 8);
#define PG8_SA(b, h) (((b) * 2 + (h)) * HTB)
#define PG8_SB(b, h) ((4 + (b) * 2 + (h)) * HTB)
#define PG8_STAGE(bufoff, gbase, voff) do { _Pragma("unroll") for (int _i = 0; _i < 2; ++_i) \
        __builtin_amdgcn_global_load_lds((const unsigned*)((const char*)(gbase) + (voff)[_i]), (PG8_LAS unsigned*)(lds + (bufoff) + ldsw + _i * 8192), 16, 0, 0); } while (0)
#define PG8_LDA(dst, b, h) do { _Pragma("unroll") for (int m = 0; m < 4; ++m) _Pragma("unroll") for (int k = 0; k < 2; ++k) dst[m][k] = *(const PG8_LAS bf16x8*)(lds + PG8_SA(b, h) + aoff + m * 2048 + k * 1024); } while (0)
#define PG8_LDB(dst, b, h) do { _Pragma("unroll") for (int n = 0; n < 2; ++n) _Pragma("unroll") for (int k = 0; k < 2; ++k) dst[n][k] = *(const PG8_LAS bf16x8*)(lds + PG8_SB(b, h) + boff + n * 2048 + k * 1024); } while (0)
#define PG8_MMA(ai, bj, At, Bt) do { __builtin_amdgcn_s_setprio(1); _Pragma("unroll") for (int m = 0; m < 4; ++m) _Pragma("unroll") for (int n = 0; n < 2; ++n) _Pragma("unroll") for (int k = 0; k < 2; ++k) \
        acc[ai][bj][m][n] = __builtin_amdgcn_mfma_f32_16x16x32_bf16(Bt[n][k], At[m][k], acc[ai][bj][m][n], 0, 0, 0); __builtin_amdgcn_s_setprio(0); } while (0)
#define PG8_WAIT_V(n) asm volatile("s_waitcnt vmcnt(" #n ")" ::: "memory")
#define PG8_WAIT_L(n) asm volatile("s_waitcnt lgkmcnt(" #n ")" ::: "memory")
#define PG8_WAIT_VP do { if constexpr (Epi::PREFETCH) PG8_WAIT_V(10); else PG8_WAIT_V(8); } while (0)
#define PG8_PF(s_) do { if constexpr (Epi::PREFETCH) E.prefetch(cur, (s_), lds + STAGE_BYTES + 4096 + wid * 1024, wid, lane); } while (0)
#define PG8_BAR __builtin_amdgcn_s_barrier()
#define PG8_SCHED __builtin_amdgcn_sched_barrier(0)
    Unit cur, nxt; int ui = 0;
    if (!S.next(0, cur)) return;
    f32x4 acc[2][2][4][2];
#pragma unroll
    for (int a = 0; a < 2; ++a)
#pragma unroll
        for (int b = 0; b < 2; ++b)
#pragma unroll
            for (int m = 0; m < 4; ++m)
#pragma unroll
                for (int n = 0; n < 2; ++n) acc[a][b][m][n] = (f32x4){0.f, 0.f, 0.f, 0.f};
    bf16x8 At[4][2], B0[2][2], B1[2][2];
    const char* cA = (const char*)g.A + (size_t)cur.pm * tstep; const char* cB = (const char*)g.Bt + (size_t)cur.pn * tstep;
    S.a_ready(cur);
    const PG8_LAS float* rsl = nullptr;
#define PG8_ROWS(unit_, par_) do { if constexpr (Epi::ROWS) { const float* gsrc_ = E.rowscale + (size_t)(unit_).pm * BM + (wid & 3) * 64 + lane; \
        __builtin_amdgcn_global_load_lds((const unsigned*)gsrc_, (PG8_LAS unsigned*)(lds + STAGE_BYTES + (par_) * 2048 + (wid >> 2) * 1024 + (wid & 3) * 256), 4, 0, 0); \
        rsl = (const PG8_LAS float*)(lds + STAGE_BYTES + (par_) * 2048); } } while (0)
    PG8_ROWS(cur, 0);
    if constexpr (SP2) {
        PG8_STAGE(PG8_SB(0, 0), cB, voffB); PG8_STAGE(PG8_SB(0, 1), cB + hstep, voffB); PG8_STAGE(PG8_SA(0, 0), cA, voffA); PG8_STAGE(PG8_SA(0, 1), cA + hstepA, voffA);
        if (wr == 1) PG8_BAR;
        PG8_WAIT_V(2); PG8_BAR;
        PG8_STAGE(PG8_SB(1, 0), cB + kstep, voffB); PG8_STAGE(PG8_SA(1, 0), cA + kstep, voffA); PG8_STAGE(PG8_SB(1, 1), cB + hstep + kstep, voffB);
        PG8_WAIT_V(6); PG8_BAR;
    } else {
        PG8_STAGE(PG8_SB(0, 0), cB, voffB); PG8_STAGE(PG8_SA(0, 0), cA, voffA); PG8_STAGE(PG8_SB(0, 1), cB + hstep, voffB); PG8_STAGE(PG8_SA(0, 1), cA + hstepA, voffA);
        if (wr == 1) PG8_BAR;
        PG8_WAIT_V(4); PG8_BAR;
        PG8_STAGE(PG8_SB(1, 0), cB + kstep, voffB); PG8_STAGE(PG8_SA(1, 0), cA + kstep, voffA); PG8_STAGE(PG8_SB(1, 1), cB + hstep + kstep, voffB);
        PG8_WAIT_V(6); PG8_BAR;
    }
    for (;;) {
        const bool has_next = S.next(ui + 1, nxt);
        const char* nA = has_next ? (const char*)g.A + (size_t)nxt.pm * tstep : cA; const char* nB = has_next ? (const char*)g.Bt + (size_t)nxt.pn * tstep : cB;
        for (int t = 0; t < nt; t += 2) {
            const bool last = (t == nt - 2);
            const char* a1 = cA + PG8_AK(t + 1);
            const char* a2 = last ? nA : cA + PG8_AK(t + 2); const char* b2 = last ? nB : cB + (size_t)(t + 2) * kstep;
            const char* a3 = a2 + kstep; const char* b3 = b2 + kstep;
            if (last && has_next) S.a_ready(nxt);
            if constexpr (Epi::HAS_MID) { if (t == nt / 2) E.mid(acc, cur, wr, wc, fr, fq); }
            if constexpr (SP2) {
            PG8_LDB(B0, 0, 0); PG8_LDB(B1, 0, 1); PG8_SCHED; PG8_LDA(At, 0, 0); PG8_STAGE(PG8_SA(1, 1), a1 + hstepA, voffA); PG8_PF(2 * t);
            PG8_WAIT_VP; PG8_WAIT_L(0); PG8_BAR; PG8_MMA(0, 0, At, B0); PG8_MMA(0, 1, At, B1); PG8_BAR; PG8_SCHED;
            PG8_LDA(At, 0, 1); PG8_STAGE(PG8_SB(0, 0), b2, voffB); PG8_STAGE(PG8_SB(0, 1), b2 + hstep, voffB); PG8_STAGE(PG8_SA(0, 0), a2, voffA); PG8_PF(2 * t + 1);
            PG8_WAIT_VP; PG8_WAIT_L(0); PG8_BAR; PG8_MMA(1, 0, At, B0); PG8_MMA(1, 1, At, B1); PG8_BAR; PG8_SCHED;
            PG8_LDB(B0, 1, 0); PG8_LDB(B1, 1, 1); PG8_SCHED; PG8_LDA(At, 1, 0); PG8_STAGE(PG8_SA(0, 1), a2 + hstepA, voffA); PG8_PF(2 * t + 2);
            PG8_WAIT_VP; PG8_WAIT_L(0); PG8_BAR; PG8_MMA(0, 0, At, B0); PG8_MMA(0, 1, At, B1); PG8_BAR; PG8_SCHED;
            PG8_LDA(At, 1, 1); PG8_STAGE(PG8_SB(1, 0), b3, voffB); PG8_STAGE(PG8_SB(1, 1), b3 + hstep, voffB); PG8_STAGE(PG8_SA(1, 0), a3, voffA); PG8_PF(2 * t + 3);
            PG8_WAIT_VP; PG8_WAIT_L(0); PG8_BAR; PG8_MMA(1, 0, At, B0); PG8_MMA(1, 1, At, B1); PG8_BAR; PG8_SCHED;
            } else {
            PG8_LDB(B0, 0, 0); PG8_SCHED; PG8_LDA(At, 0, 0); PG8_STAGE(PG8_SA(1, 1), a1 + hstepA, voffA);
            PG8_WAIT_L(8); PG8_BAR; PG8_WAIT_L(0); PG8_MMA(0, 0, At, B0); PG8_BAR; PG8_SCHED;
            PG8_LDB(B1, 0, 1); PG8_STAGE(PG8_SB(0, 0), b2, voffB);
            PG8_BAR; PG8_WAIT_L(0); PG8_MMA(0, 1, At, B1); PG8_BAR;
            PG8_LDA(At, 0, 1); PG8_STAGE(PG8_SA(0, 0), a2, voffA);
            PG8_BAR; PG8_WAIT_L(0); PG8_MMA(1, 0, At, B0); PG8_BAR; PG8_SCHED;
            PG8_STAGE(PG8_SB(0, 1), b2 + hstep, voffB);
            PG8_WAIT_V(6); PG8_BAR; PG8_MMA(1, 1, At, B1); PG8_BAR;
            PG8_LDB(B0, 1, 0); PG8_SCHED; PG8_LDA(At, 1, 0); PG8_STAGE(PG8_SA(0, 1), a2 + hstepA, voffA);
            PG8_WAIT_L(8); PG8_BAR; PG8_WAIT_L(0); PG8_MMA(0, 0, At, B0); PG8_BAR; PG8_SCHED;
            PG8_LDB(B1, 1, 1); PG8_STAGE(PG8_SB(1, 0), b3, voffB);
            PG8_BAR; PG8_WAIT_L(0); PG8_MMA(0, 1, At, B1); PG8_BAR;
            PG8_LDA(At, 1, 1); PG8_STAGE(PG8_SA(1, 0), a3, voffA);
            PG8_BAR; PG8_WAIT_L(0); PG8_MMA(1, 0, At, B0); PG8_BAR; PG8_SCHED;
            PG8_STAGE(PG8_SB(1, 1), b3 + hstep, voffB);
            PG8_WAIT_V(6); PG8_BAR; PG8_MMA(1, 1, At, B1); PG8_BAR;
            }
        }
        if constexpr (ALIGN_EPI) { if (wr == 0) PG8_BAR; }
        if constexpr (!Epi::AFTER_DRAIN) { if constexpr (Epi::ROWS) E(acc, cur, wr, wc, fr, fq, rsl); else E(acc, cur, wr, wc, fr, fq); S.done(cur); }
        if (!has_next) break;
#pragma unroll
        for (int a = 0; a < 2; ++a)
#pragma unroll
            for (int b = 0; b < 2; ++b)
#pragma unroll
                for (int m = 0; m < 4; ++m)
#pragma unroll
                    for (int n = 0; n < 2; ++n) acc[a][b][m][n] = (f32x4){0.f, 0.f, 0.f, 0.f};
        cur = nxt; cA = nA; cB = nB; ++ui;
        PG8_ROWS(cur, ui & 1);
        if constexpr (ALIGN_EPI) { if (wr == 1) PG8_BAR; }
    }
    PG8_WAIT_V(0);
    if constexpr (!ALIGN_EPI) { if (wr == 0) PG8_BAR; }
    PG8_BAR;
    if constexpr (Epi::AFTER_DRAIN) { E.fused(acc, cur, wr, wc, fr, fq, lds, wid, lane); S.done(cur); }
#undef PG8_ROWS
#undef PG8_AK
#undef PG8_SA
#undef PG8_SB
#undef PG8_STAGE
#undef PG8_LDA
#undef PG8_LDB
#undef PG8_MMA
#undef PG8_WAIT_V
#undef PG8_WAIT_L
#undef PG8_WAIT_VP
#undef PG8_PF
#undef PG8_BAR
#undef PG8_SCHED
}
}

constexpr int NWAVES = 8;
constexpr int PPITCH = 3072;
constexpr int BATCH = 8, SEQ = 8192, DM = 1024, NIN = 5120, CW = 512, AW = 512, FF = 4096, NH = 8, HD = 64, MBLK = 256, NBLK = SEQ / MBLK;
constexpr int M = BATCH * SEQ;
constexpr int C_U = 0, C_GBN = 1024;
constexpr int C_XIN = 0, C_GB = 512, C_GC = 1024, C_Q = 1536, C_K = 2048, C_V = 2560, C_GCONV = 3072, C_GATTN = 4096;
constexpr float RMS_EPS = 1e-6f, LOG2E = 1.4426950408889634f;
constexpr int N_PHASES = 10;

constexpr size_t MiB = 1u << 20;
constexpr size_t WS_CTL = 0, CTL_ZERO_BYTES = 65536;
constexpr int CW_BAR = 4096;
constexpr size_t WS_T5 = 1 * MiB, WS_KM = 1 * MiB + 65536;
constexpr size_t WS_WIN = 2 * MiB, WS_WC = 12 * MiB, WS_WA = 13 * MiB, WS_WO = 14 * MiB, WS_W1 = 16 * MiB, WS_W2 = 24 * MiB;
constexpr size_t WS_XN = 32 * MiB;
constexpr size_t WS_PROJ = 160 * MiB;
constexpr size_t WS_H = 288 * MiB;
constexpr size_t WS_U = 800 * MiB, WS_O = 864 * MiB;
constexpr size_t WS_PART = 928 * MiB, PART_STRIDE = 131072 + 4096;
constexpr size_t WS_END = 1024 * MiB;

constexpr int LDS_BYTES = 155648;
constexpr int LDS_BARST = LDS_BYTES - 64;

#define GAS __attribute__((address_space(1)))
#define LAS __attribute__((address_space(3)))
typedef unsigned short bf16;
typedef unsigned v4u __attribute__((ext_vector_type(4)));
typedef unsigned v2u __attribute__((ext_vector_type(2)));
typedef float f32x4 __attribute__((ext_vector_type(4)));
typedef float f32x2 __attribute__((ext_vector_type(2)));
typedef float f32x16 __attribute__((ext_vector_type(16)));
typedef short bf16x8 __attribute__((ext_vector_type(8)));
typedef short s16x4 __attribute__((ext_vector_type(4)));
#define LDS_WAIT() asm volatile("s_waitcnt lgkmcnt(0)" ::: "memory")
#define VM_WAIT() asm volatile("s_waitcnt vmcnt(0)" ::: "memory")
__device__ __forceinline__ unsigned f2bf(float f) { unsigned u = __builtin_bit_cast(unsigned, f); return (u + 0x7fffu + ((u >> 16) & 1u)) >> 16; }
__device__ __forceinline__ unsigned pk2(float lo, float hi) { return f2bf(lo) | (f2bf(hi) << 16); }
__device__ __forceinline__ float bflo(unsigned w) { return __uint_as_float(w << 16); }
__device__ __forceinline__ float bfhi(unsigned w) { return __uint_as_float(w & 0xffff0000u); }

#define XB_TMO      128
#define XB_XCNT(j)  (256  + 64 * (j))
#define XB_XSUB(j)  (1280 + 64 * (j))
#define XB_XGEN(j)  (2304 + 64 * (j))
#define XB_TOP      3328
#define XB_TOPGEN   3392
#define XCD_BAR_WORDS 3456
#define XB_SPIN_CAP (1u << 18)

__device__ __forceinline__ unsigned xb_ld(unsigned* p)              { return __hip_atomic_load(p, __ATOMIC_RELAXED, __HIP_MEMORY_SCOPE_AGENT); }
__device__ __forceinline__ unsigned xb_add(unsigned* p, unsigned v) { return __hip_atomic_fetch_add(p, v, __ATOMIC_RELAXED, __HIP_MEMORY_SCOPE_AGENT); }
__device__ __forceinline__ unsigned xb_xcc_id() { return (unsigned)__builtin_amdgcn_s_getreg((3 << 11) | 20) & 0xFu; }
#define XB_SPIN(cond, bar) do { unsigned _sp = 0; while (cond) { __builtin_amdgcn_s_sleep(1); \
    if ((++_sp & 255u) == 0u) { if (xb_ld(&(bar)[XB_TMO])) break; if (_sp > XB_SPIN_CAP) { atomicAdd(&(bar)[XB_TMO], 1u); break; } } } } while (0)

struct XcdBarrier {
    unsigned* bar; unsigned x;
    volatile LAS unsigned* st;
};

__device__ __forceinline__ XcdBarrier xcd_barrier_post(unsigned* bar, volatile LAS unsigned* st) {
    XcdBarrier b; b.bar = bar; b.x = xb_xcc_id(); b.st = st;
    if (threadIdx.x == 0) (void)xb_add(&bar[XB_XCNT(b.x)], 1u);
    return b;
}
__device__ __forceinline__ void xcd_barrier_complete(unsigned* bar, unsigned x, unsigned& nloc, unsigned& nx) {
    const unsigned G = gridDim.x * gridDim.y * gridDim.z;
    unsigned sum, cnt, mine, sp = 0u;
    for (;;) {
        sum = 0u; cnt = 0u; mine = 0u;
#pragma unroll
        for (unsigned j = 0; j < 16; ++j) { const unsigned c = xb_ld(&bar[XB_XCNT(j)]); sum += c; cnt += (c > 0u) ? 1u : 0u; mine = (j == x) ? c : mine; }
        if (sum == G) break;
        __builtin_amdgcn_s_sleep(1);
        if ((++sp & 255u) == 0u) { if (xb_ld(&bar[XB_TMO])) break; if (sp > XB_SPIN_CAP) { atomicAdd(&bar[XB_TMO], 1u); break; } }
    }
    nloc = mine > 0u ? mine : 1u; nx = cnt > 0u ? cnt : 1u;
}

__device__ __forceinline__ void xcd_barrier(const XcdBarrier& b) {
    asm volatile("s_waitcnt vmcnt(0)" ::: "memory");
    __syncthreads();
    if (threadIdx.x == 0) {
        unsigned* bar = b.bar;
        __builtin_amdgcn_s_waitcnt(0);
        unsigned nloc = b.st[0], nx = b.st[1];
        if (nloc == 0u) { xcd_barrier_complete(bar, b.x, nloc, nx); b.st[0] = nloc; b.st[1] = nx; }
        const unsigned old = xb_add(&bar[XB_XSUB(b.x)], 1u);
        const unsigned gen = old / nloc;
        if (old + 1u == (gen + 1u) * nloc) {
            __builtin_amdgcn_fence(__ATOMIC_RELEASE, "agent");
            asm volatile("s_waitcnt vmcnt(0)" ::: "memory");
            const unsigned og = xb_add(&bar[XB_TOP], 1u);
            const unsigned tg = og / nx;
            if (og + 1u == (tg + 1u) * nx) xb_add(&bar[XB_TOPGEN], 1u);
            else XB_SPIN(xb_ld(&bar[XB_TOPGEN]) == tg, bar);
            __builtin_amdgcn_fence(__ATOMIC_ACQUIRE, "agent");
            xb_add(&bar[XB_XGEN(b.x)], 1u);
            asm volatile("s_waitcnt vmcnt(0)" ::: "memory");
        } else {
            XB_SPIN(xb_ld(&bar[XB_XGEN(b.x)]) == gen, bar);
            __builtin_amdgcn_fence(__ATOMIC_ACQUIRE, "agent");
            asm volatile("s_waitcnt vmcnt(0)" ::: "memory");
        }
    }
    __syncthreads();
}

__device__ __forceinline__ void xcd_barrier_local(const XcdBarrier& b) {
    asm volatile("s_waitcnt vmcnt(0)" ::: "memory");
    __syncthreads();
    if (threadIdx.x == 0) {
        unsigned* bar = b.bar;
        __builtin_amdgcn_s_waitcnt(0);
        const unsigned nloc = b.st[0];
        const unsigned old = xb_add(&bar[XB_XSUB(b.x)], 1u);
        const unsigned gen = old / nloc;
        if (old + 1u == (gen + 1u) * nloc) xb_add(&bar[XB_XGEN(b.x)], 1u);
        else XB_SPIN(xb_ld(&bar[XB_XGEN(b.x)]) == gen, bar);
        __builtin_amdgcn_fence(__ATOMIC_ACQUIRE, "agent");
        asm volatile("s_waitcnt vmcnt(0)" ::: "memory");
    }
    __syncthreads();
}

struct Frame {
    LAS unsigned char* lds;
    int tid, lane, wave, vcu, G;
    const float *x, *g_pre1, *w_in, *conv_w, *w_cout, *w_aout, *rel_bias, *w_o, *g_post1, *g_pre2, *w1, *w2, *g_post2;
    float* out;
    bf16 *Win_t, *Wc_t, *Wa_t, *Wo_t, *W1_t, *W2_t;
    bf16 *XN, *PROJ, *U, *O, *M1, *MIX, *HB, *FB, *X1B, *GT;
    float *T5, *KM, *RS2, *RS1; unsigned* convctr;
    unsigned char* part;
};

__device__ __forceinline__ float wave_sum(float v) {
#pragma unroll
    for (int o = 1; o < 64; o <<= 1) v += __shfl_xor(v, o);
    return v;
}
__device__ __forceinline__ void p0_transpose_item(const float* W, int K, int N, bf16* WT, LAS float* scr, int item, int lane, int ldk = 0, int koff = 0, bool gate_il = false, const float* kgain = nullptr) {
    if (ldk == 0) ldk = K;
    const int nblk = N / 32, kb = item / nblk, nb = item % nblk, k0 = 64 * kb, n0 = 32 * nb;
    int nd0 = n0;
    if (gate_il && n0 < C_Q) { if (n0 < C_GB) nd0 = 256 * (n0 >> 7) + (n0 & 127); else if (n0 < C_GC) nd0 = C_GBN + (n0 - C_GB); else nd0 = 256 * ((n0 - C_GC) >> 7) + 128 + ((n0 - C_GC) & 127); }
    if (gate_il && n0 >= C_GCONV) { const int blk = n0 >= C_GATTN ? 1 : 0, cc = n0 - (blk ? C_GATTN : C_GCONV); nd0 = C_GCONV + 256 * (cc >> 7) + 128 * blk + (cc & 127); }
    float t[32];
#pragma unroll
    for (int i = 0; i < 32; ++i) t[i] = W[(size_t)(k0 + 2 * i + (lane >> 5)) * N + n0 + (lane & 31)];
    const int c = lane & 7;
    float g8[8];
    if (kgain) { const f32x4 ga = *(const GAS f32x4*)(kgain + k0 + 8 * c), gb = *(const GAS f32x4*)(kgain + k0 + 8 * c + 4);
        g8[0] = ga.x; g8[1] = ga.y; g8[2] = ga.z; g8[3] = ga.w; g8[4] = gb.x; g8[5] = gb.y; g8[6] = gb.z; g8[7] = gb.w; }
    else {
#pragma unroll
        for (int e = 0; e < 8; ++e) g8[e] = 1.0f; }
    __builtin_amdgcn_sched_barrier(0);
#pragma unroll
    for (int i = 0; i < 32; ++i) scr[(2 * i + (lane >> 5)) * 33 + (lane & 31)] = t[i];
    LDS_WAIT(); asm volatile("" ::: "memory");
#pragma unroll
    for (int j = 0; j < 4; ++j) { const int n = (lane >> 3) + 8 * j; const LAS float* s = scr + (8 * c) * 33 + n;
        v4u o; o.x = pk2(s[0 * 33] * g8[0], s[1 * 33] * g8[1]); o.y = pk2(s[2 * 33] * g8[2], s[3 * 33] * g8[3]); o.z = pk2(s[4 * 33] * g8[4], s[5 * 33] * g8[5]); o.w = pk2(s[6 * 33] * g8[6], s[7 * 33] * g8[7]);
        *(GAS v4u*)(WT + (size_t)(nd0 + n) * ldk + koff + k0 + 8 * c) = o; }
    LDS_WAIT(); asm volatile("" ::: "memory");
}
__device__ __forceinline__ void rms_row_to_bf16(const float* xrow, const float* gain, bf16* orow, int lane) {
    const GAS f32x4* xr = (const GAS f32x4*)xrow + lane; const GAS f32x4* gr = (const GAS f32x4*)gain + lane;
    f32x4 v[4]; float s = 0.f;
#pragma unroll
    for (int j = 0; j < 4; ++j) { v[j] = xr[64 * j]; s += (v[j].x * v[j].x + v[j].y * v[j].y) + (v[j].z * v[j].z + v[j].w * v[j].w); }
    const float rs = 1.0f / sqrtf(wave_sum(s) * (1.f / DM) + RMS_EPS);
    GAS v2u* o8 = (GAS v2u*)orow + lane;
#pragma unroll
    for (int j = 0; j < 4; ++j) { const f32x4 g = gr[64 * j]; v2u w; w.x = pk2(v[j].x * rs * g.x, v[j].y * rs * g.y); w.y = pk2(v[j].z * rs * g.z, v[j].w * rs * g.w); o8[64 * j] = w; }
}
__device__ __forceinline__ void p0_prologue(Frame& F) {
    LAS float* scr = (LAS float*)(F.lds + F.wave * 16384);
    const int gw = F.vcu * NWAVES + F.wave, NGW = F.G * NWAVES;
    constexpr int I_IN = (DM / 64) * (NIN / 32), I_C = (CW / 64) * (DM / 32), I_A = (AW / 64) * (DM / 32), I_O = (DM / 64) * (DM / 32), I_1 = (DM / 64) * (FF / 32), I_2 = (FF / 64) * (DM / 32);
    constexpr int NITEMS = I_IN + I_C + I_A + I_O + I_1 + I_2;
    for (int it = gw; it < NITEMS; it += NGW) {
        int r = it;
        if (r < I_IN) { p0_transpose_item(F.w_in, DM, NIN, F.Win_t, scr, r, F.lane, 0, 0, true, F.g_pre1); continue; } r -= I_IN;
        if (r < I_C) { p0_transpose_item(F.w_cout, CW, DM, F.Wc_t, scr, r, F.lane, CW + AW, 0); continue; } r -= I_C;
        if (r < I_A) { p0_transpose_item(F.w_aout, AW, DM, F.Wc_t, scr, r, F.lane, CW + AW, CW); continue; } r -= I_A;
        if (r < I_O) { p0_transpose_item(F.w_o, DM, DM, F.Wo_t, scr, r, F.lane); continue; } r -= I_O;
        if (r < I_1) { p0_transpose_item(F.w1, DM, FF, F.W1_t, scr, r, F.lane, 0, 0, false, F.g_pre2); continue; } r -= I_1;
        p0_transpose_item(F.w2, FF, DM, F.W2_t, scr, r, F.lane);
    }
    for (int m = gw; m < M; m += 2 * NGW) {
        const int m2 = m + NGW; const GAS f32x4* xa = (const GAS f32x4*)(F.x + (size_t)m * DM) + F.lane; const GAS f32x4* xb = (const GAS f32x4*)(F.x + (size_t)m2 * DM) + F.lane;
        f32x4 va[4], vb[4]; float sa = 0.f, sb = 0.f;
#pragma unroll
        for (int j = 0; j < 4; ++j) { va[j] = xa[64 * j]; vb[j] = xb[64 * j]; }
#pragma unroll
        for (int j = 0; j < 4; ++j) { sa += (va[j].x * va[j].x + va[j].y * va[j].y) + (va[j].z * va[j].z + va[j].w * va[j].w); sb += (vb[j].x * vb[j].x + vb[j].y * vb[j].y) + (vb[j].z * vb[j].z + vb[j].w * vb[j].w); }
        const float ra = 1.0f / sqrtf(wave_sum(sa) * (1.f / DM) + RMS_EPS), rb = 1.0f / sqrtf(wave_sum(sb) * (1.f / DM) + RMS_EPS);
        if (F.lane == 0) { F.RS1[m] = ra; F.RS1[m2] = rb; }
        GAS v2u* oa = (GAS v2u*)(F.XN + (size_t)m * DM) + F.lane; GAS v2u* ob = (GAS v2u*)(F.XN + (size_t)m2 * DM) + F.lane;
#pragma unroll
        for (int j = 0; j < 4; ++j) { v2u w; w.x = pk2(va[j].x, va[j].y); w.y = pk2(va[j].z, va[j].w); oa[64 * j] = w;
            w.x = pk2(vb[j].x, vb[j].y); w.y = pk2(vb[j].z, vb[j].w); ob[64 * j] = w; }
    }
    for (int e = F.vcu * 512 + F.tid; e < (M / MBLK) * 512; e += F.G * 512) F.KM[e] = 0.f;
    for (int e = F.vcu * 512 + F.tid; e < NH * 1024; e += F.G * 512) {
        const int h = e >> 10, d = e & 1023; int bk;
        if (d < 16) bk = d; else { bk = 16; const int thr[15] = {21, 27, 35, 46, 59, 77, 99, 128, 166, 216, 280, 363, 470, 609, 790};
#pragma unroll
            for (int k = 0; k < 15; ++k) bk += (d >= thr[k]) ? 1 : 0; }
        F.T5[e] = F.rel_bias[h * 32 + bk] * LOG2E;
    }
}

__device__ __forceinline__ void conv_tail(Frame& F) {
    const int c = F.lane * 8;
    float w0[8], w1[8], w2[8];
#pragma unroll
    for (int e = 0; e < 8; ++e) { w0[e] = F.conv_w[c + e]; w1[e] = F.conv_w[CW + c + e]; w2[e] = F.conv_w[2 * CW + c + e]; }
#pragma unroll 1
    for (;;) {
        const bool grp = (F.G % 8) == 0; const int gx = (int)blockIdx.x & 7;
        int rr = 0; if (F.lane == 0) rr = (int)__hip_atomic_fetch_add(F.convctr + (grp ? 64 * gx : 0), 1u, __ATOMIC_RELAXED, __HIP_MEMORY_SCOPE_AGENT);
        rr = __builtin_amdgcn_readfirstlane(rr);
        if (rr >= (grp ? SEQ / 32 : M / 32)) break;
        const int t0 = (grp ? gx * SEQ : 0) + rr * 32; const bf16* P = F.PROJ + (size_t)t0 * PPITCH + c;
        float um2[8], um1[8];
        if ((t0 % SEQ) == 0) {
#pragma unroll
            for (int e = 0; e < 8; ++e) { um2[e] = 0.f; um1[e] = 0.f; }
        } else {
            const v4u xa = *(const GAS v4u*)(P - 2 * PPITCH + C_U), xb = *(const GAS v4u*)(P - PPITCH + C_U);
            um2[0] = bflo(xa.x); um2[1] = bfhi(xa.x); um2[2] = bflo(xa.y); um2[3] = bfhi(xa.y); um2[4] = bflo(xa.z); um2[5] = bfhi(xa.z); um2[6] = bflo(xa.w); um2[7] = bfhi(xa.w);
            um1[0] = bflo(xb.x); um1[1] = bfhi(xb.x); um1[2] = bflo(xb.y); um1[3] = bfhi(xb.y); um1[4] = bflo(xb.z); um1[5] = bfhi(xb.z); um1[6] = bflo(xb.w); um1[7] = bfhi(xb.w);
        }
        bf16* Up = F.U + (size_t)t0 * (CW + AW) + c;
#pragma unroll 1
        for (int r0 = 0; r0 < 32; r0 += 4) {
            v4u xv[4], bv[4];
#pragma unroll
            for (int k = 0; k < 4; ++k) { const bf16* Pr = P + (size_t)(r0 + k) * PPITCH; xv[k] = *(const GAS v4u*)(Pr + C_U); bv[k] = *(const GAS v4u*)(Pr + C_GBN); }
#pragma unroll
            for (int k = 0; k < 4; ++k) {
                float u[8], b[8];
                u[0] = bflo(xv[k].x); u[1] = bfhi(xv[k].x); u[2] = bflo(xv[k].y); u[3] = bfhi(xv[k].y); u[4] = bflo(xv[k].z); u[5] = bfhi(xv[k].z); u[6] = bflo(xv[k].w); u[7] = bfhi(xv[k].w);
                b[0] = bflo(bv[k].x); b[1] = bfhi(bv[k].x); b[2] = bflo(bv[k].y); b[3] = bfhi(bv[k].y); b[4] = bflo(bv[k].z); b[5] = bfhi(bv[k].z); b[6] = bflo(bv[k].w); b[7] = bfhi(bv[k].w);
                float o[8];
#pragma unroll
                for (int e = 0; e < 8; ++e) { o[e] = b[e] * (w0[e] * um2[e] + w1[e] * um1[e] + w2[e] * u[e]); um2[e] = um1[e]; um1[e] = u[e]; }
                v4u w; w.x = pk2(o[0], o[1]); w.y = pk2(o[2], o[3]); w.z = pk2(o[4], o[5]); w.w = pk2(o[6], o[7]);
                *(GAS v4u*)(Up + (size_t)(r0 + k) * (CW + AW)) = w; }
        }
    }
}

__device__ __forceinline__ void p6_norms(Frame& F) {
    const int gw = F.vcu * NWAVES + F.wave, NGW = F.G * NWAVES; const bool BL = (F.G == 256); const int R2 = BL ? SEQ / 2 : NGW;
    const GAS f32x4* g1 = (const GAS f32x4*)F.g_post1 + F.lane;
    f32x4 gg[4];
#pragma unroll
    for (int j = 0; j < 4; ++j) gg[j] = g1[64 * j];
    for (int jj = 0; jj < M / (2 * NGW); ++jj) { const int m0 = BL ? (F.vcu >> 5) * SEQ + (F.vcu & 31) * NWAVES + F.wave + jj * 256 : gw + jj * 2 * NGW;
        f32x4 v[2][4], xv[2][4]; float s[2] = {0.f, 0.f};
#pragma unroll
        for (int rr = 0; rr < 2; ++rr) { const size_t m = (size_t)(m0 + rr * R2);
            const GAS v2u* mr = (const GAS v2u*)(F.MIX + m * DM) + F.lane; const GAS v2u* xr = (const GAS v2u*)(F.XN + m * DM) + F.lane;
#pragma unroll
            for (int j = 0; j < 4; ++j) { const v2u w = mr[64 * j]; const v2u xw = xr[64 * j]; xv[rr][j] = (f32x4){bflo(xw.x), bfhi(xw.x), bflo(xw.y), bfhi(xw.y)}; v[rr][j] = (f32x4){bflo(w.x), bfhi(w.x), bflo(w.y), bfhi(w.y)}; } }
#pragma unroll
        for (int rr = 0; rr < 2; ++rr)
#pragma unroll
            for (int j = 0; j < 4; ++j) s[rr] += (v[rr][j].x * v[rr][j].x + v[rr][j].y * v[rr][j].y) + (v[rr][j].z * v[rr][j].z + v[rr][j].w * v[rr][j].w);
        float rs[2], s2[2] = {0.f, 0.f};
#pragma unroll
        for (int rr = 0; rr < 2; ++rr) rs[rr] = 1.0f / sqrtf(wave_sum(s[rr]) * (1.f / DM) + RMS_EPS);
#pragma unroll
        for (int rr = 0; rr < 2; ++rr) { const size_t m = (size_t)(m0 + rr * R2); GAS v2u* x1row = (GAS v2u*)(F.X1B + m * DM) + F.lane;
#pragma unroll
            for (int j = 0; j < 4; ++j) { const f32x4 g = gg[j]; v[rr][j] = xv[rr][j] + v[rr][j] * rs[rr] * g; v2u w; w.x = pk2(v[rr][j].x, v[rr][j].y); w.y = pk2(v[rr][j].z, v[rr][j].w); x1row[64 * j] = w;
                s2[rr] += (v[rr][j].x * v[rr][j].x + v[rr][j].y * v[rr][j].y) + (v[rr][j].z * v[rr][j].z + v[rr][j].w * v[rr][j].w); } }
#pragma unroll
        for (int rr = 0; rr < 2; ++rr) { const size_t m = (size_t)(m0 + rr * R2); const float rs2 = 1.0f / sqrtf(wave_sum(s2[rr]) * (1.f / DM) + RMS_EPS);
            if (F.lane == 0) F.RS2[m] = rs2; }
    }
}
__device__ __forceinline__ void p9_final(Frame& F) {
    const int gw = F.vcu * NWAVES + F.wave, NGW = F.G * NWAVES; const bool BL = (F.G == 256); const int R2 = BL ? SEQ / 2 : NGW;
    const GAS f32x4* g1 = (const GAS f32x4*)F.g_post2 + F.lane;
    f32x4 gg[4];
#pragma unroll
    for (int j = 0; j < 4; ++j) gg[j] = g1[64 * j];
    for (int jj = 0; jj < M / (2 * NGW); ++jj) { const int m0 = BL ? (F.vcu >> 5) * SEQ + (F.vcu & 31) * NWAVES + F.wave + jj * 256 : gw + jj * 2 * NGW;
        f32x4 v[2][4]; v2u xw[2][4]; float s[2] = {0.f, 0.f};
#pragma unroll
        for (int rr = 0; rr < 2; ++rr) { const size_t m = (size_t)(m0 + rr * R2);
            const GAS v2u* fr = (const GAS v2u*)(F.FB + m * DM) + F.lane; const GAS v2u* x1row = (const GAS v2u*)(F.X1B + m * DM) + F.lane;
#pragma unroll
            for (int j = 0; j < 4; ++j) { const v2u w = fr[64 * j]; xw[rr][j] = x1row[64 * j]; v[rr][j] = (f32x4){bflo(w.x), bfhi(w.x), bflo(w.y), bfhi(w.y)}; } }
#pragma unroll
        for (int rr = 0; rr < 2; ++rr)
#pragma unroll
            for (int j = 0; j < 4; ++j) s[rr] += (v[rr][j].x * v[rr][j].x + v[rr][j].y * v[rr][j].y) + (v[rr][j].z * v[rr][j].z + v[rr][j].w * v[rr][j].w);
#pragma unroll
        for (int rr = 0; rr < 2; ++rr) { const size_t m = (size_t)(m0 + rr * R2); const float rs = 1.0f / sqrtf(wave_sum(s[rr]) * (1.f / DM) + RMS_EPS);
            GAS f32x4* orow = (GAS f32x4*)(F.out + m * DM) + F.lane;
#pragma unroll
            for (int j = 0; j < 4; ++j) { const f32x4 g = gg[j]; const f32x4 x1 = (f32x4){bflo(xw[rr][j].x), bfhi(xw[rr][j].x), bflo(xw[rr][j].y), bfhi(xw[rr][j].y)}; orow[64 * j] = x1 + v[rr][j] * rs * g; } }
    }
}

namespace moba2 {
constexpr int NSLOT = 3, SLOTB = 16384;
constexpr int L_RING = 0;
constexpr int L_OST = NSLOT * SLOTB;
constexpr int L_QST = L_OST + NWAVES * 4096;
constexpr int TXMAX = 1343, TLEN = TXMAX + 65;
constexpr int L_TB = L_QST + NWAVES * 4096;
constexpr int L_LIST = L_TB + 2 * TLEN * 4;
constexpr int L_SEL = L_LIST + 15360;
constexpr int L_WSF = L_SEL + 10240;
constexpr int L_CNT = L_WSF + NWAVES * 256;
constexpr int L_RTAB = L_CNT + 512;
constexpr int L_MISC = L_RTAB + 384;
constexpr int L_END = L_MISC + 64;
static_assert(L_END <= LDS_BARST, "attention LDS map");
__device__ __forceinline__ int crow(int r, int hi) { return (r & 3) + 8 * (r >> 2) + 4 * hi; }
typedef short v4i16_t __attribute__((ext_vector_type(4)));
__device__ __forceinline__ s16x4 vtr(const LAS unsigned char* p) { return __builtin_bit_cast(s16x4, __builtin_amdgcn_ds_read_tr16_b64_v4i16((LAS v4i16_t*)p)); }
typedef float f32x2_t __attribute__((ext_vector_type(2))); typedef __bf16 bf16x2_t __attribute__((ext_vector_type(2)));
__device__ __forceinline__ unsigned cvtpk(float lo, float hi) { f32x2_t v = {lo, hi}; bf16x2_t b = __builtin_convertvector(v, bf16x2_t); return __builtin_bit_cast(unsigned, b); }

__device__ __forceinline__ void unit(Frame& F, int b, int h, int lo, int hi_blk) {
    LAS unsigned char* lds = F.lds;
    LAS float* tb = (LAS float*)(lds + L_TB); LAS unsigned short* list = (LAS unsigned short*)(lds + L_LIST); LAS unsigned* selw = (LAS unsigned*)(lds + L_SEL);
    LAS float* wsf = (LAS float*)(lds + L_WSF) + F.wave * 64;
    LAS int* cnt = (LAS int*)(lds + L_CNT); LAS int* off = cnt + 32; LAS int* cur = cnt + 64; LAS unsigned* rtab = (LAS unsigned*)(lds + L_RTAB); LAS int* misc = (LAS int*)(lds + L_MISC);
    const int lane = F.lane, r32 = lane & 31, hi = lane >> 5, tid = F.tid, w = F.wave;
    const int nblk = hi_blk - lo, nq = nblk * MBLK;
    const size_t tokb = (size_t)b * SEQ;
    bf16* PO = (bf16*)F.out; float* PL = (float*)F.part;
    if (tid < 96) cnt[tid] = 0;
    for (int e = tid; e < 2 * TLEN; e += 512) { const int sft = e >= TLEN ? 1 : 0, x = e - sft * TLEN + sft, d = TXMAX - x; tb[e] = d < 0 ? -INFINITY : F.T5[h * 1024 + (d > 1023 ? 1023 : d)]; }
    __syncthreads();
    {
        bf16x8 kmh[4], kml[4];
#pragma unroll
        for (int d0 = 0; d0 < 4; ++d0) {
            const float* kmp = F.KM + ((size_t)(b * NBLK + r32) * 512 + h * 64 + d0 * 16 + hi * 8);
            const f32x4 ka = *(const GAS f32x4*)kmp, kb = *(const GAS f32x4*)(kmp + 4);
            const float kf[8] = {ka.x, ka.y, ka.z, ka.w, kb.x, kb.y, kb.z, kb.w}; unsigned hb[8], lb[8];
#pragma unroll
            for (int e = 0; e < 8; ++e) { hb[e] = f2bf(kf[e]); lb[e] = f2bf(kf[e] - __uint_as_float(hb[e] << 16)); }
            v4u hw, lw; hw.x = hb[0] | (hb[1] << 16); hw.y = hb[2] | (hb[3] << 16); hw.z = hb[4] | (hb[5] << 16); hw.w = hb[6] | (hb[7] << 16);
            lw.x = lb[0] | (lb[1] << 16); lw.y = lb[2] | (lb[3] << 16); lw.z = lb[4] | (lb[5] << 16); lw.w = lb[6] | (lb[7] << 16);
            kmh[d0] = __builtin_bit_cast(bf16x8, hw); kml[d0] = __builtin_bit_cast(bf16x8, lw);
        }
        const bf16* qsel = F.PROJ + (tokb + (size_t)lo * MBLK + r32) * PPITCH + C_Q + h * 64 + hi * 8;
        bf16x8 qc[4];
#pragma unroll
        for (int d0 = 0; d0 < 4; ++d0) qc[d0] = *(const GAS bf16x8*)(qsel + (size_t)(w * 32) * PPITCH + d0 * 16);
#pragma unroll 1
        for (int tq = w; tq < nq / 32; tq += NWAVES) {
            const int i = lo + (tq >> 3); const int qu = tq * 32 + r32;
            const int tn = (tq + NWAVES < nq / 32) ? tq + NWAVES : tq;
            bf16x8 qn[4];
#pragma unroll
            for (int d0 = 0; d0 < 4; ++d0) qn[d0] = *(const GAS bf16x8*)(qsel + (size_t)(tn * 32) * PPITCH + d0 * 16);
            __builtin_amdgcn_sched_barrier(0);
            f32x16 g = f32x16{};
#pragma unroll
            for (int d0 = 0; d0 < 4; ++d0) { const bf16x8 qf = qc[d0];
                g = __builtin_amdgcn_mfma_f32_32x32x16_bf16(kmh[d0], qf, g, 0, 0, 0); g = __builtin_amdgcn_mfma_f32_32x32x16_bf16(kml[d0], qf, g, 0, 0, 0); }
#pragma unroll
            for (int d0 = 0; d0 < 4; ++d0) qc[d0] = qn[d0];
            float v0 = -INFINITY, v1 = -INFINITY, v2 = -INFINITY; int j0 = 0, j1 = 0, j2 = 0;
#define MOBA_INS(xg_, jj_) do { const float xg = (xg_); const int jj = (jj_); const bool c0 = xg > v0, c1 = xg > v1, c2 = xg > v2; \
            const float nv2 = c1 ? v1 : (c2 ? xg : v2), nv1 = c0 ? v0 : (c1 ? xg : v1), nv0 = c0 ? xg : v0; \
            const int nj2 = c1 ? j1 : (c2 ? jj : j2), nj1 = c0 ? j0 : (c1 ? jj : j1), nj0 = c0 ? jj : j0; \
            v0 = nv0; v1 = nv1; v2 = nv2; j0 = nj0; j1 = nj1; j2 = nj2; } while (0)
#pragma unroll
            for (int r = 0; r < 16; ++r) { const int jc = crow(r, hi); MOBA_INS(jc < i ? g[r] : -INFINITY, jc); }
            { const float u0 = __shfl_xor(v0, 32), u1 = __shfl_xor(v1, 32), u2 = __shfl_xor(v2, 32); const int k0 = __shfl_xor(j0, 32), k1 = __shfl_xor(j1, 32), k2 = __shfl_xor(j2, 32);
              MOBA_INS(u0, k0); MOBA_INS(u1, k1); MOBA_INS(u2, k2); }
#undef MOBA_INS
            if (hi == 0) {
                const int nsel = i < 3 ? i : 3;
                selw[qu] = (unsigned)j0 | ((unsigned)j1 << 5) | ((unsigned)j2 << 10);
                if (nsel > 0) __hip_atomic_fetch_add(cnt + j0, 1, __ATOMIC_RELAXED, __HIP_MEMORY_SCOPE_WORKGROUP);
                if (nsel > 1) __hip_atomic_fetch_add(cnt + j1, 1, __ATOMIC_RELAXED, __HIP_MEMORY_SCOPE_WORKGROUP);
                if (nsel > 2) __hip_atomic_fetch_add(cnt + j2, 1, __ATOMIC_RELAXED, __HIP_MEMORY_SCOPE_WORKGROUP);
            }
        }
    }
    __syncthreads();
    if (w == 0) {
        const int c = lane < 32 ? cnt[lane & 31] : 0; const int nt = (c + 31) >> 5, nr = (nt + 7) >> 3;
        int inc = c, incr = nr;
#pragma unroll
        for (int o2 = 1; o2 < 32; o2 <<= 1) { const int t = __shfl_up(inc, o2), t2 = __shfl_up(incr, o2); if ((lane & 31) >= o2) { inc += t; incr += t2; } }
        if (lane < 32) { off[lane] = inc - c; cur[lane] = inc - c;
            for (int r = 0; r < nr; ++r) rtab[nblk + incr - nr + r] = (unsigned)lane | ((unsigned)(r * 8) << 8) | ((unsigned)nt << 16); }
        if (lane < nblk) rtab[lane] = (unsigned)(lo + lane) | 0x80000000u;
        if (lane == 31) misc[0] = nblk + incr;
    }
    __syncthreads();
    for (int qu = tid; qu < nq; qu += 512) {
        const int i = lo + (qu >> 8); const int nsel = i < 3 ? i : 3; const unsigned s = selw[qu];
        if (nsel > 0) { const int p = __hip_atomic_fetch_add(cur + (s & 31), 1, __ATOMIC_RELAXED, __HIP_MEMORY_SCOPE_WORKGROUP); list[p] = (unsigned short)(qu | (0 << 12)); }
        if (nsel > 1) { const int p = __hip_atomic_fetch_add(cur + ((s >> 5) & 31), 1, __ATOMIC_RELAXED, __HIP_MEMORY_SCOPE_WORKGROUP); list[p] = (unsigned short)(qu | (1 << 12)); }
        if (nsel > 2) { const int p = __hip_atomic_fetch_add(cur + ((s >> 10) & 31), 1, __ATOMIC_RELAXED, __HIP_MEMORY_SCOPE_WORKGROUP); list[p] = (unsigned short)(qu | (2 << 12)); }
    }
    __syncthreads();
    const int nrounds = __builtin_amdgcn_readfirstlane(misc[0]), NT = nrounds * 4;
    const char* kvh = (const char*)(F.PROJ + tokb * PPITCH + h * 64);
    const int kkey = 8 * w + (lane >> 3), kch = (lane & 7) ^ ((kkey >> 1) & 7);
    const int vkey = 16 * (w & 3) + (lane >> 2);
    const unsigned ksrc_off = (unsigned)(kkey * PPITCH + C_K + kch * 8) * 2u, vsrc_off = (unsigned)(vkey * PPITCH + C_V + (w >> 2) * 32 + (lane & 3) * 8) * 2u;
    const unsigned lds0 = (unsigned)(uintptr_t)lds;
#define MOBA_GLDS(gsrc_, dst_) do { unsigned keep_; asm volatile("s_mov_b32 %0, m0\n\ts_mov_b32 m0, %2\n\ts_nop 0\n\tglobal_load_lds_dwordx4 %1, off\n\ts_mov_b32 m0, %0" : "=&s"(keep_) : "v"(gsrc_), "s"(dst_) : "memory"); } while (0)
#define MOBA_DMA(jj_, kt_, sl_) do { const char* tb_ = kvh + (size_t)((jj_) * MBLK + (kt_) * 64) * (PPITCH * 2); \
        const unsigned kd_ = (unsigned)__builtin_amdgcn_readfirstlane(lds0 + L_RING + (sl_) * SLOTB + w * 1024), vd_ = (unsigned)__builtin_amdgcn_readfirstlane(lds0 + L_RING + (sl_) * SLOTB + 8192 + w * 1024); \
        MOBA_GLDS(tb_ + ksrc_off, kd_); MOBA_GLDS(tb_ + vsrc_off, vd_); } while (0)
    const int koff = r32 * 128, ksw = (r32 >> 1) & 7;
    const int voff = (4 * hi + ((lane & 15) >> 2)) * 64 + ((lane >> 4) & 1) * 32 + (lane & 3) * 8;
    LAS unsigned char* ost = lds + L_OST + w * 4096;
    LAS int* prow_s = (LAS int*)(wsf + 32);
    bool active = false, near = false, stored_prev = false; int dq = 0, kt_max = 3, jcur = 0, jnext = 0;
    bool n_active = false, n_near = false; int n_dq = 0, n_prow = -1, n_ktmax = 3;
    bf16x8 qf[4]; float mhat = 0.f, l = 0.f, c0 = 0.f, bfar = 0.f; f32x16 o[2]; bool first = true;
    o[0] = f32x16{}; o[1] = f32x16{};
    const unsigned qst0 = lds0 + L_QST + w * 4096; const LAS unsigned char* qst = lds + L_QST + w * 4096;
    bf16* trash = (bf16*)(F.part + 16 * MiB) + (size_t)(blockIdx.x * NWAVES + w) * 2048;
    const char* qbase = (const char*)(F.PROJ + (tokb + (size_t)lo * MBLK) * PPITCH + C_Q + h * 64) + (lane & 7) * 16;
    const int prow_base = (int)(((tokb + (size_t)lo * MBLK) * NH + h) * 4);
#define MOBA_PREP(R_) do { const unsigned re = (unsigned)__builtin_amdgcn_readfirstlane((int)rtab[(R_)]); const int j = re & 31; const bool own = (re >> 31) != 0; int qu, slot, base = 0, lim = 0; bool vld; \
        jnext = j; \
        if (own) { n_active = true; vld = true; qu = (j - lo) * MBLK + w * 32 + r32; slot = 3; n_near = true; n_ktmax = w >> 1; n_dq = w * 32 + r32; } \
        else { const int t0 = (re >> 8) & 255, nt = (re >> 16) & 255; const int tile = t0 + w; n_active = tile < nt; \
            const int cj = __builtin_amdgcn_readfirstlane(cnt[j]), pos = tile * 32 + r32; vld = n_active && pos < cj; base = __builtin_amdgcn_readfirstlane(off[j]) + (n_active ? tile * 32 : 0); lim = n_active ? cj - tile * 32 : 1; \
            const unsigned le = list[base + (vld ? r32 : 0)]; qu = le & 4095; slot = le >> 12; \
            const int i = lo + (qu >> 8); n_ktmax = 3; n_dq = (i - j) * MBLK + (qu & 255); n_near = __any((j + 5 > i) && n_active) != 0; } \
        n_prow = vld ? prow_base + qu * (NH * 4) + slot : -1; \
        _Pragma("unroll") for (int n_ = 0; n_ < 4; ++n_) { const int rho = 8 * n_ + (lane >> 3); int qr; \
            if (own) qr = (j - lo) * MBLK + w * 32 + rho; else qr = list[base + (rho < lim ? rho : 0)] & 4095; \
            const char* src = qbase + (unsigned)qr * (unsigned)(PPITCH * 2); \
            const unsigned qd_ = (unsigned)__builtin_amdgcn_readfirstlane(qst0 + n_ * 1024); MOBA_GLDS(src, qd_); } } while (0)
    MOBA_PREP(0); jcur = jnext;
    MOBA_DMA(jcur, 0, 0); MOBA_DMA(jcur, 1, 1);
    asm volatile("s_waitcnt vmcnt(0)" ::: "memory");
#pragma unroll 1
    for (int T = 0; T < NT; ++T) {
        const int kt = T & 3;
        if (kt == 2) asm volatile("s_waitcnt vmcnt(2) lgkmcnt(0)" ::: "memory");
        else if (kt == 3) asm volatile("s_waitcnt vmcnt(6) lgkmcnt(0)" ::: "memory");
        else if (__builtin_amdgcn_readfirstlane((int)stored_prev)) asm volatile("s_waitcnt vmcnt(7) lgkmcnt(0)" ::: "memory");
        else asm volatile("s_waitcnt vmcnt(2) lgkmcnt(0)" ::: "memory");
        __builtin_amdgcn_s_barrier(); asm volatile("" ::: "memory");
        if (kt == 2) { const int Rn = (T >> 2) + 1; MOBA_PREP(Rn < nrounds ? Rn : nrounds - 1); }
        { const int sl = (T + 2) % NSLOT; if (kt < 2) MOBA_DMA(jcur, kt + 2, sl); else MOBA_DMA(jnext, kt - 2, sl); }
        if (kt == 0) {
            active = n_active; near = n_near; dq = n_dq; kt_max = n_ktmax;
            if (hi == 0) prow_s[r32] = n_prow;
#pragma unroll
            for (int d0 = 0; d0 < 4; ++d0) qf[d0] = *(const LAS bf16x8*)(qst + r32 * 128 + (2 * d0 + hi) * 16);
            bfar = near ? 0.f : tb[TXMAX - 1023]; mhat = 0.f; l = 0.f; c0 = bfar; first = true; o[0] = f32x16{}; o[1] = f32x16{};
        }
        if (kt == 3) jcur = jnext;
        if (kt == 1) stored_prev = false;
        if (active && kt <= kt_max) {
            const LAS unsigned char* buf = lds + L_RING + (T % NSLOT) * SLOTB;
            bf16x8 ka[4], kb[4];
#pragma unroll
            for (int d0 = 0; d0 < 4; ++d0) { const int co = ((2 * d0 + hi) ^ ksw) * 16; ka[d0] = *(const LAS bf16x8*)(buf + koff + co); kb[d0] = *(const LAS bf16x8*)(buf + 4096 + koff + co); }
            f32x16 p0, p1;
#pragma unroll
            for (int r = 0; r < 16; ++r) { p0[r] = c0; p1[r] = c0; }
            __builtin_amdgcn_s_setprio(1);
#pragma unroll
            for (int d0 = 0; d0 < 4; ++d0) { p0 = __builtin_amdgcn_mfma_f32_32x32x16_bf16(ka[d0], qf[d0], p0, 0, 0, 0); p1 = __builtin_amdgcn_mfma_f32_32x32x16_bf16(kb[d0], qf[d0], p1, 0, 0, 0); }
            __builtin_amdgcn_s_setprio(0);
            s16x4 va[8], vc[8];
#pragma unroll
            for (int n = 0; n < 4; ++n) { const LAS unsigned char* vb = buf + 8192 + n * 1024 + voff; va[n] = vtr(vb); vc[n] = vtr(vb + 512); }
            __builtin_amdgcn_sched_barrier(0);
            if (near) {
                int D0 = dq - 64 * kt - 4 * hi; D0 = D0 > 1279 ? 1279 : D0;
                const int x0 = TXMAX - D0, sft = x0 & 1;
                const LAS float* tp = tb + sft * TLEN + (x0 - sft);
#pragma unroll
                for (int g4 = 0; g4 < 4; ++g4) {
                    const f32x2 a0 = *(const LAS f32x2*)(tp + 8 * g4), a1 = *(const LAS f32x2*)(tp + 8 * g4 + 2), b0 = *(const LAS f32x2*)(tp + 32 + 8 * g4), b1 = *(const LAS f32x2*)(tp + 32 + 8 * g4 + 2);
                    p0[4 * g4] += a0.x; p0[4 * g4 + 1] += a0.y; p0[4 * g4 + 2] += a1.x; p0[4 * g4 + 3] += a1.y;
                    p1[4 * g4] += b0.x; p1[4 * g4 + 1] += b0.y; p1[4 * g4 + 2] += b1.x; p1[4 * g4 + 3] += b1.y; }
            }
            float rm;
            { float ma = __builtin_fmaxf(p0[0], p1[0]), mb = __builtin_fmaxf(p0[1], p1[1]);
#pragma unroll
              for (int r = 2; r < 16; r += 2) { asm("v_max3_f32 %0, %1, %2, %3" : "=v"(ma) : "v"(ma), "v"(p0[r]), "v"(p1[r])); asm("v_max3_f32 %0, %1, %2, %3" : "=v"(mb) : "v"(mb), "v"(p0[r + 1]), "v"(p1[r + 1])); }
              rm = __builtin_fmaxf(ma, mb); }
            rm = fmaxf(rm, __shfl_xor(rm, 32));
            if (first || __any(rm > 8.0f)) {
                const float dl = first ? rm : fmaxf(rm, 0.f);
                mhat += dl;
#pragma unroll
                for (int r = 0; r < 16; ++r) { p0[r] -= dl; p1[r] -= dl; }
                const float f = __builtin_amdgcn_exp2f(-dl); l *= f;
                if (!first) {
                    if (hi == 0) wsf[r32] = f;
#pragma unroll
                    for (int r = 0; r < 16; ++r) { const float fr = wsf[crow(r, hi)]; o[0][r] *= fr; o[1][r] *= fr; }
                }
                c0 = bfar - mhat; first = false;
            }
            float sacc = 0.f;
#pragma unroll
            for (int r = 0; r < 16; ++r) { p0[r] = __builtin_amdgcn_exp2f(p0[r]); p1[r] = __builtin_amdgcn_exp2f(p1[r]); sacc += p0[r] + p1[r]; }
            l += sacc;
            v4u pw[4];
            pw[0].x = cvtpk(p0[0], p0[1]); pw[0].y = cvtpk(p0[2], p0[3]); pw[0].z = cvtpk(p0[4], p0[5]); pw[0].w = cvtpk(p0[6], p0[7]);
            pw[1].x = cvtpk(p0[8], p0[9]); pw[1].y = cvtpk(p0[10], p0[11]); pw[1].z = cvtpk(p0[12], p0[13]); pw[1].w = cvtpk(p0[14], p0[15]);
            pw[2].x = cvtpk(p1[0], p1[1]); pw[2].y = cvtpk(p1[2], p1[3]); pw[2].z = cvtpk(p1[4], p1[5]); pw[2].w = cvtpk(p1[6], p1[7]);
            pw[3].x = cvtpk(p1[8], p1[9]); pw[3].y = cvtpk(p1[10], p1[11]); pw[3].z = cvtpk(p1[12], p1[13]); pw[3].w = cvtpk(p1[14], p1[15]);
#pragma unroll
            for (int n = 4; n < 8; ++n) { const LAS unsigned char* vb = buf + 8192 + n * 1024 + voff; va[n] = vtr(vb); vc[n] = vtr(vb + 512); }
            __builtin_amdgcn_s_setprio(1);
#pragma unroll
            for (int d0 = 0; d0 < 2; ++d0)
#pragma unroll
                for (int s = 0; s < 4; ++s) { const int n = d0 * 4 + s;
                    const bf16x8 vf = (bf16x8){va[n][0], va[n][1], va[n][2], va[n][3], vc[n][0], vc[n][1], vc[n][2], vc[n][3]};
                    o[d0] = __builtin_amdgcn_mfma_f32_32x32x16_bf16(__builtin_bit_cast(bf16x8, pw[s]), vf, o[d0], 0, 0, 0); }
            __builtin_amdgcn_s_setprio(0);
        }
        if (kt == 3 && active) {
            l += __shfl_xor(l, 32);
            LAS unsigned* so = (LAS unsigned*)ost;
#pragma unroll
            for (int r = 0; r < 16; ++r) so[crow(r, hi) * 32 + r32] = cvtpk(o[0][r], o[1][r]);
#pragma unroll
            for (int it = 0; it < 4; ++it) { const int row = it * 8 + (lane >> 3), ch = lane & 7;
                const v4u v = *(const LAS v4u*)(ost + row * 128 + ch * 16);
                const int pr = prow_s[row];
                bf16* dst = pr >= 0 ? PO + (size_t)pr * 64 + ch * 8 : trash + row * 64 + ch * 8;
                *(GAS v4u*)dst = v; }
            { const int pr = prow_s[r32]; float* pl = (hi == 0 && pr >= 0) ? PL + (size_t)pr * 2 : (float*)trash + lane * 2; *(GAS f32x2*)pl = (f32x2){mhat, l}; }
            stored_prev = true;
        }
    }
#undef MOBA_DMA
#undef MOBA_GLDS
#undef MOBA_PREP
    VM_WAIT(); LDS_WAIT(); __syncthreads();
#pragma unroll 1
    for (int id0 = tid; id0 < nq * 8; id0 += 2048) {
        f32x4 La[4], Lb[4]; v4u pv[4][4]; size_t tokv[4]; int nselv[4];
#pragma unroll
        for (int u = 0; u < 4; ++u) { const int id = id0 + 512 * u, qu = id >> 3; const int i = lo + (qu >> 8); nselv[u] = i < 3 ? i : 3;
            tokv[u] = tokb + (size_t)lo * MBLK + qu; const size_t pr = (tokv[u] * NH + h) * 4;
            La[u] = __builtin_nontemporal_load((const f32x4*)(PL + pr * 2)); Lb[u] = __builtin_nontemporal_load((const f32x4*)(PL + pr * 2 + 4));
#pragma unroll
            for (int s = 0; s < 4; ++s) pv[u][s] = __builtin_nontemporal_load((const v4u*)(PO + (pr + s) * 64 + (id & 7) * 8)); }
#pragma unroll
        for (int u = 0; u < 4; ++u) { const int id = id0 + 512 * u, ch = id & 7; const int nsel = nselv[u];
            const float Ms[4] = {La[u].x, La[u].z, Lb[u].x, Lb[u].z}, Ls[4] = {La[u].y, La[u].w, Lb[u].y, Lb[u].w}; float Mm = Ms[3];
#pragma unroll
            for (int s = 0; s < 3; ++s) if (s < nsel) Mm = fmaxf(Mm, Ms[s]);
            float acc[8]; float W = 0.f;
#pragma unroll
            for (int e = 0; e < 8; ++e) acc[e] = 0.f;
#pragma unroll
            for (int s = 0; s < 4; ++s) { if (s == 3 || s < nsel) { const float wgt = __builtin_amdgcn_exp2f(Ms[s] - Mm); W += wgt * Ls[s]; const v4u v = pv[u][s];
                acc[0] += wgt * bflo(v.x); acc[1] += wgt * bflo(v.y); acc[2] += wgt * bflo(v.z); acc[3] += wgt * bflo(v.w);
                acc[4] += wgt * bfhi(v.x); acc[5] += wgt * bfhi(v.y); acc[6] += wgt * bfhi(v.z); acc[7] += wgt * bfhi(v.w); } }
            const float rw = 1.0f / W; v2u oa, ob;
            oa.x = pk2(acc[0] * rw, acc[1] * rw); oa.y = pk2(acc[2] * rw, acc[3] * rw); ob.x = pk2(acc[4] * rw, acc[5] * rw); ob.y = pk2(acc[6] * rw, acc[7] * rw);
            bf16* orow = F.U + tokv[u] * (CW + AW) + CW + h * 64 + ch * 4;
            *(GAS v2u*)orow = oa; *(GAS v2u*)(orow + 32) = ob; }
    }
    __syncthreads();
}
__device__ __forceinline__ void phase(Frame& F) {
    const int nun = (BATCH * NH * 4 - (int)blockIdx.x + F.G - 1) / F.G;
#pragma unroll 1
    for (int n = 0; n < nun; ++n) {
        const int id = blockIdx.x + n * F.G; const int x = id & 7, k = (id >> 3) & 31; const int bh = 8 * x + (k >> 2), g = k & 3;
        const int lo = g == 0 ? 0 : (g == 1 ? 10 : (g == 2 ? 18 : 24)), hb = g == 0 ? 10 : (g == 1 ? 18 : (g == 2 ? 24 : 32));
        unit(F, bh >> 3, bh & 7, lo, hb);
    }
}
}

struct Args { const float* in[13]; float* out; unsigned char* ws; int ph_lo, ph_hi; };
__global__ void __launch_bounds__(NWAVES * 64, 2) fwd_kernel(Args args) {
    extern __shared__ __attribute__((aligned(16))) unsigned char lds[];
    Frame F;
    F.lds = (LAS unsigned char*)lds;
    F.tid = threadIdx.x; F.lane = F.tid & 63; F.wave = __builtin_amdgcn_readfirstlane(F.tid >> 6);
    F.G = gridDim.x; { const int bx = blockIdx.x; F.vcu = (F.G % 8 == 0) ? (bx % 8) * (F.G / 8) + bx / 8 : bx; }
    unsigned char* ws = args.ws;
    F.x = args.in[0]; F.g_pre1 = args.in[1]; F.w_in = args.in[2]; F.conv_w = args.in[3]; F.w_cout = args.in[4]; F.w_aout = args.in[5]; F.rel_bias = args.in[6];
    F.w_o = args.in[7]; F.g_post1 = args.in[8]; F.g_pre2 = args.in[9]; F.w1 = args.in[10]; F.w2 = args.in[11]; F.g_post2 = args.in[12]; F.out = args.out;
    F.Win_t = (bf16*)(ws + WS_WIN); F.Wc_t = (bf16*)(ws + WS_WC); F.Wa_t = (bf16*)(ws + WS_WA); F.Wo_t = (bf16*)(ws + WS_WO); F.W1_t = (bf16*)(ws + WS_W1); F.W2_t = (bf16*)(ws + WS_W2);
    F.XN = (bf16*)(ws + WS_XN); F.PROJ = (bf16*)(ws + WS_PROJ); F.U = (bf16*)(ws + WS_U); F.O = (bf16*)(ws + WS_O); F.M1 = (bf16*)args.out; F.MIX = (bf16*)(ws + WS_PROJ);
    F.HB = (bf16*)(ws + WS_H); F.FB = (bf16*)(ws + WS_PROJ); F.T5 = (float*)(ws + WS_T5); F.KM = (float*)(ws + WS_KM); F.part = ws + WS_PART; F.X1B = (bf16*)(ws + WS_U); F.convctr = (unsigned*)(ws + WS_CTL) + 1024; F.RS2 = (float*)(ws + WS_PART + 40 * MiB); F.RS1 = (float*)(ws + WS_PART + 41 * MiB); F.GT = (bf16*)(ws + WS_PROJ + 384 * MiB);
    const int lo = args.ph_lo, hi = args.ph_hi;
    { volatile LAS unsigned* st = (volatile LAS unsigned*)(F.lds + LDS_BARST); if (F.tid == 0) { st[0] = 0u; st[1] = 0u; } }
    __syncthreads();
    XcdBarrier bar = xcd_barrier_post((unsigned*)(ws + WS_CTL) + CW_BAR, (volatile LAS unsigned*)(F.lds + LDS_BARST));
    unsigned* gmask = (unsigned*)(ws + WS_CTL) + 2048;
    if (F.tid == 0) (void)__hip_atomic_fetch_or(gmask + 64 * (blockIdx.x & 7), 1u << bar.x, __ATOMIC_RELAXED, __HIP_MEMORY_SCOPE_AGENT);
    bool local = false;
#ifndef PH_MASK
#define PH_MASK 0x3ff
#endif
#define IN(k) ((((PH_MASK) >> (k)) & 1) && lo <= (k) && (k) < hi)
#define GRID_BAR(k) do { if (IN(k) && (IN((k) + 1) || ((k) == 1 && IN(3)))) { xcd_barrier(bar); } } while (0)
#define LOCAL_BAR(k) do { if (IN(k) && (IN((k) + 1) || ((k) == 1 && IN(3)))) { if (local) xcd_barrier_local(bar); else xcd_barrier(bar); } } while (0)
#ifndef REP_MASK
#define REP_MASK 0
#endif
#define RUNPH(k, ...) do { if (IN(k)) { __VA_ARGS__; if ((REP_MASK >> (k)) & 1) { xcd_barrier(bar); __VA_ARGS__; } } } while (0)
    RUNPH(0, p0_prologue(F)); GRID_BAR(0);
    if (lo == 0 && hi >= 10) {
        volatile LAS unsigned* st = (volatile LAS unsigned*)(F.lds + LDS_BARST);
        if (F.tid == 0) { unsigned ok = (gridDim.x == 256u) ? 1u : 0u, un = 0u;
#pragma unroll
            for (int k = 0; k < 8; ++k) { const unsigned m = xb_ld(gmask + 64 * k); ok &= (m != 0u && (m & (m - 1u)) == 0u) ? 1u : 0u; un |= m; }
            ok &= (__builtin_popcount(un) == 8) ? 1u : 0u; ok &= (st[0] == 32u) ? 1u : 0u;
            st[2] = ok; }
        __syncthreads();
        local = __builtin_amdgcn_readfirstlane((int)st[2]) != 0;
    }
    RUNPH(1, { pg8::Gemm g{F.XN, F.Win_t, M, NIN, DM}; pg8::StaticOrder S; S.init(M, NIN, F.G, (int)blockIdx.x);
        pg8::EpiB<pg8::EM_PROJ> E{F.PROJ, PPITCH, (const pg8::bf16_t*)F.GT, 0, 0, 0, F.KM, F.RS1};
        pg8::gemm_phase<pg8::EpiB<pg8::EM_PROJ>, pg8::StaticOrder, false, true>(F.lds, g, S, E); }); LOCAL_BAR(1);
    RUNPH(3, { moba2::phase(F); conv_tail(F); }); GRID_BAR(3);
    RUNPH(4, { pg8::Gemm g{F.U, F.Wc_t, M, DM, CW + AW}; pg8::StaticOrder S; S.init(M, DM, F.G, (int)blockIdx.x);
        pg8::EpiB<pg8::EM_GATE2> E{F.M1, DM, (const pg8::bf16_t*)F.GT, 0, 0, 0};
        pg8::gemm_phase<pg8::EpiB<pg8::EM_GATE2>, pg8::StaticOrder, true, true>(F.lds, g, S, E); }); LOCAL_BAR(4);
    RUNPH(5, { pg8::Gemm g{F.M1, F.Wo_t, M, DM, DM}; pg8::StaticOrder S; S.init(M, DM, F.G, (int)blockIdx.x);
        pg8::EpiB<pg8::EM_PLAIN> E{F.MIX, DM, nullptr, 0, 0};
        pg8::gemm_phase<pg8::EpiB<pg8::EM_PLAIN>, pg8::StaticOrder, true, true>(F.lds, g, S, E); }); GRID_BAR(5);
    RUNPH(6, p6_norms(F)); LOCAL_BAR(6);
    RUNPH(7, { pg8::Gemm g{F.X1B, F.W1_t, M, FF, DM}; pg8::StaticOrder S; S.init(M, FF, F.G, (int)blockIdx.x);
        pg8::EpiB<pg8::EM_RELU2> E{F.HB, FF, nullptr, 0, 0, 0, nullptr, F.RS2, FF / 256};
        pg8::gemm_phase<pg8::EpiB<pg8::EM_RELU2>, pg8::StaticOrder, false, true>(F.lds, g, S, E); }); LOCAL_BAR(7);
    RUNPH(8, { pg8::Gemm g{F.HB, F.W2_t, M, DM, FF}; pg8::StaticOrder S; S.init(M, DM, F.G, (int)blockIdx.x);
        pg8::EpiB<pg8::EM_PLAIN> E{F.FB, DM, nullptr, 0, 0};
        pg8::gemm_phase<pg8::EpiB<pg8::EM_PLAIN>, pg8::StaticOrder, true, true, true>(F.lds, g, S, E); }); LOCAL_BAR(8);
    if (IN(9)) { p9_final(F); }
#undef IN
#undef GRID_BAR
#undef LOCAL_BAR
}

#ifndef MK_N_LAUNCHES
#define MK_N_LAUNCHES 1
#endif
extern "C" void kernel_launch(void* const* d_in, const int* in_sizes, int n_in, void* d_out, int out_size, void* d_ws, size_t ws_size, hipStream_t stream) {
    static int grid = 0;
    if (grid == 0) {
        if (n_in != 13 || in_sizes[0] != M * DM || out_size != M * DM || ws_size < WS_END) { fprintf(stderr, "kernel_launch: unexpected shapes (n_in %d, in0 %d, out %d, ws %zu)\n", n_in, n_in > 0 ? in_sizes[0] : -1, out_size, ws_size); grid = -1; return; }
        int dev = 0, cus = 0, per_cu = 0;
        if (hipGetDevice(&dev) != hipSuccess || hipDeviceGetAttribute(&cus, hipDeviceAttributeMultiprocessorCount, dev) != hipSuccess) { grid = -1; return; }
        if (hipFuncSetAttribute((const void*)fwd_kernel, hipFuncAttributeMaxDynamicSharedMemorySize, LDS_BYTES) != hipSuccess) { fprintf(stderr, "kernel_launch: hipFuncSetAttribute failed\n"); grid = -1; return; }
        if (hipOccupancyMaxActiveBlocksPerMultiprocessor(&per_cu, (const void*)fwd_kernel, NWAVES * 64, LDS_BYTES) != hipSuccess || per_cu < 1) { fprintf(stderr, "kernel_launch: occupancy query says %d blocks per CU\n", per_cu); (void)hipGetLastError(); per_cu = 1; }
        if (per_cu > 1) per_cu = 1;
        grid = cus * per_cu;
    }
    if (grid < 0) return;
    if (hipMemsetAsync((char*)d_ws + WS_CTL, 0, CTL_ZERO_BYTES, stream) != hipSuccess) { fprintf(stderr, "kernel_launch: hipMemsetAsync failed\n"); return; }
    Args a{};
    for (int i = 0; i < 13; ++i) a.in[i] = (const float*)d_in[i];
    a.out = (float*)d_out; a.ws = (unsigned char*)d_ws;
#if MK_N_LAUNCHES == 1
    a.ph_lo = 0; a.ph_hi = N_PHASES;
    void* kargs[] = {&a};
    hipError_t e = hipLaunchCooperativeKernel((const void*)fwd_kernel, dim3(grid), dim3(NWAVES * 64), kargs, LDS_BYTES, stream);
    if (e != hipSuccess) fprintf(stderr, "kernel_launch: cooperative launch failed: %s (grid %d)\n", hipGetErrorString(e), grid);
#else
    for (int p = 0; p < N_PHASES; ++p) { a.ph_lo = p; a.ph_hi = p + 1;
        void* kargs[] = {&a};
        hipError_t e = hipLaunchCooperativeKernel((const void*)fwd_kernel, dim3(grid), dim3(NWAVES * 64), kargs, LDS_BYTES, stream);
        if (e != hipSuccess) { fprintf(stderr, "kernel_launch: launch %d failed: %s\n", p, hipGetErrorString(e)); break; } }
#endif
}
```

```cpp
#include <hip/hip_runtime.h>
#include <cstdio>
#include <cstdint>
namespace pg8 {
#define PG8_LAS __attribute__((address_space(3)))
typedef unsigned short bf16_t;
typedef short bf16x8 __attribute__((ext_vector_type(8)));
typedef float f32x4 __attribute__((ext_vector_type(4)));
typedef unsigned u32x4 __attribute__((ext_vector_type(4)));
constexpr int BM = 256, BK = 64, HALF = 128, HTB = HALF * BK * 2  , STAGE_BYTES = 8 * HTB, NXCD = 8, WGM = 8;

__host__ __device__ __forceinline__ int lds_byte(int r, int c) { const int st = (r >> 4) * 2 + (c >> 5), rr = r & 15, cc = c & 31, ob = rr * 64 + cc * 2; return st * 1024 + (ob ^ (((ob >> 9) & 1) << 5)); }
__host__ __device__ __forceinline__ void stage_rc(int b, int& R, int& C) { const int st = b / 1024, sb = b % 1024, swz = sb ^ (((sb >> 9) & 1) << 5); R = (st >> 1) * 16 + swz / 64; C = (st & 1) * 32 + (swz % 64) / 2; }
__host__ __device__ __forceinline__ int perm32(int rho) { const int n = rho >> 4, i = rho & 15; return 8 * (i >> 2) + 4 * n + (i & 3); }

struct Unit { int pm, pn; };
struct Gemm { const bf16_t* A; const bf16_t* Bt; int M, N, K; };

struct StaticOrder {
    int nM, nN, nwg, G, c;
    __host__ __device__ void init(int M, int N, int G_, int c_) { nM = M / BM; nN = N / BM; nwg = nM * nN; G = G_; c = c_; }
    __host__ __device__ bool next(int i, Unit& u) const {
        const long L = (long)i * G + c; if (L >= nwg) return false;
        int wgid = (int)L; { const int q = nwg / NXCD, r = nwg % NXCD, xcd = wgid % NXCD, off = wgid / NXCD; wgid = (xcd < r ? xcd * (q + 1) : r * (q + 1) + (xcd - r) * q) + off; }
        const int nig = WGM * nN, gid = wgid / nig, fm = gid * WGM, gsz = (nM - fm) < WGM ? (nM - fm) : WGM;
        u.pm = fm + ((wgid % nig) % gsz); u.pn = (wgid % nig) / gsz; return true;
    }
    __device__ __forceinline__ void a_ready(const Unit&) const {}
    __device__ __forceinline__ void done(const Unit&) const {}
};

__device__ __forceinline__ unsigned cvt_pk_bf16(float lo, float hi) { unsigned r; asm volatile("v_cvt_pk_bf16_f32 %0, %1, %2" : "=v"(r) : "v"(lo), "v"(hi)); return r; }
typedef float f32x2 __attribute__((ext_vector_type(2)));
__device__ __forceinline__ float bf_lo(unsigned w) { return __uint_as_float(w << 16); }
__device__ __forceinline__ float bf_hi(unsigned w) { return __uint_as_float(w & 0xffff0000u); }
constexpr float QSCALE = 0.125f * 1.4426950408889634f;
enum { EM_PROJ = 0, EM_GATE = 1, EM_GATEADD = 2, EM_PLAIN = 3, EM_RELU2 = 4, EM_GATE2 = 5 };
template <int MODE> struct EpiB {
    static constexpr bool PERM = true, AFTER_DRAIN = false, HAS_MID = (MODE == EM_GATE2), ROWS = (MODE == EM_PROJ || MODE == EM_RELU2), PREFETCH = (MODE == EM_GATE2);
    bf16_t* O; int ldc; const bf16_t* G; int ldg; int goff; int goff2 = 0; float* KMp = nullptr; const float* rowscale = nullptr; int otile = 0;
    __device__ __forceinline__ void operator()(f32x4 (&acc)[2][2][4][2], const Unit& u, int wr, int wc, int fr, int fq, const PG8_LAS float* rsl = nullptr) const {
        const int row0 = u.pm * BM + wr * 64 + fr, col0 = u.pn * BM + wc * 32 + 8 * fq;
        float rsq[2][4];
        if (MODE == EM_PROJ) {
#pragma unroll
            for (int ai = 0; ai < 2; ++ai)
#pragma unroll
                for (int m = 0; m < 4; ++m) { const float r_ = rsl[wr * 64 + fr + ai * HALF + m * 16];
#pragma unroll
                    for (int bj = 0; bj < 2; ++bj) { acc[ai][bj][m][0] = acc[ai][bj][m][0] * r_; acc[ai][bj][m][1] = acc[ai][bj][m][1] * r_; } } }
        if (MODE == EM_RELU2) {
#pragma unroll
            for (int ai = 0; ai < 2; ++ai)
#pragma unroll
                for (int m = 0; m < 4; ++m) { const float r_ = rsl[wr * 64 + fr + ai * HALF + m * 16]; rsq[ai][m] = r_ * r_; } }
        u32x4 gpre[2][4][2];
        if (MODE == EM_GATE2) {
#pragma unroll
            for (int ai = 0; ai < 2; ++ai)
#pragma unroll
                for (int m = 0; m < 4; ++m)
#pragma unroll
                    for (int bj = 0; bj < 2; ++bj) gpre[ai][m][bj] = *(const u32x4*)(G + (((((((size_t)u.pm * 8 + (2 * u.pn + bj)) * 2 + 1) * 2 + ai) * 4 + m) * 8 + (wr * 4 + wc)) * 64 + (fq * 16 + fr)) * 8); }
        int pmode = 0; if (MODE == EM_PROJ) { pmode = (u.pn >= 12) ? 2 : ((u.pn == 6 || u.pn == 7) ? 1 : (u.pn < 4 ? 3 : 0)); }
        if (MODE == EM_PROJ) { if (u.pn == 8 || u.pn == 9) {
            float cs[2][2][4];
#pragma unroll
            for (int bj = 0; bj < 2; ++bj)
#pragma unroll
                for (int n = 0; n < 2; ++n)
#pragma unroll
                    for (int e = 0; e < 4; ++e) { float t = 0.f;
#pragma unroll
                        for (int ai = 0; ai < 2; ++ai)
#pragma unroll
                            for (int m = 0; m < 4; ++m) t += acc[ai][bj][m][n][e];
                        t += __shfl_xor(t, 1); t += __shfl_xor(t, 2); t += __shfl_xor(t, 4); t += __shfl_xor(t, 8); cs[bj][n][e] = t; }
            if (fr == 0) { float* kp = KMp + (size_t)u.pm * 512 + (u.pn - 8) * BM + wc * 32 + 8 * fq;
#pragma unroll
                for (int bj = 0; bj < 2; ++bj)
#pragma unroll
                    for (int n = 0; n < 2; ++n)
#pragma unroll
                        for (int e = 0; e < 4; ++e) atomicAdd(kp + bj * HALF + 4 * n + e, cs[bj][n][e]); }
        } }
#pragma unroll
        for (int ai = 0; ai < 2; ++ai)
#pragma unroll
            for (int m = 0; m < 4; ++m) { const size_t row = (size_t)(row0 + ai * HALF + m * 16);
#pragma unroll
                for (int bj = 0; bj < 2; ++bj) { f32x4 v0 = acc[ai][bj][m][0], v1 = acc[ai][bj][m][1]; const int col = col0 + bj * HALF;
                    if (MODE == EM_PROJ) {
                        if (pmode == 3) { if (bj == 1) continue; v0 = v0 * acc[ai][1][m][0]; v1 = v1 * acc[ai][1][m][1]; }
                        if (pmode == 1) { v0 = v0 * QSCALE; v1 = v1 * QSCALE; }
                        else if (pmode == 2) {
                            const f32x4 a0 = acc[ai][1][m][0], a1 = acc[ai][1][m][1];
#pragma unroll
                            for (int e = 0; e < 4; ++e) {
                                const float ea0 = 1.0f + __builtin_amdgcn_exp2f(-1.4426950408889634f * a0[e]), ea1 = 1.0f + __builtin_amdgcn_exp2f(-1.4426950408889634f * a1[e]);
                                if (bj == 0) { v0[e] = ea0 * __builtin_amdgcn_rcpf(1.0f + __builtin_amdgcn_exp2f(-1.4426950408889634f * v0[e])); v1[e] = ea1 * __builtin_amdgcn_rcpf(1.0f + __builtin_amdgcn_exp2f(-1.4426950408889634f * v1[e])); }
                                else { v0[e] = __builtin_amdgcn_rcpf(ea0); v1[e] = __builtin_amdgcn_rcpf(ea1); } }
                        }
                    }
                    if (MODE == EM_RELU2) {
#pragma unroll
                        for (int e = 0; e < 4; ++e) { float a, b; asm("v_max_f32 %0, 0, %1" : "=v"(a) : "v"(v0[e])); asm("v_max_f32 %0, 0, %1" : "=v"(b) : "v"(v1[e])); v0[e] = a * a * rsq[ai][m]; v1[e] = b * b * rsq[ai][m]; }
                    }
                    if (MODE == EM_GATE || MODE == EM_GATEADD || MODE == EM_GATE2) {
                        const u32x4 g = (MODE == EM_GATE2) ? gpre[ai][m][bj] : *(const u32x4*)(G + row * (size_t)ldg + (goff + col));
                        v0[0] *= bf_lo(g.x); v0[1] *= bf_hi(g.x); v0[2] *= bf_lo(g.y); v0[3] *= bf_hi(g.y);
                        v1[0] *= bf_lo(g.z); v1[1] *= bf_hi(g.z); v1[2] *= bf_lo(g.w); v1[3] *= bf_hi(g.w);
                        if (MODE == EM_GATEADD) { const u32x4 o = *(const u32x4*)(O + row * (size_t)ldc + col);
                            v0[0] += bf_lo(o.x); v0[1] += bf_hi(o.x); v0[2] += bf_lo(o.y); v0[3] += bf_hi(o.y);
                            v1[0] += bf_lo(o.z); v1[1] += bf_hi(o.z); v1[2] += bf_lo(o.w); v1[3] += bf_hi(o.w); }
                    }
                    u32x4 w; w.x = cvt_pk_bf16(v0[0], v0[1]); w.y = cvt_pk_bf16(v0[2], v0[3]); w.z = cvt_pk_bf16(v1[0], v1[1]); w.w = cvt_pk_bf16(v1[2], v1[3]);
                    if (MODE == EM_PROJ && pmode == 2) {
                        const size_t vi = ((((((size_t)u.pm * 8 + (u.pn - 12)) * 2 + bj) * 2 + ai) * 4 + m) * 8 + (wr * 4 + wc)) * 64 + (fq * 16 + fr);
                        *(u32x4*)((bf16_t*)G + vi * 8) = w;
                    } else if (otile > 0) {
                        *(u32x4*)(O + ((size_t)u.pm * otile + u.pn) * 65536 + (size_t)(row - (size_t)u.pm * BM) * 256 + (col - u.pn * BM)) = w;
                    } else
                    *(u32x4*)(O + row * (size_t)ldc + ((MODE == EM_PROJ && pmode == 3) ? (HALF * u.pn + wc * 32 + 8 * fq) : col)) = w; }
                if (MODE == EM_GATE || MODE == EM_GATEADD) asm volatile("" ::: "memory"); }
    }
    __device__ __forceinline__ void prefetch(const Unit& u, int s_, PG8_LAS unsigned char* dump, int wid, int lane) const {
        { s_ &= 31;
          const int kind = s_ >> 4, ai = (s_ >> 3) & 1, m = (s_ >> 1) & 3, bj = s_ & 1;
            const bf16_t* src = G + (((((((size_t)u.pm * 8 + (2 * u.pn + bj)) * 2 + kind) * 2 + ai) * 4 + m) * 8 + wid) * 64 + lane) * 8;
            __builtin_amdgcn_global_load_lds((const unsigned*)src, (PG8_LAS unsigned*)dump, 16, 0, 0); }
    }
    __device__ __forceinline__ void mid(f32x4 (&acc)[2][2][4][2], const Unit& u, int wr, int wc, int fr, int fq) const {
        const bf16_t* gp = G + ((((size_t)u.pm * 8 + 2 * u.pn) * 2 * 2 * 4 * 8 + (wr * 4 + wc)) * 64 + (fq * 16 + fr)) * 8;
#pragma unroll
        for (int ai = 0; ai < 2; ++ai) {
            asm volatile("" : "+v"(gp));
            u32x4 g1[4][2];
#pragma unroll
            for (int m = 0; m < 4; ++m)
#pragma unroll
                for (int bj = 0; bj < 2; ++bj) g1[m][bj] = *(const u32x4*)(gp + ((size_t)bj * (2 * 2 * 4 * 8) + (ai * 4 + m) * 8) * 64 * 8);
#pragma unroll
            for (int m = 0; m < 4; ++m)
#pragma unroll
                for (int bj = 0; bj < 2; ++bj) { const u32x4 g = g1[m][bj];
                    f32x4& v0 = acc[ai][bj][m][0]; f32x4& v1 = acc[ai][bj][m][1];
                    v0[0] *= bf_lo(g.x); v0[1] *= bf_hi(g.x); v0[2] *= bf_lo(g.y); v0[3] *= bf_hi(g.y);
                    v1[0] *= bf_lo(g.z); v1[1] *= bf_hi(g.z); v1[2] *= bf_lo(g.w); v1[3] *= bf_hi(g.w); }
            asm volatile("" ::: "memory"); }
    }
};
template <class Epi, class Sched, bool ALIGN_EPI = false, bool SP2 = false, bool ATILE = false>
__device__ __forceinline__ void gemm_phase(PG8_LAS unsigned char* lds, const Gemm g, const Sched& S, const Epi& E) {
    const int tid = threadIdx.x, wid = __builtin_amdgcn_readfirstlane(tid >> 6), lane = tid & 63, wr = wid >> 2, wc = wid & 3, fr = lane & 15, fq = lane >> 4;
    const int K = g.K, nt = K / BK;
    unsigned voffA[2], voffB[2];
#pragma unroll
    for (int i = 0; i < 2; ++i) { int R, C; stage_rc(tid * 16 + i * 8192, R, C); const int Rb = Epi::PERM ? ((R & ~31) + perm32(R & 31)) : R;
        voffA[i] = (unsigned)(R * (ATILE ? 256 : K) + C) * 2u; voffB[i] = (unsigned)(Rb * K + C) * 2u; }
    const size_t kstep = (size_t)(BK * 2);
    const size_t hstep = (size_t)HALF * K * 2;
    const size_t tstep = 2 * hstep;
    const size_t hstepA = ATILE ? (size_t)HALF * 256 * 2 : hstep;
#define PG8_AK(t_) (ATILE ? ((size_t)((t_) >> 2) * 131072 + (size_t)((t_) & 3) * 128) : (size_t)(t_) * kstep)
    const unsigned ldsw = (unsigned)wid * 1024u;
    const int aoff = lds_byte(wr * 64 + fr, fq * 8), boff = lds_byte(wc * 32 + fr, fq * 8);
#define PG8_SA(b, h) (((b) * 2 + (h)) * HTB)
#define PG8_SB(b, h) ((4 + (b) * 2 + (h)) * HTB)
#define PG8_STAGE(bufoff, gbase, voff) do { _Pragma("unroll") for (int _i = 0; _i < 2; ++_i) \
        __builtin_amdgcn_global_load_lds((const unsigned*)((const char*)(gbase) + (voff)[_i]), (PG8_LAS unsigned*)(lds + (bufoff) + ldsw + _i * 8192), 16, 0, 0); } while (0)
#define PG8_LDA(dst, b, h) do { _Pragma("unroll") for (int m = 0; m < 4; ++m) _Pragma("unroll") for (int k = 0; k < 2; ++k) dst[m][k] = *(const PG8_LAS bf16x8*)(lds + PG8_SA(b, h) + aoff + m * 2048 + k * 1024); } while (0)
#define PG8_LDB(dst, b, h) do { _Pragma("unroll") for (int n = 0; n < 2; ++n) _Pragma("unroll") for (int k = 0; k < 2; ++k) dst[n][k] = *(const PG8_LAS bf16x8*)(lds + PG8_SB(b, h) + boff + n * 2048 + k * 1024); } while (0)
#define PG8_MMA(ai, bj, At, Bt) do { __builtin_amdgcn_s_setprio(1); _Pragma("unroll") for (int m = 0; m < 4; ++m) _Pragma("unroll") for (int n = 0; n < 2; ++n) _Pragma("unroll") for (int k = 0; k < 2; ++k) \
        acc[ai][bj][m][n] = __builtin_amdgcn_mfma_f32_16x16x32_bf16(Bt[n][k], At[m][k], acc[ai][bj][m][n], 0, 0, 0); __builtin_amdgcn_s_setprio(0); } while (0)
#define PG8_WAIT_V(n) asm volatile("s_waitcnt vmcnt(" #n ")" ::: "memory")
#define PG8_WAIT_L(n) asm volatile("s_waitcnt lgkmcnt(" #n ")" ::: "memory")
#define PG8_WAIT_VP do { if constexpr (Epi::PREFETCH) PG8_WAIT_V(10); else PG8_WAIT_V(8); } while (0)
#define PG8_PF(s_) do { if constexpr (Epi::PREFETCH) E.prefetch(cur, (s_), lds + STAGE_BYTES + 4096 + wid * 1024, wid, lane); } while (0)
#define PG8_BAR __builtin_amdgcn_s_barrier()
#define PG8_SCHED __builtin_amdgcn_sched_barrier(0)
    Unit cur, nxt; int ui = 0;
    if (!S.next(0, cur)) return;
    f32x4 acc[2][2][4][2];
#pragma unroll
    for (int a = 0; a < 2; ++a)
#pragma unroll
        for (int b = 0; b < 2; ++b)
#pragma unroll
            for (int m = 0; m < 4; ++m)
#pragma unroll
                for (int n = 0; n < 2; ++n) acc[a][b][m][n] = (f32x4){0.f, 0.f, 0.f, 0.f};
    bf16x8 At[4][2], B0[2][2], B1[2][2];
    const char* cA = (const char*)g.A + (size_t)cur.pm * tstep; const char* cB = (const char*)g.Bt + (size_t)cur.pn * tstep;
    S.a_ready(cur);
    const PG8_LAS float* rsl = nullptr;
#define PG8_ROWS(unit_, par_) do { if constexpr (Epi::ROWS) { const float* gsrc_ = E.rowscale + (size_t)(unit_).pm * BM + (wid & 3) * 64 + lane; \
        __builtin_amdgcn_global_load_lds((const unsigned*)gsrc_, (PG8_LAS unsigned*)(lds + STAGE_BYTES + (par_) * 2048 + (wid >> 2) * 1024 + (wid & 3) * 256), 4, 0, 0); \
        rsl = (const PG8_LAS float*)(lds + STAGE_BYTES + (par_) * 2048); } } while (0)
    PG8_ROWS(cur, 0);
    if constexpr (SP2) {
        PG8_STAGE(PG8_SB(0, 0), cB, voffB); PG8_STAGE(PG8_SB(0, 1), cB + hstep, voffB); PG8_STAGE(PG8_SA(0, 0), cA, voffA); PG8_STAGE(PG8_SA(0, 1), cA + hstepA, voffA);
        if (wr == 1) PG8_BAR;
        PG8_WAIT_V(2); PG8_BAR;
        PG8_STAGE(PG8_SB(1, 0), cB + kstep, voffB); PG8_STAGE(PG8_SA(1, 0), cA + kstep, voffA); PG8_STAGE(PG8_SB(1, 1), cB + hstep + kstep, voffB);
        PG8_WAIT_V(6); PG8_BAR;
    } else {
        PG8_STAGE(PG8_SB(0, 0), cB, voffB); PG8_STAGE(PG8_SA(0, 0), cA, voffA); PG8_STAGE(PG8_SB(0, 1), cB + hstep, voffB); PG8_STAGE(PG8_SA(0, 1), cA + hstepA, voffA);
        if (wr == 1) PG8_BAR;
        PG8_WAIT_V(4); PG8_BAR;
        PG8_STAGE(PG8_SB(1, 0), cB + kstep, voffB); PG8_STAGE(PG8_SA(1, 0), cA + kstep, voffA); PG8_STAGE(PG8_SB(1, 1), cB + hstep + kstep, voffB);
        PG8_WAIT_V(6); PG8_BAR;
    }
    for (;;) {
        const bool has_next = S.next(ui + 1, nxt);
        const char* nA = has_next ? (const char*)g.A + (size_t)nxt.pm * tstep : cA; const char* nB = has_next ? (const char*)g.Bt + (size_t)nxt.pn * tstep : cB;
        for (int t = 0; t < nt; t += 2) {
            const bool last = (t == nt - 2);
            const char* a1 = cA + PG8_AK(t + 1);
            const char* a2 = last ? nA : cA + PG8_AK(t + 2); const char* b2 = last ? nB : cB + (size_t)(t + 2) * kstep;
            const char* a3 = a2 + kstep; const char* b3 = b2 + kstep;
            if (last && has_next) S.a_ready(nxt);
            if constexpr (Epi::HAS_MID) { if (t == nt / 2) E.mid(acc, cur, wr, wc, fr, fq); }
            if constexpr (SP2) {
            PG8_LDB(B0, 0, 0); PG8_LDB(B1, 0, 1); PG8_SCHED; PG8_LDA(At, 0, 0); PG8_STAGE(PG8_SA(1, 1), a1 + hstepA, voffA); PG8_PF(2 * t);
            PG8_WAIT_VP; PG8_WAIT_L(0); PG8_BAR; PG8_MMA(0, 0, At, B0); PG8_MMA(0, 1, At, B1); PG8_BAR; PG8_SCHED;
            PG8_LDA(At, 0, 1); PG8_STAGE(PG8_SB(0, 0), b2, voffB); PG8_STAGE(PG8_SB(0, 1), b2 + hstep, voffB); PG8_STAGE(PG8_SA(0, 0), a2, voffA); PG8_PF(2 * t + 1);
            PG8_WAIT_VP; PG8_WAIT_L(0); PG8_BAR; PG8_MMA(1, 0, At, B0); PG8_MMA(1, 1, At, B1); PG8_BAR; PG8_SCHED;
            PG8_LDB(B0, 1, 0); PG8_LDB(B1, 1, 1); PG8_SCHED; PG8_LDA(At, 1, 0); PG8_STAGE(PG8_SA(0, 1), a2 + hstepA, voffA); PG8_PF(2 * t + 2);
            PG8_WAIT_VP; PG8_WAIT_L(0); PG8_BAR; PG8_MMA(0, 0, At, B0); PG8_MMA(0, 1, At, B1); PG8_BAR; PG8_SCHED;
            PG8_LDA(At, 1, 1); PG8_STAGE(PG8_SB(1, 0), b3, voffB); PG8_STAGE(PG8_SB(1, 1), b3 + hstep, voffB); PG8_STAGE(PG8_SA(1, 0), a3, voffA); PG8_PF(2 * t + 3);
            PG8_WAIT_VP; PG8_WAIT_L(0); PG8_BAR; PG8_MMA(1, 0, At, B0); PG8_MMA(1, 1, At, B1); PG8_BAR; PG8_SCHED;
            } else {
            PG8_LDB(B0, 0, 0); PG8_SCHED; PG8_LDA(At, 0, 0); PG8_STAGE(PG8_SA(1, 1), a1 + hstepA, voffA);
            PG8_WAIT_L(8); PG8_BAR; PG8_WAIT_L(0); PG8_MMA(0, 0, At, B0); PG8_BAR; PG8_SCHED;
            PG8_LDB(B1, 0, 1); PG8_STAGE(PG8_SB(0, 0), b2, voffB);
            PG8_BAR; PG8_WAIT_L(0); PG8_MMA(0, 1, At, B1); PG8_BAR;
            PG8_LDA(At, 0, 1); PG8_STAGE(PG8_SA(0, 0), a2, voffA);
            PG8_BAR; PG8_WAIT_L(0); PG8_MMA(1, 0, At, B0); PG8_BAR; PG8_SCHED;
            PG8_STAGE(PG8_SB(0, 1), b2 + hstep, voffB);
            PG8_WAIT_V(6); PG8_BAR; PG8_MMA(1, 1, At, B1); PG8_BAR;
            PG8_LDB(B0, 1, 0); PG8_SCHED; PG8_LDA(At, 1, 0); PG8_STAGE(PG8_SA(0, 1), a2 + hstepA, voffA);
            PG8_WAIT_L(8); PG8_BAR; PG8_WAIT_L(0); PG8_MMA(0, 0, At, B0); PG8_BAR; PG8_SCHED;
            PG8_LDB(B1, 1, 1); PG8_STAGE(PG8_SB(1, 0), b3, voffB);
            PG8_BAR; PG8_WAIT_L(0); PG8_MMA(0, 1, At, B1); PG8_BAR;
            PG8_LDA(At, 1, 1); PG8_STAGE(PG8_SA(1, 0), a3, voffA);
            PG8_BAR; PG8_WAIT_L(0); PG8_MMA(1, 0, At, B0); PG8_BAR; PG8_SCHED;
            PG8_STAGE(PG8_SB(1, 1), b3 + hstep, voffB);
            PG8_WAIT_V(6); PG8_BAR; PG8_MMA(1, 1, At, B1); PG8_BAR;
            }
        }
        if constexpr (ALIGN_EPI) { if (wr == 0) PG8_BAR; }
        if constexpr (!Epi::AFTER_DRAIN) { if constexpr (Epi::ROWS) E(acc, cur, wr, wc, fr, fq, rsl); else E(acc, cur, wr, wc, fr, fq); S.done(cur); }
        if (!has_next) break;
#pragma unroll
        for (int a = 0; a < 2; ++a)
#pragma unroll
            for (int b = 0; b < 2; ++b)
#pragma unroll
                for (int m = 0; m < 4; ++m)
#pragma unroll
                    for (int n = 0; n < 2; ++n) acc[a][b][m][n] = (f32x4){0.f, 0.f, 0.f, 0.f};
        cur = nxt; cA = nA; cB = nB; ++ui;
        PG8_ROWS(cur, ui & 1);
        if constexpr (ALIGN_EPI) { if (wr == 1) PG8_BAR; }
    }
    PG8_WAIT_V(0);
    if constexpr (!ALIGN_EPI) { if (wr == 0) PG8_BAR; }
    PG8_BAR;
    if constexpr (Epi::AFTER_DRAIN) { E.fused(acc, cur, wr, wc, fr, fq, lds, wid, lane); S.done(cur); }
#undef PG8_ROWS
#undef PG8_AK
#undef PG8_SA
#undef PG8_SB
#undef PG8_STAGE
#undef PG8_LDA
#undef PG8_LDB
#undef PG8_MMA
#undef PG8_WAIT_V
#undef PG8_WAIT_L
#undef PG8_WAIT_VP
#undef PG8_PF
#undef PG8_BAR
#undef PG8_SCHED
}
}

constexpr int NWAVES = 8;
constexpr int PPITCH = 3072;
constexpr int BATCH = 8, SEQ = 8192, DM = 1024, NIN = 5120, CW = 512, AW = 512, FF = 4096, NH = 8, HD = 64, MBLK = 256, NBLK = SEQ / MBLK;
constexpr int M = BATCH * SEQ;
constexpr int C_U = 0, C_GBN = 1024;
constexpr int C_XIN = 0, C_GB = 512, C_GC = 1024, C_Q = 1536, C_K = 2048, C_V = 2560, C_GCONV = 3072, C_GATTN = 4096;
constexpr float RMS_EPS = 1e-6f, LOG2E = 1.4426950408889634f;
constexpr int N_PHASES = 10;

constexpr size_t MiB = 1u << 20;
constexpr size_t WS_CTL = 0, CTL_ZERO_BYTES = 65536;
constexpr int CW_BAR = 4096;
constexpr size_t WS_T5 = 1 * MiB, WS_KM = 1 * MiB + 65536;
constexpr size_t WS_WIN = 2 * MiB, WS_WC = 12 * MiB, WS_WA = 13 * MiB, WS_WO = 14 * MiB, WS_W1 = 16 * MiB, WS_W2 = 24 * MiB;
constexpr size_t WS_XN = 32 * MiB;
constexpr size_t WS_PROJ = 160 * MiB;
constexpr size_t WS_H = 288 * MiB;
constexpr size_t WS_U = 800 * MiB, WS_O = 864 * MiB;
constexpr size_t WS_PART = 928 * MiB, PART_STRIDE = 131072 + 4096;
constexpr size_t WS_END = 1024 * MiB;

constexpr int LDS_BYTES = 155648;
constexpr int LDS_BARST = LDS_BYTES - 64;

#define GAS __attribute__((address_space(1)))
#define LAS __attribute__((address_space(3)))
typedef unsigned short bf16;
typedef unsigned v4u __attribute__((ext_vector_type(4)));
typedef unsigned v2u __attribute__((ext_vector_type(2)));
typedef float f32x4 __attribute__((ext_vector_type(4)));
typedef float f32x2 __attribute__((ext_vector_type(2)));
typedef float f32x16 __attribute__((ext_vector_type(16)));
typedef short bf16x8 __attribute__((ext_vector_type(8)));
typedef short s16x4 __attribute__((ext_vector_type(4)));
#define LDS_WAIT() asm volatile("s_waitcnt lgkmcnt(0)" ::: "memory")
#define VM_WAIT() asm volatile("s_waitcnt vmcnt(0)" ::: "memory")
__device__ __forceinline__ unsigned f2bf(float f) { unsigned u = __builtin_bit_cast(unsigned, f); return (u + 0x7fffu + ((u >> 16) & 1u)) >> 16; }
__device__ __forceinline__ unsigned pk2(float lo, float hi) { return f2bf(lo) | (f2bf(hi) << 16); }
__device__ __forceinline__ float bflo(unsigned w) { return __uint_as_float(w << 16); }
__device__ __forceinline__ float bfhi(unsigned w) { return __uint_as_float(w & 0xffff0000u); }

#define XB_TMO      128
#define XB_XCNT(j)  (256  + 64 * (j))
#define XB_XSUB(j)  (1280 + 64 * (j))
#define XB_XGEN(j)  (2304 + 64 * (j))
#define XB_TOP      3328
#define XB_TOPGEN   3392
#define XCD_BAR_WORDS 3456
#define XB_SPIN_CAP (1u << 18)

__device__ __forceinline__ unsigned xb_ld(unsigned* p)              { return __hip_atomic_load(p, __ATOMIC_RELAXED, __HIP_MEMORY_SCOPE_AGENT); }
__device__ __forceinline__ unsigned xb_add(unsigned* p, unsigned v) { return __hip_atomic_fetch_add(p, v, __ATOMIC_RELAXED, __HIP_MEMORY_SCOPE_AGENT); }
__device__ __forceinline__ unsigned xb_xcc_id() { return (unsigned)__builtin_amdgcn_s_getreg((3 << 11) | 20) & 0xFu; }
#define XB_SPIN(cond, bar) do { unsigned _sp = 0; while (cond) { __builtin_amdgcn_s_sleep(1); \
    if ((++_sp & 255u) == 0u) { if (xb_ld(&(bar)[XB_TMO])) break; if (_sp > XB_SPIN_CAP) { atomicAdd(&(bar)[XB_TMO], 1u); break; } } } } while (0)

struct XcdBarrier {
    unsigned* bar; unsigned x;
    volatile LAS unsigned* st;
};

__device__ __forceinline__ XcdBarrier xcd_barrier_post(unsigned* bar, volatile LAS unsigned* st) {
    XcdBarrier b; b.bar = bar; b.x = xb_xcc_id(); b.st = st;
    if (threadIdx.x == 0) (void)xb_add(&bar[XB_XCNT(b.x)], 1u);
    return b;
}
__device__ __forceinline__ void xcd_barrier_complete(unsigned* bar, unsigned x, unsigned& nloc, unsigned& nx) {
    const unsigned G = gridDim.x * gridDim.y * gridDim.z;
    unsigned sum, cnt, mine, sp = 0u;
    for (;;) {
        sum = 0u; cnt = 0u; mine = 0u;
#pragma unroll
        for (unsigned j = 0; j < 16; ++j) { const unsigned c = xb_ld(&bar[XB_XCNT(j)]); sum += c; cnt += (c > 0u) ? 1u : 0u; mine = (j == x) ? c : mine; }
        if (sum == G) break;
        __builtin_amdgcn_s_sleep(1);
        if ((++sp & 255u) == 0u) { if (xb_ld(&bar[XB_TMO])) break; if (sp > XB_SPIN_CAP) { atomicAdd(&bar[XB_TMO], 1u); break; } }
    }
    nloc = mine > 0u ? mine : 1u; nx = cnt > 0u ? cnt : 1u;
}

__device__ __forceinline__ void xcd_barrier(const XcdBarrier& b) {
    asm volatile("s_waitcnt vmcnt(0)" ::: "memory");
    __syncthreads();
    if (threadIdx.x == 0) {
        unsigned* bar = b.bar;
        __builtin_amdgcn_s_waitcnt(0);
        unsigned nloc = b.st[0], nx = b.st[1];
        if (nloc == 0u) { xcd_barrier_complete(bar, b.x, nloc, nx); b.st[0] = nloc; b.st[1] = nx; }
        const unsigned old = xb_add(&bar[XB_XSUB(b.x)], 1u);
        const unsigned gen = old / nloc;
        if (old + 1u == (gen + 1u) * nloc) {
            __builtin_amdgcn_fence(__ATOMIC_RELEASE, "agent");
            asm volatile("s_waitcnt vmcnt(0)" ::: "memory");
            const unsigned og = xb_add(&bar[XB_TOP], 1u);
            const unsigned tg = og / nx;
            if (og + 1u == (tg + 1u) * nx) xb_add(&bar[XB_TOPGEN], 1u);
            else XB_SPIN(xb_ld(&bar[XB_TOPGEN]) == tg, bar);
            __builtin_amdgcn_fence(__ATOMIC_ACQUIRE, "agent");
            xb_add(&bar[XB_XGEN(b.x)], 1u);
            asm volatile("s_waitcnt vmcnt(0)" ::: "memory");
        } else {
            XB_SPIN(xb_ld(&bar[XB_XGEN(b.x)]) == gen, bar);
            __builtin_amdgcn_fence(__ATOMIC_ACQUIRE, "agent");
            asm volatile("s_waitcnt vmcnt(0)" ::: "memory");
        }
    }
    __syncthreads();
}

__device__ __forceinline__ void xcd_barrier_local(const XcdBarrier& b) {
    asm volatile("s_waitcnt vmcnt(0)" ::: "memory");
    __syncthreads();
    if (threadIdx.x == 0) {
        unsigned* bar = b.bar;
        __builtin_amdgcn_s_waitcnt(0);
        const unsigned nloc = b.st[0];
        const unsigned old = xb_add(&bar[XB_XSUB(b.x)], 1u);
        const unsigned gen = old / nloc;
        if (old + 1u == (gen + 1u) * nloc) xb_add(&bar[XB_XGEN(b.x)], 1u);
        else XB_SPIN(xb_ld(&bar[XB_XGEN(b.x)]) == gen, bar);
        __builtin_amdgcn_fence(__ATOMIC_ACQUIRE, "agent");
        asm volatile("s_waitcnt vmcnt(0)" ::: "memory");
    }
    __syncthreads();
}

struct Frame {
    LAS unsigned char* lds;
    int tid, lane, wave, vcu, G;
    const float *x, *g_pre1, *w_in, *conv_w, *w_cout, *w_aout, *rel_bias, *w_o, *g_post1, *g_pre2, *w1, *w2, *g_post2;
    float* out;
    bf16 *Win_t, *Wc_t, *Wa_t, *Wo_t, *W1_t, *W2_t;
    bf16 *XN, *PROJ, *U, *O, *M1, *MIX, *HB, *FB, *X1B, *GT;
    float *T5, *KM, *RS2, *RS1; unsigned* convctr;
    unsigned char* part;
};

__device__ __forceinline__ float wave_sum(float v) {
#pragma unroll
    for (int o = 1; o < 64; o <<= 1) v += __shfl_xor(v, o);
    return v;
}
__device__ __forceinline__ void p0_transpose_item(const float* W, int K, int N, bf16* WT, LAS float* scr, int item, int lane, int ldk = 0, int koff = 0, bool gate_il = false, const float* kgain = nullptr) {
    if (ldk == 0) ldk = K;
    const int nblk = N / 32, kb = item / nblk, nb = item % nblk, k0 = 64 * kb, n0 = 32 * nb;
    int nd0 = n0;
    if (gate_il && n0 < C_Q) { if (n0 < C_GB) nd0 = 256 * (n0 >> 7) + (n0 & 127); else if (n0 < C_GC) nd0 = C_GBN + (n0 - C_GB); else nd0 = 256 * ((n0 - C_GC) >> 7) + 128 + ((n0 - C_GC) & 127); }
    if (gate_il && n0 >= C_GCONV) { const int blk = n0 >= C_GATTN ? 1 : 0, cc = n0 - (blk ? C_GATTN : C_GCONV); nd0 = C_GCONV + 256 * (cc >> 7) + 128 * blk + (cc & 127); }
    float t[32];
#pragma unroll
    for (int i = 0; i < 32; ++i) t[i] = W[(size_t)(k0 + 2 * i + (lane >> 5)) * N + n0 + (lane & 31)];
    const int c = lane & 7;
    float g8[8];
    if (kgain) { const f32x4 ga = *(const GAS f32x4*)(kgain + k0 + 8 * c), gb = *(const GAS f32x4*)(kgain + k0 + 8 * c + 4);
        g8[0] = ga.x; g8[1] = ga.y; g8[2] = ga.z; g8[3] = ga.w; g8[4] = gb.x; g8[5] = gb.y; g8[6] = gb.z; g8[7] = gb.w; }
    else {
#pragma unroll
        for (int e = 0; e < 8; ++e) g8[e] = 1.0f; }
    __builtin_amdgcn_sched_barrier(0);
#pragma unroll
    for (int i = 0; i < 32; ++i) scr[(2 * i + (lane >> 5)) * 33 + (lane & 31)] = t[i];
    LDS_WAIT(); asm volatile("" ::: "memory");
#pragma unroll
    for (int j = 0; j < 4; ++j) { const int n = (lane >> 3) + 8 * j; const LAS float* s = scr + (8 * c) * 33 + n;
        v4u o; o.x = pk2(s[0 * 33] * g8[0], s[1 * 33] * g8[1]); o.y = pk2(s[2 * 33] * g8[2], s[3 * 33] * g8[3]); o.z = pk2(s[4 * 33] * g8[4], s[5 * 33] * g8[5]); o.w = pk2(s[6 * 33] * g8[6], s[7 * 33] * g8[7]);
        *(GAS v4u*)(WT + (size_t)(nd0 + n) * ldk + koff + k0 + 8 * c) = o; }
    LDS_WAIT(); asm volatile("" ::: "memory");
}
__device__ __forceinline__ void rms_row_to_bf16(const float* xrow, const float* gain, bf16* orow, int lane) {
    const GAS f32x4* xr = (const GAS f32x4*)xrow + lane; const GAS f32x4* gr = (const GAS f32x4*)gain + lane;
    f32x4 v[4]; float s = 0.f;
#pragma unroll
    for (int j = 0; j < 4; ++j) { v[j] = xr[64 * j]; s += (v[j].x * v[j].x + v[j].y * v[j].y) + (v[j].z * v[j].z + v[j].w * v[j].w); }
    const float rs = 1.0f / sqrtf(wave_sum(s) * (1.f / DM) + RMS_EPS);
    GAS v2u* o8 = (GAS v2u*)orow + lane;
#pragma unroll
    for (int j = 0; j < 4; ++j) { const f32x4 g = gr[64 * j]; v2u w; w.x = pk2(v[j].x * rs * g.x, v[j].y * rs * g.y); w.y = pk2(v[j].z * rs * g.z, v[j].w * rs * g.w); o8[64 * j] = w; }
}
__device__ __forceinline__ void p0_prologue(Frame& F) {
    LAS float* scr = (LAS float*)(F.lds + F.wave * 16384);
    const int gw = F.vcu * NWAVES + F.wave, NGW = F.G * NWAVES;
    constexpr int I_IN = (DM / 64) * (NIN / 32), I_C = (CW / 64) * (DM / 32), I_A = (AW / 64) * (DM / 32), I_O = (DM / 64) * (DM / 32), I_1 = (DM / 64) * (FF / 32), I_2 = (FF / 64) * (DM / 32);
    constexpr int NITEMS = I_IN + I_C + I_A + I_O + I_1 + I_2;
    for (int it = gw; it < NITEMS; it += NGW) {
        int r = it;
        if (r < I_IN) { p0_transpose_item(F.w_in, DM, NIN, F.Win_t, scr, r, F.lane, 0, 0, true, F.g_pre1); continue; } r -= I_IN;
        if (r < I_C) { p0_transpose_item(F.w_cout, CW, DM, F.Wc_t, scr, r, F.lane, CW + AW, 0); continue; } r -= I_C;
        if (r < I_A) { p0_transpose_item(F.w_aout, AW, DM, F.Wc_t, scr, r, F.lane, CW + AW, CW); continue; } r -= I_A;
        if (r < I_O) { p0_transpose_item(F.w_o, DM, DM, F.Wo_t, scr, r, F.lane); continue; } r -= I_O;
        if (r < I_1) { p0_transpose_item(F.w1, DM, FF, F.W1_t, scr, r, F.lane, 0, 0, false, F.g_pre2); continue; } r -= I_1;
        p0_transpose_item(F.w2, FF, DM, F.W2_t, scr, r, F.lane);
    }
    for (int m = gw; m < M; m += 2 * NGW) {
        const int m2 = m + NGW; const GAS f32x4* xa = (const GAS f32x4*)(F.x + (size_t)m * DM) + F.lane; const GAS f32x4* xb = (const GAS f32x4*)(F.x + (size_t)m2 * DM) + F.lane;
        f32x4 va[4], vb[4]; float sa = 0.f, sb = 0.f;
#pragma unroll
        for (int j = 0; j < 4; ++j) { va[j] = xa[64 * j]; vb[j] = xb[64 * j]; }
#pragma unroll
        for (int j = 0; j < 4; ++j) { sa += (va[j].x * va[j].x + va[j].y * va[j].y) + (va[j].z * va[j].z + va[j].w * va[j].w); sb += (vb[j].x * vb[j].x + vb[j].y * vb[j].y) + (vb[j].z * vb[j].z + vb[j].w * vb[j].w); }
        const float ra = 1.0f / sqrtf(wave_sum(sa) * (1.f / DM) + RMS_EPS), rb = 1.0f / sqrtf(wave_sum(sb) * (1.f / DM) + RMS_EPS);
        if (F.lane == 0) { F.RS1[m] = ra; F.RS1[m2] = rb; }
        GAS v2u* oa = (GAS v2u*)(F.XN + (size_t)m * DM) + F.lane; GAS v2u* ob = (GAS v2u*)(F.XN + (size_t)m2 * DM) + F.lane;
#pragma unroll
        for (int j = 0; j < 4; ++j) { v2u w; w.x = pk2(va[j].x, va[j].y); w.y = pk2(va[j].z, va[j].w); oa[64 * j] = w;
            w.x = pk2(vb[j].x, vb[j].y); w.y = pk2(vb[j].z, vb[j].w); ob[64 * j] = w; }
    }
    for (int e = F.vcu * 512 + F.tid; e < (M / MBLK) * 512; e += F.G * 512) F.KM[e] = 0.f;
    for (int e = F.vcu * 512 + F.tid; e < NH * 1024; e += F.G * 512) {
        const int h = e >> 10, d = e & 1023; int bk;
        if (d < 16) bk = d; else { bk = 16; const int thr[15] = {21, 27, 35, 46, 59, 77, 99, 128, 166, 216, 280, 363, 470, 609, 790};
#pragma unroll
            for (int k = 0; k < 15; ++k) bk += (d >= thr[k]) ? 1 : 0; }
        F.T5[e] = F.rel_bias[h * 32 + bk] * LOG2E;
    }
}

__device__ __forceinline__ void conv_tail(Frame& F) {
    const int c = F.lane * 8;
    float w0[8], w1[8], w2[8];
#pragma unroll
    for (int e = 0; e < 8; ++e) { w0[e] = F.conv_w[c + e]; w1[e] = F.conv_w[CW + c + e]; w2[e] = F.conv_w[2 * CW + c + e]; }
#pragma unroll 1
    for (;;) {
        const bool grp = (F.G % 8) == 0; const int gx = (int)blockIdx.x & 7;
        int rr = 0; if (F.lane == 0) rr = (int)__hip_atomic_fetch_add(F.convctr + (grp ? 64 * gx : 0), 1u, __ATOMIC_RELAXED, __HIP_MEMORY_SCOPE_AGENT);
        rr = __builtin_amdgcn_readfirstlane(rr);
        if (rr >= (grp ? SEQ / 32 : M / 32)) break;
        const int t0 = (grp ? gx * SEQ : 0) + rr * 32; const bf16* P = F.PROJ + (size_t)t0 * PPITCH + c;
        float um2[8], um1[8];
        if ((t0 % SEQ) == 0) {
#pragma unroll
            for (int e = 0; e < 8; ++e) { um2[e] = 0.f; um1[e] = 0.f; }
        } else {
            const v4u xa = *(const GAS v4u*)(P - 2 * PPITCH + C_U), xb = *(const GAS v4u*)(P - PPITCH + C_U);
            um2[0] = bflo(xa.x); um2[1] = bfhi(xa.x); um2[2] = bflo(xa.y); um2[3] = bfhi(xa.y); um2[4] = bflo(xa.z); um2[5] = bfhi(xa.z); um2[6] = bflo(xa.w); um2[7] = bfhi(xa.w);
            um1[0] = bflo(xb.x); um1[1] = bfhi(xb.x); um1[2] = bflo(xb.y); um1[3] = bfhi(xb.y); um1[4] = bflo(xb.z); um1[5] = bfhi(xb.z); um1[6] = bflo(xb.w); um1[7] = bfhi(xb.w);
        }
        bf16* Up = F.U + (size_t)t0 * (CW + AW) + c;
#pragma unroll 1
        for (int r0 = 0; r0 < 32; r0 += 4) {
            v4u xv[4], bv[4];
#pragma unroll
            for (int k = 0; k < 4; ++k) { const bf16* Pr = P + (size_t)(r0 + k) * PPITCH; xv[k] = *(const GAS v4u*)(Pr + C_U); bv[k] = *(const GAS v4u*)(Pr + C_GBN); }
#pragma unroll
            for (int k = 0; k < 4; ++k) {
                float u[8], b[8];
                u[0] = bflo(xv[k].x); u[1] = bfhi(xv[k].x); u[2] = bflo(xv[k].y); u[3] = bfhi(xv[k].y); u[4] = bflo(xv[k].z); u[5] = bfhi(xv[k].z); u[6] = bflo(xv[k].w); u[7] = bfhi(xv[k].w);
                b[0] = bflo(bv[k].x); b[1] = bfhi(bv[k].x); b[2] = bflo(bv[k].y); b[3] = bfhi(bv[k].y); b[4] = bflo(bv[k].z); b[5] = bfhi(bv[k].z); b[6] = bflo(bv[k].w); b[7] = bfhi(bv[k].w);
                float o[8];
#pragma unroll
                for (int e = 0; e < 8; ++e) { o[e] = b[e] * (w0[e] * um2[e] + w1[e] * um1[e] + w2[e] * u[e]); um2[e] = um1[e]; um1[e] = u[e]; }
                v4u w; w.x = pk2(o[0], o[1]); w.y = pk2(o[2], o[3]); w.z = pk2(o[4], o[5]); w.w = pk2(o[6], o[7]);
                *(GAS v4u*)(Up + (size_t)(r0 + k) * (CW + AW)) = w; }
        }
    }
}

__device__ __forceinline__ void p6_norms(Frame& F) {
    const int gw = F.vcu * NWAVES + F.wave, NGW = F.G * NWAVES; const bool BL = (F.G == 256); const int R2 = BL ? SEQ / 2 : NGW;
    const GAS f32x4* g1 = (const GAS f32x4*)F.g_post1 + F.lane;
    f32x4 gg[4];
#pragma unroll
    for (int j = 0; j < 4; ++j) gg[j] = g1[64 * j];
    for (int jj = 0; jj < M / (2 * NGW); ++jj) { const int m0 = BL ? (F.vcu >> 5) * SEQ + (F.vcu & 31) * NWAVES + F.wave + jj * 256 : gw + jj * 2 * NGW;
        f32x4 v[2][4], xv[2][4]; float s[2] = {0.f, 0.f};
#pragma unroll
        for (int rr = 0; rr < 2; ++rr) { const size_t m = (size_t)(m0 + rr * R2);
            const GAS v2u* mr = (const GAS v2u*)(F.MIX + m * DM) + F.lane; const GAS v2u* xr = (const GAS v2u*)(F.XN + m * DM) + F.lane;
#pragma unroll
            for (int j = 0; j < 4; ++j) { const v2u w = mr[64 * j]; const v2u xw = xr[64 * j]; xv[rr][j] = (f32x4){bflo(xw.x), bfhi(xw.x), bflo(xw.y), bfhi(xw.y)}; v[rr][j] = (f32x4){bflo(w.x), bfhi(w.x), bflo(w.y), bfhi(w.y)}; } }
#pragma unroll
        for (int rr = 0; rr < 2; ++rr)
#pragma unroll
            for (int j = 0; j < 4; ++j) s[rr] += (v[rr][j].x * v[rr][j].x + v[rr][j].y * v[rr][j].y) + (v[rr][j].z * v[rr][j].z + v[rr][j].w * v[rr][j].w);
        float rs[2], s2[2] = {0.f, 0.f};
#pragma unroll
        for (int rr = 0; rr < 2; ++rr) rs[rr] = 1.0f / sqrtf(wave_sum(s[rr]) * (1.f / DM) + RMS_EPS);
#pragma unroll
        for (int rr = 0; rr < 2; ++rr) { const size_t m = (size_t)(m0 + rr * R2); GAS v2u* x1row = (GAS v2u*)(F.X1B + m * DM) + F.lane;
#pragma unroll
            for (int j = 0; j < 4; ++j) { const f32x4 g = gg[j]; v[rr][j] = xv[rr][j] + v[rr][j] * rs[rr] * g; v2u w; w.x = pk2(v[rr][j].x, v[rr][j].y); w.y = pk2(v[rr][j].z, v[rr][j].w); x1row[64 * j] = w;
                s2[rr] += (v[rr][j].x * v[rr][j].x + v[rr][j].y * v[rr][j].y) + (v[rr][j].z * v[rr][j].z + v[rr][j].w * v[rr][j].w); } }
#pragma unroll
        for (int rr = 0; rr < 2; ++rr) { const size_t m = (size_t)(m0 + rr * R2); const float rs2 = 1.0f / sqrtf(wave_sum(s2[rr]) * (1.f / DM) + RMS_EPS);
            if (F.lane == 0) F.RS2[m] = rs2; }
    }
}
__device__ __forceinline__ void p9_final(Frame& F) {
    const int gw = F.vcu * NWAVES + F.wave, NGW = F.G * NWAVES; const bool BL = (F.G == 256); const int R2 = BL ? SEQ / 2 : NGW;
    const GAS f32x4* g1 = (const GAS f32x4*)F.g_post2 + F.lane;
    f32x4 gg[4];
#pragma unroll
    for (int j = 0; j < 4; ++j) gg[j] = g1[64 * j];
    for (int jj = 0; jj < M / (2 * NGW); ++jj) { const int m0 = BL ? (F.vcu >> 5) * SEQ + (F.vcu & 31) * NWAVES + F.wave + jj * 256 : gw + jj * 2 * NGW;
        f32x4 v[2][4]; v2u xw[2][4]; float s[2] = {0.f, 0.f};
#pragma unroll
        for (int rr = 0; rr < 2; ++rr) { const size_t m = (size_t)(m0 + rr * R2);
            const GAS v2u* fr = (const GAS v2u*)(F.FB + m * DM) + F.lane; const GAS v2u* x1row = (const GAS v2u*)(F.X1B + m * DM) + F.lane;
#pragma unroll
            for (int j = 0; j < 4; ++j) { const v2u w = fr[64 * j]; xw[rr][j] = x1row[64 * j]; v[rr][j] = (f32x4){bflo(w.x), bfhi(w.x), bflo(w.y), bfhi(w.y)}; } }
#pragma unroll
        for (int rr = 0; rr < 2; ++rr)
#pragma unroll
            for (int j = 0; j < 4; ++j) s[rr] += (v[rr][j].x * v[rr][j].x + v[rr][j].y * v[rr][j].y) + (v[rr][j].z * v[rr][j].z + v[rr][j].w * v[rr][j].w);
#pragma unroll
        for (int rr = 0; rr < 2; ++rr) { const size_t m = (size_t)(m0 + rr * R2); const float rs = 1.0f / sqrtf(wave_sum(s[rr]) * (1.f / DM) + RMS_EPS);
            GAS f32x4* orow = (GAS f32x4*)(F.out + m * DM) + F.lane;
#pragma unroll
            for (int j = 0; j < 4; ++j) { const f32x4 g = gg[j]; const f32x4 x1 = (f32x4){bflo(xw[rr][j].x), bfhi(xw[rr][j].x), bflo(xw[rr][j].y), bfhi(xw[rr][j].y)}; orow[64 * j] = x1 + v[rr][j] * rs * g; } }
    }
}

namespace moba2 {
constexpr int NSLOT = 3, SLOTB = 16384;
constexpr int L_RING = 0;
constexpr int L_OST = NSLOT * SLOTB;
constexpr int L_QST = L_OST + NWAVES * 4096;
constexpr int TXMAX = 1343, TLEN = TXMAX + 65;
constexpr int L_TB = L_QST + NWAVES * 4096;
constexpr int L_LIST = L_TB + 2 * TLEN * 4;
constexpr int L_SEL = L_LIST + 15360;
constexpr int L_WSF = L_SEL + 10240;
constexpr int L_CNT = L_WSF + NWAVES * 256;
constexpr int L_RTAB = L_CNT + 512;
constexpr int L_MISC = L_RTAB + 384;
constexpr int L_END = L_MISC + 64;
static_assert(L_END <= LDS_BARST, "attention LDS map");
__device__ __forceinline__ int crow(int r, int hi) { return (r & 3) + 8 * (r >> 2) + 4 * hi; }
typedef short v4i16_t __attribute__((ext_vector_type(4)));
__device__ __forceinline__ s16x4 vtr(const LAS unsigned char* p) { return __builtin_bit_cast(s16x4, __builtin_amdgcn_ds_read_tr16_b64_v4i16((LAS v4i16_t*)p)); }
typedef float f32x2_t __attribute__((ext_vector_type(2))); typedef __bf16 bf16x2_t __attribute__((ext_vector_type(2)));
__device__ __forceinline__ unsigned cvtpk(float lo, float hi) { f32x2_t v = {lo, hi}; bf16x2_t b = __builtin_convertvector(v, bf16x2_t); return __builtin_bit_cast(unsigned, b); }

__device__ __forceinline__ void unit(Frame& F, int b, int h, int lo, int hi_blk) {
    LAS unsigned char* lds = F.lds;
    LAS float* tb = (LAS float*)(lds + L_TB); LAS unsigned short* list = (LAS unsigned short*)(lds + L_LIST); LAS unsigned* selw = (LAS unsigned*)(lds + L_SEL);
    LAS float* wsf = (LAS float*)(lds + L_WSF) + F.wave * 64;
    LAS int* cnt = (LAS int*)(lds + L_CNT); LAS int* off = cnt + 32; LAS int* cur = cnt + 64; LAS unsigned* rtab = (LAS unsigned*)(lds + L_RTAB); LAS int* misc = (LAS int*)(lds + L_MISC);
    const int lane = F.lane, r32 = lane & 31, hi = lane >> 5, tid = F.tid, w = F.wave;
    const int nblk = hi_blk - lo, nq = nblk * MBLK;
    const size_t tokb = (size_t)b * SEQ;
    bf16* PO = (bf16*)F.out; float* PL = (float*)F.part;
    if (tid < 96) cnt[tid] = 0;
    { constexpr int NTB = (2 * TLEN + 511) / 512; float tv[NTB];
#pragma unroll
      for (int k = 0; k < NTB; ++k) { const int e = tid + 512 * k, sft = e >= TLEN ? 1 : 0, x = e - sft * TLEN + sft; int d = TXMAX - x; d = d < 0 ? 0 : (d > 1023 ? 1023 : d); tv[k] = F.T5[h * 1024 + d]; }
      __builtin_amdgcn_sched_barrier(0);
#pragma unroll
      for (int k = 0; k < NTB; ++k) { const int e = tid + 512 * k, sft = e >= TLEN ? 1 : 0, x = e - sft * TLEN + sft, d = TXMAX - x; if (e < 2 * TLEN) tb[e] = d < 0 ? -INFINITY : tv[k]; } }
    __syncthreads();
    {
        bf16x8 kmh[4], kml[4];
        f32x4 kav[4], kbv[4];
#pragma unroll
        for (int d0 = 0; d0 < 4; ++d0) { const float* kmp = F.KM + ((size_t)(b * NBLK + r32) * 512 + h * 64 + d0 * 16 + hi * 8); kav[d0] = *(const GAS f32x4*)kmp; kbv[d0] = *(const GAS f32x4*)(kmp + 4); }
        __builtin_amdgcn_sched_barrier(0);
#pragma unroll
        for (int d0 = 0; d0 < 4; ++d0) {
            const f32x4 ka = kav[d0], kb = kbv[d0];
            const float kf[8] = {ka.x, ka.y, ka.z, ka.w, kb.x, kb.y, kb.z, kb.w}; unsigned hb[8], lb[8];
#pragma unroll
            for (int e = 0; e < 8; ++e) { hb[e] = f2bf(kf[e]); lb[e] = f2bf(kf[e] - __uint_as_float(hb[e] << 16)); }
            v4u hw, lw; hw.x = hb[0] | (hb[1] << 16); hw.y = hb[2] | (hb[3] << 16); hw.z = hb[4] | (hb[5] << 16); hw.w = hb[6] | (hb[7] << 16);
            lw.x = lb[0] | (lb[1] << 16); lw.y = lb[2] | (lb[3] << 16); lw.z = lb[4] | (lb[5] << 16); lw.w = lb[6] | (lb[7] << 16);
            kmh[d0] = __builtin_bit_cast(bf16x8, hw); kml[d0] = __builtin_bit_cast(bf16x8, lw);
        }
        const bf16* qsel = F.PROJ + (tokb + (size_t)lo * MBLK + r32) * PPITCH + C_Q + h * 64 + hi * 8;
        bf16x8 qc[4];
#pragma unroll
        for (int d0 = 0; d0 < 4; ++d0) qc[d0] = *(const GAS bf16x8*)(qsel + (size_t)(w * 32) * PPITCH + d0 * 16);
#pragma unroll 1
        for (int tq = w; tq < nq / 32; tq += NWAVES) {
            const int i = lo + (tq >> 3); const int qu = tq * 32 + r32;
            const int tn = (tq + NWAVES < nq / 32) ? tq + NWAVES : tq;
            bf16x8 qn[4];
#pragma unroll
            for (int d0 = 0; d0 < 4; ++d0) qn[d0] = *(const GAS bf16x8*)(qsel + (size_t)(tn * 32) * PPITCH + d0 * 16);
            __builtin_amdgcn_sched_barrier(0);
            f32x16 g = f32x16{};
#pragma unroll
            for (int d0 = 0; d0 < 4; ++d0) { const bf16x8 qf = qc[d0];
                g = __builtin_amdgcn_mfma_f32_32x32x16_bf16(kmh[d0], qf, g, 0, 0, 0); g = __builtin_amdgcn_mfma_f32_32x32x16_bf16(kml[d0], qf, g, 0, 0, 0); }
#pragma unroll
            for (int d0 = 0; d0 < 4; ++d0) qc[d0] = qn[d0];
            float v0 = -INFINITY, v1 = -INFINITY, v2 = -INFINITY; int j0 = 0, j1 = 0, j2 = 0;
#define MOBA_INS(xg_, jj_) do { const float xg = (xg_); const int jj = (jj_); const bool c0 = xg > v0, c1 = xg > v1, c2 = xg > v2; \
            const float nv2 = c1 ? v1 : (c2 ? xg : v2), nv1 = c0 ? v0 : (c1 ? xg : v1), nv0 = c0 ? xg : v0; \
            const int nj2 = c1 ? j1 : (c2 ? jj : j2), nj1 = c0 ? j0 : (c1 ? jj : j1), nj0 = c0 ? jj : j0; \
            v0 = nv0; v1 = nv1; v2 = nv2; j0 = nj0; j1 = nj1; j2 = nj2; } while (0)
#pragma unroll
            for (int r = 0; r < 16; ++r) { const int jc = crow(r, hi); MOBA_INS(jc < i ? g[r] : -INFINITY, jc); }
            { const float u0 = __shfl_xor(v0, 32), u1 = __shfl_xor(v1, 32), u2 = __shfl_xor(v2, 32); const int k0 = __shfl_xor(j0, 32), k1 = __shfl_xor(j1, 32), k2 = __shfl_xor(j2, 32);
              MOBA_INS(u0, k0); MOBA_INS(u1, k1); MOBA_INS(u2, k2); }
#undef MOBA_INS
            if (hi == 0) {
                const int nsel = i < 3 ? i : 3;
                selw[qu] = (unsigned)j0 | ((unsigned)j1 << 5) | ((unsigned)j2 << 10);
                if (nsel > 0) __hip_atomic_fetch_add(cnt + j0, 1, __ATOMIC_RELAXED, __HIP_MEMORY_SCOPE_WORKGROUP);
                if (nsel > 1) __hip_atomic_fetch_add(cnt + j1, 1, __ATOMIC_RELAXED, __HIP_MEMORY_SCOPE_WORKGROUP);
                if (nsel > 2) __hip_atomic_fetch_add(cnt + j2, 1, __ATOMIC_RELAXED, __HIP_MEMORY_SCOPE_WORKGROUP);
            }
        }
    }
    __syncthreads();
    if (w == 0) {
        const int c = lane < 32 ? cnt[lane & 31] : 0; const int nt = (c + 31) >> 5, nr = (nt + 7) >> 3;
        int inc = c, incr = nr;
#pragma unroll
        for (int o2 = 1; o2 < 32; o2 <<= 1) { const int t = __shfl_up(inc, o2), t2 = __shfl_up(incr, o2); if ((lane & 31) >= o2) { inc += t; incr += t2; } }
        if (lane < 32) { off[lane] = inc - c; cur[lane] = inc - c;
            for (int r = 0; r < nr; ++r) rtab[nblk + incr - nr + r] = (unsigned)lane | ((unsigned)(r * 8) << 8) | ((unsigned)nt << 16); }
        if (lane < nblk) rtab[lane] = (unsigned)(lo + lane) | 0x80000000u;
        if (lane == 31) misc[0] = nblk + incr;
    }
    __syncthreads();
    for (int qu = tid; qu < nq; qu += 512) {
        const int i = lo + (qu >> 8); const int nsel = i < 3 ? i : 3; const unsigned s = selw[qu];
        if (nsel > 0) { const int p = __hip_atomic_fetch_add(cur + (s & 31), 1, __ATOMIC_RELAXED, __HIP_MEMORY_SCOPE_WORKGROUP); list[p] = (unsigned short)(qu | (0 << 12)); }
        if (nsel > 1) { const int p = __hip_atomic_fetch_add(cur + ((s >> 5) & 31), 1, __ATOMIC_RELAXED, __HIP_MEMORY_SCOPE_WORKGROUP); list[p] = (unsigned short)(qu | (1 << 12)); }
        if (nsel > 2) { const int p = __hip_atomic_fetch_add(cur + ((s >> 10) & 31), 1, __ATOMIC_RELAXED, __HIP_MEMORY_SCOPE_WORKGROUP); list[p] = (unsigned short)(qu | (2 << 12)); }
    }
    __syncthreads();
    const int nrounds = __builtin_amdgcn_readfirstlane(misc[0]), NT = nrounds * 4;
    const char* kvh = (const char*)(F.PROJ + tokb * PPITCH + h * 64);
    const int kkey = 8 * w + (lane >> 3), kch = (lane & 7) ^ ((kkey >> 1) & 7);
    const int vkey = 16 * (w & 3) + (lane >> 2);
    const unsigned ksrc_off = (unsigned)(kkey * PPITCH + C_K + kch * 8) * 2u, vsrc_off = (unsigned)(vkey * PPITCH + C_V + (w >> 2) * 32 + (lane & 3) * 8) * 2u;
    const unsigned lds0 = (unsigned)(uintptr_t)lds;
#define MOBA_GLDS(gsrc_, dst_) do { unsigned keep_; asm volatile("s_mov_b32 %0, m0\n\ts_mov_b32 m0, %2\n\ts_nop 0\n\tglobal_load_lds_dwordx4 %1, off\n\ts_mov_b32 m0, %0" : "=&s"(keep_) : "v"(gsrc_), "s"(dst_) : "memory"); } while (0)
#define MOBA_DMA(jj_, kt_, sl_) do { const char* tb_ = kvh + (size_t)((jj_) * MBLK + (kt_) * 64) * (PPITCH * 2); \
        const unsigned kd_ = (unsigned)__builtin_amdgcn_readfirstlane(lds0 + L_RING + (sl_) * SLOTB + w * 1024), vd_ = (unsigned)__builtin_amdgcn_readfirstlane(lds0 + L_RING + (sl_) * SLOTB + 8192 + w * 1024); \
        MOBA_GLDS(tb_ + ksrc_off, kd_); MOBA_GLDS(tb_ + vsrc_off, vd_); } while (0)
    const int koff = r32 * 128, ksw = (r32 >> 1) & 7;
    const int voff = (4 * hi + ((lane & 15) >> 2)) * 64 + ((lane >> 4) & 1) * 32 + (lane & 3) * 8;
    LAS unsigned char* ost = lds + L_OST + w * 4096;
    LAS int* prow_s = (LAS int*)(wsf + 32);
    bool active = false, near = false, stored_prev = false; int dq = 0, kt_max = 3, jcur = 0, jnext = 0;
    bool n_active = false, n_near = false; int n_dq = 0, n_prow = -1, n_ktmax = 3;
    bf16x8 qf[4]; float mhat = 0.f, l = 0.f, c0 = 0.f, bfar = 0.f; f32x16 o[2]; bool first = true;
    o[0] = f32x16{}; o[1] = f32x16{};
    const unsigned qst0 = lds0 + L_QST + w * 4096; const LAS unsigned char* qst = lds + L_QST + w * 4096;
    bf16* trash = (bf16*)(F.part + 16 * MiB) + (size_t)(blockIdx.x * NWAVES + w) * 2048;
    const char* qbase = (const char*)(F.PROJ + (tokb + (size_t)lo * MBLK) * PPITCH + C_Q + h * 64) + (lane & 7) * 16;
    const int prow_base = (int)(((tokb + (size_t)lo * MBLK) * NH + h) * 4);
#define MOBA_PREP(R_) do { const unsigned re = (unsigned)__builtin_amdgcn_readfirstlane((int)rtab[(R_)]); const int j = re & 31; const bool own = (re >> 31) != 0; int qu, slot, base = 0, lim = 0; bool vld; \
        jnext = j; \
        if (own) { n_active = true; vld = true; qu = (j - lo) * MBLK + w * 32 + r32; slot = 3; n_near = true; n_ktmax = w >> 1; n_dq = w * 32 + r32; } \
        else { const int t0 = (re >> 8) & 255, nt = (re >> 16) & 255; const int tile = t0 + w; n_active = tile < nt; \
            const int cj = __builtin_amdgcn_readfirstlane(cnt[j]), pos = tile * 32 + r32; vld = n_active && pos < cj; base = __builtin_amdgcn_readfirstlane(off[j]) + (n_active ? tile * 32 : 0); lim = n_active ? cj - tile * 32 : 1; \
            const unsigned le = list[base + (vld ? r32 : 0)]; qu = le & 4095; slot = le >> 12; \
            const int i = lo + (qu >> 8); n_ktmax = 3; n_dq = (i - j) * MBLK + (qu & 255); n_near = __any((j + 5 > i) && n_active) != 0; } \
        n_prow = vld ? prow_base + qu * (NH * 4) + slot : -1; \
        _Pragma("unroll") for (int n_ = 0; n_ < 4; ++n_) { const int rho = 8 * n_ + (lane >> 3); int qr; \
            if (own) qr = (j - lo) * MBLK + w * 32 + rho; else qr = list[base + (rho < lim ? rho : 0)] & 4095; \
            const char* src = qbase + (unsigned)qr * (unsigned)(PPITCH * 2); \
            const unsigned qd_ = (unsigned)__builtin_amdgcn_readfirstlane(qst0 + n_ * 1024); MOBA_GLDS(src, qd_); } } while (0)
    MOBA_PREP(0); jcur = jnext;
    MOBA_DMA(jcur, 0, 0); MOBA_DMA(jcur, 1, 1);
    asm volatile("s_waitcnt vmcnt(0)" ::: "memory");
#pragma unroll 1
    for (int T = 0; T < NT; ++T) {
        const int kt = T & 3;
        if (kt == 2) asm volatile("s_waitcnt vmcnt(2) lgkmcnt(0)" ::: "memory");
        else if (kt == 3) asm volatile("s_waitcnt vmcnt(6) lgkmcnt(0)" ::: "memory");
        else if (__builtin_amdgcn_readfirstlane((int)stored_prev)) asm volatile("s_waitcnt vmcnt(7) lgkmcnt(0)" ::: "memory");
        else asm volatile("s_waitcnt vmcnt(2) lgkmcnt(0)" ::: "memory");
        __builtin_amdgcn_s_barrier(); asm volatile("" ::: "memory");
        if (kt == 2) { const int Rn = (T >> 2) + 1; MOBA_PREP(Rn < nrounds ? Rn : nrounds - 1); }
        { const int sl = (T + 2) % NSLOT; if (kt < 2) MOBA_DMA(jcur, kt + 2, sl); else MOBA_DMA(jnext, kt - 2, sl); }
        if (kt == 0) {
            active = n_active; near = n_near; dq = n_dq; kt_max = n_ktmax;
            if (hi == 0) prow_s[r32] = n_prow;
#pragma unroll
            for (int d0 = 0; d0 < 4; ++d0) qf[d0] = *(const LAS bf16x8*)(qst + r32 * 128 + (2 * d0 + hi) * 16);
            bfar = near ? 0.f : tb[TXMAX - 1023]; mhat = 0.f; l = 0.f; c0 = bfar; first = true; o[0] = f32x16{}; o[1] = f32x16{};
        }
        if (kt == 3) jcur = jnext;
        if (kt == 1) stored_prev = false;
        if (active && kt <= kt_max) {
            const LAS unsigned char* buf = lds + L_RING + (T % NSLOT) * SLOTB;
            bf16x8 ka[4], kb[4];
#pragma unroll
            for (int d0 = 0; d0 < 4; ++d0) { const int co = ((2 * d0 + hi) ^ ksw) * 16; ka[d0] = *(const LAS bf16x8*)(buf + koff + co); kb[d0] = *(const LAS bf16x8*)(buf + 4096 + koff + co); }
            f32x16 p0, p1;
#pragma unroll
            for (int r = 0; r < 16; ++r) { p0[r] = c0; p1[r] = c0; }
            __builtin_amdgcn_s_setprio(1);
#pragma unroll
            for (int d0 = 0; d0 < 4; ++d0) { p0 = __builtin_amdgcn_mfma_f32_32x32x16_bf16(ka[d0], qf[d0], p0, 0, 0, 0); p1 = __builtin_amdgcn_mfma_f32_32x32x16_bf16(kb[d0], qf[d0], p1, 0, 0, 0); }
            __builtin_amdgcn_s_setprio(0);
            s16x4 va[8], vc[8];
#pragma unroll
            for (int n = 0; n < 4; ++n) { const LAS unsigned char* vb = buf + 8192 + n * 1024 + voff; va[n] = vtr(vb); vc[n] = vtr(vb + 512); }
            __builtin_amdgcn_sched_barrier(0);
            if (near) {
                int D0 = dq - 64 * kt - 4 * hi; D0 = D0 > 1279 ? 1279 : D0;
                const int x0 = TXMAX - D0, sft = x0 & 1;
                const LAS float* tp = tb + sft * TLEN + (x0 - sft);
#pragma unroll
                for (int g4 = 0; g4 < 4; ++g4) {
                    const f32x2 a0 = *(const LAS f32x2*)(tp + 8 * g4), a1 = *(const LAS f32x2*)(tp + 8 * g4 + 2), b0 = *(const LAS f32x2*)(tp + 32 + 8 * g4), b1 = *(const LAS f32x2*)(tp + 32 + 8 * g4 + 2);
                    p0[4 * g4] += a0.x; p0[4 * g4 + 1] += a0.y; p0[4 * g4 + 2] += a1.x; p0[4 * g4 + 3] += a1.y;
                    p1[4 * g4] += b0.x; p1[4 * g4 + 1] += b0.y; p1[4 * g4 + 2] += b1.x; p1[4 * g4 + 3] += b1.y; }
            }
            float rm;
            { float ma = __builtin_fmaxf(p0[0], p1[0]), mb = __builtin_fmaxf(p0[1], p1[1]);
#pragma unroll
              for (int r = 2; r < 16; r += 2) { asm("v_max3_f32 %0, %1, %2, %3" : "=v"(ma) : "v"(ma), "v"(p0[r]), "v"(p1[r])); asm("v_max3_f32 %0, %1, %2, %3" : "=v"(mb) : "v"(mb), "v"(p0[r + 1]), "v"(p1[r + 1])); }
              rm = __builtin_fmaxf(ma, mb); }
            rm = fmaxf(rm, __shfl_xor(rm, 32));
            if (first || __any(rm > 8.0f)) {
                const float dl = first ? rm : fmaxf(rm, 0.f);
                mhat += dl;
#pragma unroll
                for (int r = 0; r < 16; ++r) { p0[r] -= dl; p1[r] -= dl; }
                const float f = __builtin_amdgcn_exp2f(-dl); l *= f;
                if (!first) {
                    if (hi == 0) wsf[r32] = f;
#pragma unroll
                    for (int r = 0; r < 16; ++r) { const float fr = wsf[crow(r, hi)]; o[0][r] *= fr; o[1][r] *= fr; }
                }
                c0 = bfar - mhat; first = false;
            }
            float sacc = 0.f;
#pragma unroll
            for (int r = 0; r < 16; ++r) { p0[r] = __builtin_amdgcn_exp2f(p0[r]); p1[r] = __builtin_amdgcn_exp2f(p1[r]); sacc += p0[r] + p1[r]; }
            l += sacc;
            v4u pw[4];
            pw[0].x = cvtpk(p0[0], p0[1]); pw[0].y = cvtpk(p0[2], p0[3]); pw[0].z = cvtpk(p0[4], p0[5]); pw[0].w = cvtpk(p0[6], p0[7]);
            pw[1].x = cvtpk(p0[8], p0[9]); pw[1].y = cvtpk(p0[10], p0[11]); pw[1].z = cvtpk(p0[12], p0[13]); pw[1].w = cvtpk(p0[14], p0[15]);
            pw[2].x = cvtpk(p1[0], p1[1]); pw[2].y = cvtpk(p1[2], p1[3]); pw[2].z = cvtpk(p1[4], p1[5]); pw[2].w = cvtpk(p1[6], p1[7]);
            pw[3].x = cvtpk(p1[8], p1[9]); pw[3].y = cvtpk(p1[10], p1[11]); pw[3].z = cvtpk(p1[12], p1[13]); pw[3].w = cvtpk(p1[14], p1[15]);
#pragma unroll
            for (int n = 4; n < 8; ++n) { const LAS unsigned char* vb = buf + 8192 + n * 1024 + voff; va[n] = vtr(vb); vc[n] = vtr(vb + 512); }
            __builtin_amdgcn_s_setprio(1);
#pragma unroll
            for (int d0 = 0; d0 < 2; ++d0)
#pragma unroll
                for (int s = 0; s < 4; ++s) { const int n = d0 * 4 + s;
                    const bf16x8 vf = (bf16x8){va[n][0], va[n][1], va[n][2], va[n][3], vc[n][0], vc[n][1], vc[n][2], vc[n][3]};
                    o[d0] = __builtin_amdgcn_mfma_f32_32x32x16_bf16(__builtin_bit_cast(bf16x8, pw[s]), vf, o[d0], 0, 0, 0); }
            __builtin_amdgcn_s_setprio(0);
        }
        if (kt == 3 && active) {
            l += __shfl_xor(l, 32);
            LAS unsigned* so = (LAS unsigned*)ost;
#pragma unroll
            for (int r = 0; r < 16; ++r) so[crow(r, hi) * 32 + r32] = cvtpk(o[0][r], o[1][r]);
#pragma unroll
            for (int it = 0; it < 4; ++it) { const int row = it * 8 + (lane >> 3), ch = lane & 7;
                const v4u v = *(const LAS v4u*)(ost + row * 128 + ch * 16);
                const int pr = prow_s[row];
                bf16* dst = pr >= 0 ? PO + (size_t)pr * 64 + ch * 8 : trash + row * 64 + ch * 8;
                *(GAS v4u*)dst = v; }
            { const int pr = prow_s[r32]; float* pl = (hi == 0 && pr >= 0) ? PL + (size_t)pr * 2 : (float*)trash + lane * 2; *(GAS f32x2*)pl = (f32x2){mhat, l}; }
            stored_prev = true;
        }
    }
#undef MOBA_DMA
#undef MOBA_GLDS
#undef MOBA_PREP
    VM_WAIT(); LDS_WAIT(); __syncthreads();
#pragma unroll 1
    for (int id0 = tid; id0 < nq * 8; id0 += 2048) {
        f32x4 La[4], Lb[4]; v4u pv[4][4]; size_t tokv[4]; int nselv[4];
#pragma unroll
        for (int u = 0; u < 4; ++u) { const int id = id0 + 512 * u, qu = id >> 3; const int i = lo + (qu >> 8); nselv[u] = i < 3 ? i : 3;
            tokv[u] = tokb + (size_t)lo * MBLK + qu; const size_t pr = (tokv[u] * NH + h) * 4;
            La[u] = __builtin_nontemporal_load((const f32x4*)(PL + pr * 2)); Lb[u] = __builtin_nontemporal_load((const f32x4*)(PL + pr * 2 + 4));
#pragma unroll
            for (int s = 0; s < 4; ++s) pv[u][s] = __builtin_nontemporal_load((const v4u*)(PO + (pr + s) * 64 + (id & 7) * 8)); }
#pragma unroll
        for (int u = 0; u < 4; ++u) { const int id = id0 + 512 * u, ch = id & 7; const int nsel = nselv[u];
            const float Ms[4] = {La[u].x, La[u].z, Lb[u].x, Lb[u].z}, Ls[4] = {La[u].y, La[u].w, Lb[u].y, Lb[u].w}; float Mm = Ms[3];
#pragma unroll
            for (int s = 0; s < 3; ++s) if (s < nsel) Mm = fmaxf(Mm, Ms[s]);
            float acc[8]; float W = 0.f;
#pragma unroll
            for (int e = 0; e < 8; ++e) acc[e] = 0.f;
#pragma unroll
            for (int s = 0; s < 4; ++s) { if (s == 3 || s < nsel) { const float wgt = __builtin_amdgcn_exp2f(Ms[s] - Mm); W += wgt * Ls[s]; const v4u v = pv[u][s];
                acc[0] += wgt * bflo(v.x); acc[1] += wgt * bflo(v.y); acc[2] += wgt * bflo(v.z); acc[3] += wgt * bflo(v.w);
                acc[4] += wgt * bfhi(v.x); acc[5] += wgt * bfhi(v.y); acc[6] += wgt * bfhi(v.z); acc[7] += wgt * bfhi(v.w); } }
            const float rw = 1.0f / W; v2u oa, ob;
            oa.x = pk2(acc[0] * rw, acc[1] * rw); oa.y = pk2(acc[2] * rw, acc[3] * rw); ob.x = pk2(acc[4] * rw, acc[5] * rw); ob.y = pk2(acc[6] * rw, acc[7] * rw);
            bf16* orow = F.U + tokv[u] * (CW + AW) + CW + h * 64 + ch * 4;
            *(GAS v2u*)orow = oa; *(GAS v2u*)(orow + 32) = ob; }
    }
    __syncthreads();
}
__device__ __forceinline__ void phase(Frame& F) {
    const int nun = (BATCH * NH * 4 - (int)blockIdx.x + F.G - 1) / F.G;
#pragma unroll 1
    for (int n = 0; n < nun; ++n) {
        const int id = blockIdx.x + n * F.G; const int x = id & 7, k = (id >> 3) & 31; const int bh = 8 * x + (k >> 2), g = k & 3;
        const int lo = g == 0 ? 0 : (g == 1 ? 10 : (g == 2 ? 18 : 24)), hb = g == 0 ? 10 : (g == 1 ? 18 : (g == 2 ? 24 : 32));
        unit(F, bh >> 3, bh & 7, lo, hb);
    }
}
}

struct Args { const float* in[13]; float* out; unsigned char* ws; int ph_lo, ph_hi; };
__global__ void __launch_bounds__(NWAVES * 64, 2) fwd_kernel(Args args) {
    extern __shared__ __attribute__((aligned(16))) unsigned char lds[];
    Frame F;
    F.lds = (LAS unsigned char*)lds;
    F.tid = threadIdx.x; F.lane = F.tid & 63; F.wave = __builtin_amdgcn_readfirstlane(F.tid >> 6);
    F.G = gridDim.x; { const int bx = blockIdx.x; F.vcu = (F.G % 8 == 0) ? (bx % 8) * (F.G / 8) + bx / 8 : bx; }
    unsigned char* ws = args.ws;
    F.x = args.in[0]; F.g_pre1 = args.in[1]; F.w_in = args.in[2]; F.conv_w = args.in[3]; F.w_cout = args.in[4]; F.w_aout = args.in[5]; F.rel_bias = args.in[6];
    F.w_o = args.in[7]; F.g_post1 = args.in[8]; F.g_pre2 = args.in[9]; F.w1 = args.in[10]; F.w2 = args.in[11]; F.g_post2 = args.in[12]; F.out = args.out;
    F.Win_t = (bf16*)(ws + WS_WIN); F.Wc_t = (bf16*)(ws + WS_WC); F.Wa_t = (bf16*)(ws + WS_WA); F.Wo_t = (bf16*)(ws + WS_WO); F.W1_t = (bf16*)(ws + WS_W1); F.W2_t = (bf16*)(ws + WS_W2);
    F.XN = (bf16*)(ws + WS_XN); F.PROJ = (bf16*)(ws + WS_PROJ); F.U = (bf16*)(ws + WS_U); F.O = (bf16*)(ws + WS_O); F.M1 = (bf16*)args.out; F.MIX = (bf16*)(ws + WS_PROJ);
    F.HB = (bf16*)(ws + WS_H); F.FB = (bf16*)(ws + WS_PROJ); F.T5 = (float*)(ws + WS_T5); F.KM = (float*)(ws + WS_KM); F.part = ws + WS_PART; F.X1B = (bf16*)(ws + WS_U); F.convctr = (unsigned*)(ws + WS_CTL) + 1024; F.RS2 = (float*)(ws + WS_PART + 40 * MiB); F.RS1 = (float*)(ws + WS_PART + 41 * MiB); F.GT = (bf16*)(ws + WS_PROJ + 384 * MiB);
    const int lo = args.ph_lo, hi = args.ph_hi;
    { volatile LAS unsigned* st = (volatile LAS unsigned*)(F.lds + LDS_BARST); if (F.tid == 0) { st[0] = 0u; st[1] = 0u; } }
    __syncthreads();
    XcdBarrier bar = xcd_barrier_post((unsigned*)(ws + WS_CTL) + CW_BAR, (volatile LAS unsigned*)(F.lds + LDS_BARST));
    unsigned* gmask = (unsigned*)(ws + WS_CTL) + 2048;
    if (F.tid == 0) (void)__hip_atomic_fetch_or(gmask + 64 * (blockIdx.x & 7), 1u << bar.x, __ATOMIC_RELAXED, __HIP_MEMORY_SCOPE_AGENT);
    bool local = false;
#ifndef PH_MASK
#define PH_MASK 0x3ff
#endif
#define IN(k) ((((PH_MASK) >> (k)) & 1) && lo <= (k) && (k) < hi)
#define GRID_BAR(k) do { if (IN(k) && (IN((k) + 1) || ((k) == 1 && IN(3)))) { xcd_barrier(bar); } } while (0)
#define LOCAL_BAR(k) do { if (IN(k) && (IN((k) + 1) || ((k) == 1 && IN(3)))) { if (local) xcd_barrier_local(bar); else xcd_barrier(bar); } } while (0)
#ifndef REP_MASK
#define REP_MASK 0
#endif
#define RUNPH(k, ...) do { if (IN(k)) { __VA_ARGS__; if ((REP_MASK >> (k)) & 1) { xcd_barrier(bar); __VA_ARGS__; } } } while (0)
    RUNPH(0, p0_prologue(F)); GRID_BAR(0);
    if (lo == 0 && hi >= 10) {
        volatile LAS unsigned* st = (volatile LAS unsigned*)(F.lds + LDS_BARST);
        if (F.tid == 0) { unsigned ok = (gridDim.x == 256u) ? 1u : 0u, un = 0u;
#pragma unroll
            for (int k = 0; k < 8; ++k) { const unsigned m = xb_ld(gmask + 64 * k); ok &= (m != 0u && (m & (m - 1u)) == 0u) ? 1u : 0u; un |= m; }
            ok &= (__builtin_popcount(un) == 8) ? 1u : 0u; ok &= (st[0] == 32u) ? 1u : 0u;
            st[2] = ok; }
        __syncthreads();
        local = __builtin_amdgcn_readfirstlane((int)st[2]) != 0;
    }
    RUNPH(1, { pg8::Gemm g{F.XN, F.Win_t, M, NIN, DM}; pg8::StaticOrder S; S.init(M, NIN, F.G, (int)blockIdx.x);
        pg8::EpiB<pg8::EM_PROJ> E{F.PROJ, PPITCH, (const pg8::bf16_t*)F.GT, 0, 0, 0, F.KM, F.RS1};
        pg8::gemm_phase<pg8::EpiB<pg8::EM_PROJ>, pg8::StaticOrder, false, true>(F.lds, g, S, E); }); LOCAL_BAR(1);
    RUNPH(3, { moba2::phase(F); conv_tail(F); }); GRID_BAR(3);
    RUNPH(4, { pg8::Gemm g{F.U, F.Wc_t, M, DM, CW + AW}; pg8::StaticOrder S; S.init(M, DM, F.G, (int)blockIdx.x);
        pg8::EpiB<pg8::EM_GATE2> E{F.M1, DM, (const pg8::bf16_t*)F.GT, 0, 0, 0};
        pg8::gemm_phase<pg8::EpiB<pg8::EM_GATE2>, pg8::StaticOrder, true, true>(F.lds, g, S, E); }); LOCAL_BAR(4);
    RUNPH(5, { pg8::Gemm g{F.M1, F.Wo_t, M, DM, DM}; pg8::StaticOrder S; S.init(M, DM, F.G, (int)blockIdx.x);
        pg8::EpiB<pg8::EM_PLAIN> E{F.MIX, DM, nullptr, 0, 0};
        pg8::gemm_phase<pg8::EpiB<pg8::EM_PLAIN>, pg8::StaticOrder, true, true>(F.lds, g, S, E); }); GRID_BAR(5);
    RUNPH(6, p6_norms(F)); LOCAL_BAR(6);
    RUNPH(7, { pg8::Gemm g{F.X1B, F.W1_t, M, FF, DM}; pg8::StaticOrder S; S.init(M, FF, F.G, (int)blockIdx.x);
        pg8::EpiB<pg8::EM_RELU2> E{F.HB, FF, nullptr, 0, 0, 0, nullptr, F.RS2, FF / 256};
        pg8::gemm_phase<pg8::EpiB<pg8::EM_RELU2>, pg8::StaticOrder, false, true>(F.lds, g, S, E); }); LOCAL_BAR(7);
    RUNPH(8, { pg8::Gemm g{F.HB, F.W2_t, M, DM, FF}; pg8::StaticOrder S; S.init(M, DM, F.G, (int)blockIdx.x);
        pg8::EpiB<pg8::EM_PLAIN> E{F.FB, DM, nullptr, 0, 0};
        pg8::gemm_phase<pg8::EpiB<pg8::EM_PLAIN>, pg8::StaticOrder, true, true, true>(F.lds, g, S, E); }); LOCAL_BAR(8);
    if (IN(9)) { p9_final(F); }
#undef IN
#undef GRID_BAR
#undef LOCAL_BAR
}

#ifndef MK_N_LAUNCHES
#define MK_N_LAUNCHES 1
#endif
extern "C" void kernel_launch(void* const* d_in, const int* in_sizes, int n_in, void* d_out, int out_size, void* d_ws, size_t ws_size, hipStream_t stream) {
    static int grid = 0;
    if (grid == 0) {
        if (n_in != 13 || in_sizes[0] != M * DM || out_size != M * DM || ws_size < WS_END) { fprintf(stderr, "kernel_launch: unexpected shapes (n_in %d, in0 %d, out %d, ws %zu)\n", n_in, n_in > 0 ? in_sizes[0] : -1, out_size, ws_size); grid = -1; return; }
        int dev = 0, cus = 0, per_cu = 0;
        if (hipGetDevice(&dev) != hipSuccess || hipDeviceGetAttribute(&cus, hipDeviceAttributeMultiprocessorCount, dev) != hipSuccess) { grid = -1; return; }
        if (hipFuncSetAttribute((const void*)fwd_kernel, hipFuncAttributeMaxDynamicSharedMemorySize, LDS_BYTES) != hipSuccess) { fprintf(stderr, "kernel_launch: hipFuncSetAttribute failed\n"); grid = -1; return; }
        if (hipOccupancyMaxActiveBlocksPerMultiprocessor(&per_cu, (const void*)fwd_kernel, NWAVES * 64, LDS_BYTES) != hipSuccess || per_cu < 1) { fprintf(stderr, "kernel_launch: occupancy query says %d blocks per CU\n", per_cu); (void)hipGetLastError(); per_cu = 1; }
        if (per_cu > 1) per_cu = 1;
        grid = cus * per_cu;
    }
    if (grid < 0) return;
    if (hipMemsetAsync((char*)d_ws + WS_CTL, 0, CTL_ZERO_BYTES, stream) != hipSuccess) { fprintf(stderr, "kernel_launch: hipMemsetAsync failed\n"); return; }
    Args a{};
    for (int i = 0; i < 13; ++i) a.in[i] = (const float*)d_in[i];
    a.out = (float*)d_out; a.ws = (unsigned char*)d_ws;
#if MK_N_LAUNCHES == 1
    a.ph_lo = 0; a.ph_hi = N_PHASES;
    void* kargs[] = {&a};
    hipError_t e = hipLaunchCooperativeKernel((const void*)fwd_kernel, dim3(grid), dim3(NWAVES * 64), kargs, LDS_BYTES, stream);
    if (e != hipSuccess) fprintf(stderr, "kernel_launch: cooperative launch failed: %s (grid %d)\n", hipGetErrorString(e), grid);
#else
    for (int p = 0; p < N_PHASES; ++p) { a.ph_lo = p; a.ph_hi = p + 1;
        void* kargs[] = {&a};
        hipError_t e = hipLaunchCooperativeKernel((const void*)fwd_kernel, dim3(grid), dim3(NWAVES * 64), kargs, LDS_BYTES, stream);
        if (e != hipSuccess) { fprintf(stderr, "kernel_launch: launch %d failed: %s\n", p, hipGetErrorString(e)); break; } }
#endif
}
```

```cpp
#include <hip/hip_runtime.h>
#include <cstdio>
#include <cstdint>
namespace pg8 {
#define PG8_LAS __attribute__((address_space(3)))
typedef unsigned short bf16_t;
typedef short bf16x8 __attribute__((ext_vector_type(8)));
typedef float f32x4 __attribute__((ext_vector_type(4)));
typedef unsigned u32x4 __attribute__((ext_vector_type(4)));
constexpr int BM = 256, BK = 64, HALF = 128, HTB = HALF * BK * 2  , STAGE_BYTES = 8 * HTB, NXCD = 8, WGM = 8;

__host__ __device__ __forceinline__ int lds_byte(int r, int c) { const int st = (r >> 4) * 2 + (c >> 5), rr = r & 15, cc = c & 31, ob = rr * 64 + cc * 2; return st * 1024 + (ob ^ (((ob >> 9) & 1) << 5)); }
__host__ __device__ __forceinline__ void stage_rc(int b, int& R, int& C) { const int st = b / 1024, sb = b % 1024, swz = sb ^ (((sb >> 9) & 1) << 5); R = (st >> 1) * 16 + swz / 64; C = (st & 1) * 32 + (swz % 64) / 2; }
__host__ __device__ __forceinline__ int perm32(int rho) { const int n = rho >> 4, i = rho & 15; return 8 * (i >> 2) + 4 * n + (i & 3); }

struct Unit { int pm, pn; };
struct Gemm { const bf16_t* A; const bf16_t* Bt; int M, N, K; };

struct StaticOrder {
    int nM, nN, nwg, G, c;
    __host__ __device__ void init(int M, int N, int G_, int c_) { nM = M / BM; nN = N / BM; nwg = nM * nN; G = G_; c = c_; }
    __host__ __device__ bool next(int i, Unit& u) const {
        const long L = (long)i * G + c; if (L >= nwg) return false;
        int wgid = (int)L; { const int q = nwg / NXCD, r = nwg % NXCD, xcd = wgid % NXCD, off = wgid / NXCD; wgid = (xcd < r ? xcd * (q + 1) : r * (q + 1) + (xcd - r) * q) + off; }
        const int nig = WGM * nN, gid = wgid / nig, fm = gid * WGM, gsz = (nM - fm) < WGM ? (nM - fm) : WGM;
        u.pm = fm + ((wgid % nig) % gsz); u.pn = (wgid % nig) / gsz; return true;
    }
    __device__ __forceinline__ void a_ready(const Unit&) const {}
    __device__ __forceinline__ void done(const Unit&) const {}
};

__device__ __forceinline__ unsigned cvt_pk_bf16(float lo, float hi) { unsigned r; asm volatile("v_cvt_pk_bf16_f32 %0, %1, %2" : "=v"(r) : "v"(lo), "v"(hi)); return r; }
typedef float f32x2 __attribute__((ext_vector_type(2)));
__device__ __forceinline__ float bf_lo(unsigned w) { return __uint_as_float(w << 16); }
__device__ __forceinline__ float bf_hi(unsigned w) { return __uint_as_float(w & 0xffff0000u); }
constexpr float QSCALE = 0.125f * 1.4426950408889634f;
enum { EM_PROJ = 0, EM_GATE = 1, EM_GATEADD = 2, EM_PLAIN = 3, EM_RELU2 = 4, EM_GATE2 = 5 };
template <int MODE> struct EpiB {
    static constexpr bool PERM = true, AFTER_DRAIN = false, HAS_MID = (MODE == EM_GATE2), ROWS = (MODE == EM_PROJ || MODE == EM_RELU2), PREFETCH = (MODE == EM_GATE2);
    bf16_t* O; int ldc; const bf16_t* G; int ldg; int goff; int goff2 = 0; float* KMp = nullptr; const float* rowscale = nullptr; int otile = 0;
    __device__ __forceinline__ void operator()(f32x4 (&acc)[2][2][4][2], const Unit& u, int wr, int wc, int fr, int fq, const PG8_LAS float* rsl = nullptr) const {
        const int row0 = u.pm * BM + wr * 64 + fr, col0 = u.pn * BM + wc * 32 + 8 * fq;
        float rsq[2][4];
        if (MODE == EM_PROJ) {
#pragma unroll
            for (int ai = 0; ai < 2; ++ai)
#pragma unroll
                for (int m = 0; m < 4; ++m) { const float r_ = rsl[wr * 64 + fr + ai * HALF + m * 16];
#pragma unroll
                    for (int bj = 0; bj < 2; ++bj) { acc[ai][bj][m][0] = acc[ai][bj][m][0] * r_; acc[ai][bj][m][1] = acc[ai][bj][m][1] * r_; } } }
        if (MODE == EM_RELU2) {
#pragma unroll
            for (int ai = 0; ai < 2; ++ai)
#pragma unroll
                for (int m = 0; m < 4; ++m) { const float r_ = rsl[wr * 64 + fr + ai * HALF + m * 16]; rsq[ai][m] = r_ * r_; } }
        u32x4 gpre[2][4][2];
        if (MODE == EM_GATE2) {
#pragma unroll
            for (int ai = 0; ai < 2; ++ai)
#pragma unroll
                for (int m = 0; m < 4; ++m)
#pragma unroll
                    for (int bj = 0; bj < 2; ++bj) gpre[ai][m][bj] = *(const u32x4*)(G + (((((((size_t)u.pm * 8 + (2 * u.pn + bj)) * 2 + 1) * 2 + ai) * 4 + m) * 8 + (wr * 4 + wc)) * 64 + (fq * 16 + fr)) * 8); }
        int pmode = 0; if (MODE == EM_PROJ) { pmode = (u.pn >= 12) ? 2 : ((u.pn == 6 || u.pn == 7) ? 1 : (u.pn < 4 ? 3 : 0)); }
        if (MODE == EM_PROJ) { if (u.pn == 8 || u.pn == 9) {
            float cs[2][2][4];
#pragma unroll
            for (int bj = 0; bj < 2; ++bj)
#pragma unroll
                for (int n = 0; n < 2; ++n)
#pragma unroll
                    for (int e = 0; e < 4; ++e) { float t = 0.f;
#pragma unroll
                        for (int ai = 0; ai < 2; ++ai)
#pragma unroll
                            for (int m = 0; m < 4; ++m) t += acc[ai][bj][m][n][e];
                        t += __shfl_xor(t, 1); t += __shfl_xor(t, 2); t += __shfl_xor(t, 4); t += __shfl_xor(t, 8); cs[bj][n][e] = t; }
            if (fr == 0) { float* kp = KMp + (size_t)u.pm * 512 + (u.pn - 8) * BM + wc * 32 + 8 * fq;
#pragma unroll
                for (int bj = 0; bj < 2; ++bj)
#pragma unroll
                    for (int n = 0; n < 2; ++n)
#pragma unroll
                        for (int e = 0; e < 4; ++e) atomicAdd(kp + bj * HALF + 4 * n + e, cs[bj][n][e]); }
        } }
#pragma unroll
        for (int ai = 0; ai < 2; ++ai)
#pragma unroll
            for (int m = 0; m < 4; ++m) { const size_t row = (size_t)(row0 + ai * HALF + m * 16);
#pragma unroll
                for (int bj = 0; bj < 2; ++bj) { f32x4 v0 = acc[ai][bj][m][0], v1 = acc[ai][bj][m][1]; const int col = col0 + bj * HALF;
                    if (MODE == EM_PROJ) {
                        if (pmode == 3) { if (bj == 1) continue; v0 = v0 * acc[ai][1][m][0]; v1 = v1 * acc[ai][1][m][1]; }
                        if (pmode == 1) { v0 = v0 * QSCALE; v1 = v1 * QSCALE; }
                        else if (pmode == 2) {
                            const f32x4 a0 = acc[ai][1][m][0], a1 = acc[ai][1][m][1];
#pragma unroll
                            for (int e = 0; e < 4; ++e) {
                                const float ea0 = 1.0f + __builtin_amdgcn_exp2f(-1.4426950408889634f * a0[e]), ea1 = 1.0f + __builtin_amdgcn_exp2f(-1.4426950408889634f * a1[e]);
                                if (bj == 0) { v0[e] = ea0 * __builtin_amdgcn_rcpf(1.0f + __builtin_amdgcn_exp2f(-1.4426950408889634f * v0[e])); v1[e] = ea1 * __builtin_amdgcn_rcpf(1.0f + __builtin_amdgcn_exp2f(-1.4426950408889634f * v1[e])); }
                                else { v0[e] = __builtin_amdgcn_rcpf(ea0); v1[e] = __builtin_amdgcn_rcpf(ea1); } }
                        }
                    }
                    if (MODE == EM_RELU2) {
#pragma unroll
                        for (int e = 0; e < 4; ++e) { float a, b; asm("v_max_f32 %0, 0, %1" : "=v"(a) : "v"(v0[e])); asm("v_max_f32 %0, 0, %1" : "=v"(b) : "v"(v1[e])); v0[e] = a * a * rsq[ai][m]; v1[e] = b * b * rsq[ai][m]; }
                    }
                    if (MODE == EM_GATE || MODE == EM_GATEADD || MODE == EM_GATE2) {
                        const u32x4 g = (MODE == EM_GATE2) ? gpre[ai][m][bj] : *(const u32x4*)(G + row * (size_t)ldg + (goff + col));
                        v0[0] *= bf_lo(g.x); v0[1] *= bf_hi(g.x); v0[2] *= bf_lo(g.y); v0[3] *= bf_hi(g.y);
                        v1[0] *= bf_lo(g.z); v1[1] *= bf_hi(g.z); v1[2] *= bf_lo(g.w); v1[3] *= bf_hi(g.w);
                        if (MODE == EM_GATEADD) { const u32x4 o = *(const u32x4*)(O + row * (size_t)ldc + col);
                            v0[0] += bf_lo(o.x); v0[1] += bf_hi(o.x); v0[2] += bf_lo(o.y); v0[3] += bf_hi(o.y);
                            v1[0] += bf_lo(o.z); v1[1] += bf_hi(o.z); v1[2] += bf_lo(o.w); v1[3] += bf_hi(o.w); }
                    }
                    u32x4 w; w.x = cvt_pk_bf16(v0[0], v0[1]); w.y = cvt_pk_bf16(v0[2], v0[3]); w.z = cvt_pk_bf16(v1[0], v1[1]); w.w = cvt_pk_bf16(v1[2], v1[3]);
                    if (MODE == EM_PROJ && pmode == 2) {
                        const size_t vi = ((((((size_t)u.pm * 8 + (u.pn - 12)) * 2 + bj) * 2 + ai) * 4 + m) * 8 + (wr * 4 + wc)) * 64 + (fq * 16 + fr);
                        *(u32x4*)((bf16_t*)G + vi * 8) = w;
                    } else if (otile > 0) {
                        *(u32x4*)(O + ((size_t)u.pm * otile + u.pn) * 65536 + (size_t)(row - (size_t)u.pm * BM) * 256 + (col - u.pn * BM)) = w;
                    } else
                    *(u32x4*)(O + row * (size_t)ldc + ((MODE == EM_PROJ && pmode == 3) ? (HALF * u.pn + wc * 32 + 8 * fq) : col)) = w; }
                if (MODE == EM_GATE || MODE == EM_GATEADD) asm volatile("" ::: "memory"); }
    }
    __device__ __forceinline__ void prefetch(const Unit& u, int s_, PG8_LAS unsigned char* dump, int wid, int lane) const {
        { s_ &= 31;
          const int kind = s_ >> 4, ai = (s_ >> 3) & 1, m = (s_ >> 1) & 3, bj = s_ & 1;
            const bf16_t* src = G + (((((((size_t)u.pm * 8 + (2 * u.pn + bj)) * 2 + kind) * 2 + ai) * 4 + m) * 8 + wid) * 64 + lane) * 8;
            __builtin_amdgcn_global_load_lds((const unsigned*)src, (PG8_LAS unsigned*)dump, 16, 0, 0); }
    }
    __device__ __forceinline__ void mid(f32x4 (&acc)[2][2][4][2], const Unit& u, int wr, int wc, int fr, int fq) const {
        const bf16_t* gp = G + ((((size_t)u.pm * 8 + 2 * u.pn) * 2 * 2 * 4 * 8 + (wr * 4 + wc)) * 64 + (fq * 16 + fr)) * 8;
#pragma unroll
        for (int ai = 0; ai < 2; ++ai) {
            asm volatile("" : "+v"(gp));
            u32x4 g1[4][2];
#pragma unroll
            for (int m = 0; m < 4; ++m)
#pragma unroll
                for (int bj = 0; bj < 2; ++bj) g1[m][bj] = *(const u32x4*)(gp + ((size_t)bj * (2 * 2 * 4 * 8) + (ai * 4 + m) * 8) * 64 * 8);
#pragma unroll
            for (int m = 0; m < 4; ++m)
#pragma unroll
                for (int bj = 0; bj < 2; ++bj) { const u32x4 g = g1[m][bj];
                    f32x4& v0 = acc[ai][bj][m][0]; f32x4& v1 = acc[ai][bj][m][1];
                    v0[0] *= bf_lo(g.x); v0[1] *= bf_hi(g.x); v0[2] *= bf_lo(g.y); v0[3] *= bf_hi(g.y);
                    v1[0] *= bf_lo(g.z); v1[1] *= bf_hi(g.z); v1[2] *= bf_lo(g.w); v1[3] *= bf_hi(g.w); }
            asm volatile("" ::: "memory"); }
    }
};
template <class Epi, class Sched, bool ALIGN_EPI = false, bool SP2 = false, bool ATILE = false>
__device__ __forceinline__ void gemm_phase(PG8_LAS unsigned char* lds, const Gemm g, const Sched& S, const Epi& E) {
    const int tid = threadIdx.x, wid = __builtin_amdgcn_readfirstlane(tid >> 6), lane = tid & 63, wr = wid >> 2, wc = wid & 3, fr = lane & 15, fq = lane >> 4;
    const int K = g.K, nt = K / BK;
    unsigned voffA[2], voffB[2];
#pragma unroll
    for (int i = 0; i < 2; ++i) { int R, C; stage_rc(tid * 16 + i * 8192, R, C); const int Rb = Epi::PERM ? ((R & ~31) + perm32(R & 31)) : R;
        voffA[i] = (unsigned)(R * (ATILE ? 256 : K) + C) * 2u; voffB[i] = (unsigned)(Rb * K + C) * 2u; }
    const size_t kstep = (size_t)(BK * 2);
    const size_t hstep = (size_t)HALF * K * 2;
    const size_t tstep = 2 * hstep;
    const size_t hstepA = ATILE ? (size_t)HALF * 256 * 2 : hstep;
#define PG8_AK(t_) (ATILE ? ((size_t)((t_) >> 2) * 131072 + (size_t)((t_) & 3) * 128) : (size_t)(t_) * kstep)
    const unsigned ldsw = (unsigned)wid * 1024u;
    const int aoff = lds_byte(wr * 64 + fr, fq * 8), boff = lds_byte(wc * 32 + fr, fq * 8);
#define PG8_SA(b, h) (((b) * 2 + (h)) * HTB)
#define PG8_SB(b, h) ((4 + (b) * 2 + (h)) * HTB)
#define PG8_STAGE(bufoff, gbase, voff) do { _Pragma("unroll") for (int _i = 0; _i < 2; ++_i) \
        __builtin_amdgcn_global_load_lds((const unsigned*)((const char*)(gbase) + (voff)[_i]), (PG8_LAS unsigned*)(lds + (bufoff) + ldsw + _i * 8192), 16, 0, 0); } while (0)
#define PG8_LDA(dst, b, h) do { _Pragma("unroll") for (int m = 0; m < 4; ++m) _Pragma("unroll") for (int k = 0; k < 2; ++k) dst[m][k] = *(const PG8_LAS bf16x8*)(lds + PG8_SA(b, h) + aoff + m * 2048 + k * 1024); } while (0)
#define PG8_LDB(dst, b, h) do { _Pragma("unroll") for (int n = 0; n < 2; ++n) _Pragma("unroll") for (int k = 0; k < 2; ++k) dst[n][k] = *(const PG8_LAS bf16x8*)(lds + PG8_SB(b, h) + boff + n * 2048 + k * 1024); } while (0)
#define PG8_MMA(ai, bj, At, Bt) do { __builtin_amdgcn_s_setprio(1); _Pragma("unroll") for (int m = 0; m < 4; ++m) _Pragma("unroll") for (int n = 0; n < 2; ++n) _Pragma("unroll") for (int k = 0; k < 2; ++k) \
        acc[ai][bj][m][n] = __builtin_amdgcn_mfma_f32_16x16x32_bf16(Bt[n][k], At[m][k], acc[ai][bj][m][n], 0, 0, 0); __builtin_amdgcn_s_setprio(0); } while (0)
#define PG8_WAIT_V(n) asm volatile("s_waitcnt vmcnt(" #n ")" ::: "memory")
#define PG8_WAIT_L(n) asm volatile("s_waitcnt lgkmcnt(" #n ")" ::: "memory")
#define PG8_WAIT_VP do { if constexpr (Epi::PREFETCH) PG8_WAIT_V(10); else PG8_WAIT_V(8); } while (0)
#define PG8_PF(s_) do { if constexpr (Epi::PREFETCH) E.prefetch(cur, (s_), lds + STAGE_BYTES + 4096 + wid * 1024, wid, lane); } while (0)
#define PG8_BAR __builtin_amdgcn_s_barrier()
#define PG8_SCHED __builtin_amdgcn_sched_barrier(0)
    Unit cur, nxt; int ui = 0;
    if (!S.next(0, cur)) return;
    f32x4 acc[2][2][4][2];
#pragma unroll
    for (int a = 0; a < 2; ++a)
#pragma unroll
        for (int b = 0; b < 2; ++b)
#pragma unroll
            for (int m = 0; m < 4; ++m)
#pragma unroll
                for (int n = 0; n < 2; ++n) acc[a][b][m][n] = (f32x4){0.f, 0.f, 0.f, 0.f};
    bf16x8 At[4][2], B0[2][2], B1[2][2];
    const char* cA = (const char*)g.A + (size_t)cur.pm * tstep; const char* cB = (const char*)g.Bt + (size_t)cur.pn * tstep;
    S.a_ready(cur);
    const PG8_LAS float* rsl = nullptr;
#define PG8_ROWS(unit_, par_) do { if constexpr (Epi::ROWS) { const float* gsrc_ = E.rowscale + (size_t)(unit_).pm * BM + (wid & 3) * 64 + lane; \
        __builtin_amdgcn_global_load_lds((const unsigned*)gsrc_, (PG8_LAS unsigned*)(lds + STAGE_BYTES + (par_) * 2048 + (wid >> 2) * 1024 + (wid & 3) * 256), 4, 0, 0); \
        rsl = (const PG8_LAS float*)(lds + STAGE_BYTES + (par_) * 2048); } } while (0)
    PG8_ROWS(cur, 0);
    if constexpr (SP2) {
        PG8_STAGE(PG8_SB(0, 0), cB, voffB); PG8_STAGE(PG8_SB(0, 1), cB + hstep, voffB); PG8_STAGE(PG8_SA(0, 0), cA, voffA); PG8_STAGE(PG8_SA(0, 1), cA + hstepA, voffA);
        if (wr == 1) PG8_BAR;
        PG8_WAIT_V(2); PG8_BAR;
        PG8_STAGE(PG8_SB(1, 0), cB + kstep, voffB); PG8_STAGE(PG8_SA(1, 0), cA + kstep, voffA); PG8_STAGE(PG8_SB(1, 1), cB + hstep + kstep, voffB);
        PG8_WAIT_V(6); PG8_BAR;
    } else {
        PG8_STAGE(PG8_SB(0, 0), cB, voffB); PG8_STAGE(PG8_SA(0, 0), cA, voffA); PG8_STAGE(PG8_SB(0, 1), cB + hstep, voffB); PG8_STAGE(PG8_SA(0, 1), cA + hstepA, voffA);
        if (wr == 1) PG8_BAR;
        PG8_WAIT_V(4); PG8_BAR;
        PG8_STAGE(PG8_SB(1, 0), cB + kstep, voffB); PG8_STAGE(PG8_SA(1, 0), cA + kstep, voffA); PG8_STAGE(PG8_SB(1, 1), cB + hstep + kstep, voffB);
        PG8_WAIT_V(6); PG8_BAR;
    }
    for (;;) {
        const bool has_next = S.next(ui + 1, nxt);
        const char* nA = has_next ? (const char*)g.A + (size_t)nxt.pm * tstep : cA; const char* nB = has_next ? (const char*)g.Bt + (size_t)nxt.pn * tstep : cB;
        for (int t = 0; t < nt; t += 2) {
            const bool last = (t == nt - 2);
            const char* a1 = cA + PG8_AK(t + 1);
            const char* a2 = last ? nA : cA + PG8_AK(t + 2); const char* b2 = last ? nB : cB + (size_t)(t + 2) * kstep;
            const char* a3 = a2 + kstep; const char* b3 = b2 + kstep;
            if (last && has_next) S.a_ready(nxt);
            if constexpr (Epi::HAS_MID) { if (t == nt / 2) E.mid(acc, cur, wr, wc, fr, fq); }
            if constexpr (SP2) {
            PG8_LDB(B0, 0, 0); PG8_LDB(B1, 0, 1); PG8_SCHED; PG8_LDA(At, 0, 0); PG8_STAGE(PG8_SA(1, 1), a1 + hstepA, voffA); PG8_PF(2 * t);
            PG8_WAIT_VP; PG8_WAIT_L(0); PG8_BAR; PG8_MMA(0, 0, At, B0); PG8_MMA(0, 1, At, B1); PG8_BAR; PG8_SCHED;
            PG8_LDA(At, 0, 1); PG8_STAGE(PG8_SB(0, 0), b2, voffB); PG8_STAGE(PG8_SB(0, 1), b2 + hstep, voffB); PG8_STAGE(PG8_SA(0, 0), a2, voffA); PG8_PF(2 * t + 1);
            PG8_WAIT_VP; PG8_WAIT_L(0); PG8_BAR; PG8_MMA(1, 0, At, B0); PG8_MMA(1, 1, At, B1); PG8_BAR; PG8_SCHED;
            PG8_LDB(B0, 1, 0); PG8_LDB(B1, 1, 1); PG8_SCHED; PG8_LDA(At, 1, 0); PG8_STAGE(PG8_SA(0, 1), a2 + hstepA, voffA); PG8_PF(2 * t + 2);
            PG8_WAIT_VP; PG8_WAIT_L(0); PG8_BAR; PG8_MMA(0, 0, At, B0); PG8_MMA(0, 1, At, B1); PG8_BAR; PG8_SCHED;
            PG8_LDA(At, 1, 1); PG8_STAGE(PG8_SB(1, 0), b3, voffB); PG8_STAGE(PG8_SB(1, 1), b3 + hstep, voffB); PG8_STAGE(PG8_SA(1, 0), a3, voffA); PG8_PF(2 * t + 3);
            PG8_WAIT_VP; PG8_WAIT_L(0); PG8_BAR; PG8_MMA(1, 0, At, B0); PG8_MMA(1, 1, At, B1); PG8_BAR; PG8_SCHED;
            } else {
            PG8_LDB(B0, 0, 0); PG8_SCHED; PG8_LDA(At, 0, 0); PG8_STAGE(PG8_SA(1, 1), a1 + hstepA, voffA);
            PG8_WAIT_L(8); PG8_BAR; PG8_WAIT_L(0); PG8_MMA(0, 0, At, B0); PG8_BAR; PG8_SCHED;
            PG8_LDB(B1, 0, 1); PG8_STAGE(PG8_SB(0, 0), b2, voffB);
            PG8_BAR; PG8_WAIT_L(0); PG8_MMA(0, 1, At, B1); PG8_BAR;
            PG8_LDA(At, 0, 1); PG8_STAGE(PG8_SA(0, 0), a2, voffA);
            PG8_BAR; PG8_WAIT_L(0); PG8_MMA(1, 0, At, B0); PG8_BAR; PG8_SCHED;
            PG8_STAGE(PG8_SB(0, 1), b2 + hstep, voffB);
            PG8_WAIT_V(6); PG8_BAR; PG8_MMA(1, 1, At, B1); PG8_BAR;
            PG8_LDB(B0, 1, 0); PG8_SCHED; PG8_LDA(At, 1, 0); PG8_STAGE(PG8_SA(0, 1), a2 + hstepA, voffA);
            PG8_WAIT_L(8); PG8_BAR; PG8_WAIT_L(0); PG8_MMA(0, 0, At, B0); PG8_BAR; PG8_SCHED;
            PG8_LDB(B1, 1, 1); PG8_STAGE(PG8_SB(1, 0), b3, voffB);
            PG8_BAR; PG8_WAIT_L(0); PG8_MMA(0, 1, At, B1); PG8_BAR;
            PG8_LDA(At, 1, 1); PG8_STAGE(PG8_SA(1, 0), a3, voffA);
            PG8_BAR; PG8_WAIT_L(0); PG8_MMA(1, 0, At, B0); PG8_BAR; PG8_SCHED;
            PG8_STAGE(PG8_SB(1, 1), b3 + hstep, voffB);
            PG8_WAIT_V(6); PG8_BAR; PG8_MMA(1, 1, At, B1); PG8_BAR;
            }
        }
        if constexpr (ALIGN_EPI) { if (wr == 0) PG8_BAR; }
        if constexpr (!Epi::AFTER_DRAIN) { if constexpr (Epi::ROWS) E(acc, cur, wr, wc, fr, fq, rsl); else E(acc, cur, wr, wc, fr, fq); S.done(cur); }
        if (!has_next) break;
#pragma unroll
        for (int a = 0; a < 2; ++a)
#pragma unroll
            for (int b = 0; b < 2; ++b)
#pragma unroll
                for (int m = 0; m < 4; ++m)
#pragma unroll
                    for (int n = 0; n < 2; ++n) acc[a][b][m][n] = (f32x4){0.f, 0.f, 0.f, 0.f};
        cur = nxt; cA = nA; cB = nB; ++ui;
        PG8_ROWS(cur, ui & 1);
        if constexpr (ALIGN_EPI) { if (wr == 1) PG8_BAR; }
    }
    PG8_WAIT_V(0);
    if constexpr (!ALIGN_EPI) { if (wr == 0) PG8_BAR; }
    PG8_BAR;
    if constexpr (Epi::AFTER_DRAIN) { E.fused(acc, cur, wr, wc, fr, fq, lds, wid, lane); S.done(cur); }
#undef PG8_ROWS
#undef PG8_AK
#undef PG8_SA
#undef PG8_SB
#undef PG8_STAGE
#undef PG8_LDA
#undef PG8_LDB
#undef PG8_MMA
#undef PG8_WAIT_V
#undef PG8_WAIT_L
#undef PG8_WAIT_VP
#undef PG8_PF
#undef PG8_BAR
#undef PG8_SCHED
}
}

constexpr int NWAVES = 8;
constexpr int PPITCH = 3072;
constexpr int BATCH = 8, SEQ = 8192, DM = 1024, NIN = 5120, CW = 512, AW = 512, FF = 4096, NH = 8, HD = 64, MBLK = 256, NBLK = SEQ / MBLK;
constexpr int M = BATCH * SEQ;
constexpr int C_U = 0, C_GBN = 1024;
constexpr int C_XIN = 0, C_GB = 512, C_GC = 1024, C_Q = 1536, C_K = 2048, C_V = 2560, C_GCONV = 3072, C_GATTN = 4096;
constexpr float RMS_EPS = 1e-6f, LOG2E = 1.4426950408889634f;
constexpr int N_PHASES = 10;

constexpr size_t MiB = 1u << 20;
constexpr size_t WS_CTL = 0, CTL_ZERO_BYTES = 65536;
constexpr int CW_BAR = 4096;
constexpr size_t WS_T5 = 1 * MiB, WS_KM = 1 * MiB + 65536;
constexpr size_t WS_WIN = 2 * MiB, WS_WC = 12 * MiB, WS_WA = 13 * MiB, WS_WO = 14 * MiB, WS_W1 = 16 * MiB, WS_W2 = 24 * MiB;
constexpr size_t WS_XN = 32 * MiB;
constexpr size_t WS_PROJ = 160 * MiB;
constexpr size_t WS_H = 288 * MiB;
constexpr size_t WS_U = 800 * MiB, WS_O = 864 * MiB;
constexpr size_t WS_PART = 928 * MiB, PART_STRIDE = 131072 + 4096;
constexpr size_t WS_END = 1024 * MiB;

constexpr int LDS_BYTES = 155648;
constexpr int LDS_BARST = LDS_BYTES - 64;

#define GAS __attribute__((address_space(1)))
#define LAS __attribute__((address_space(3)))
typedef unsigned short bf16;
typedef unsigned v4u __attribute__((ext_vector_type(4)));
typedef unsigned v2u __attribute__((ext_vector_type(2)));
typedef float f32x4 __attribute__((ext_vector_type(4)));
typedef float f32x2 __attribute__((ext_vector_type(2)));
typedef float f32x16 __attribute__((ext_vector_type(16)));
typedef short bf16x8 __attribute__((ext_vector_type(8)));
typedef short s16x4 __attribute__((ext_vector_type(4)));
#define LDS_WAIT() asm volatile("s_waitcnt lgkmcnt(0)" ::: "memory")
#define VM_WAIT() asm volatile("s_waitcnt vmcnt(0)" ::: "memory")
__device__ __forceinline__ unsigned f2bf(float f) { unsigned u = __builtin_bit_cast(unsigned, f); return (u + 0x7fffu + ((u >> 16) & 1u)) >> 16; }
__device__ __forceinline__ unsigned pk2(float lo, float hi) { return f2bf(lo) | (f2bf(hi) << 16); }
__device__ __forceinline__ float bflo(unsigned w) { return __uint_as_float(w << 16); }
__device__ __forceinline__ float bfhi(unsigned w) { return __uint_as_float(w & 0xffff0000u); }

#define XB_TMO      128
#define XB_XCNT(j)  (256  + 64 * (j))
#define XB_XSUB(j)  (1280 + 64 * (j))
#define XB_XGEN(j)  (2304 + 64 * (j))
#define XB_TOP      3328
#define XB_TOPGEN   3392
#define XCD_BAR_WORDS 3456
#define XB_SPIN_CAP (1u << 18)

__device__ __forceinline__ unsigned xb_ld(unsigned* p)              { return __hip_atomic_load(p, __ATOMIC_RELAXED, __HIP_MEMORY_SCOPE_AGENT); }
__device__ __forceinline__ unsigned xb_add(unsigned* p, unsigned v) { return __hip_atomic_fetch_add(p, v, __ATOMIC_RELAXED, __HIP_MEMORY_SCOPE_AGENT); }
__device__ __forceinline__ unsigned xb_xcc_id() { return (unsigned)__builtin_amdgcn_s_getreg((3 << 11) | 20) & 0xFu; }
#define XB_SPIN(cond, bar) do { unsigned _sp = 0; while (cond) { __builtin_amdgcn_s_sleep(1); \
    if ((++_sp & 255u) == 0u) { if (xb_ld(&(bar)[XB_TMO])) break; if (_sp > XB_SPIN_CAP) { atomicAdd(&(bar)[XB_TMO], 1u); break; } } } } while (0)

struct XcdBarrier {
    unsigned* bar; unsigned x;
    volatile LAS unsigned* st;
};

__device__ __forceinline__ XcdBarrier xcd_barrier_post(unsigned* bar, volatile LAS unsigned* st) {
    XcdBarrier b; b.bar = bar; b.x = xb_xcc_id(); b.st = st;
    if (threadIdx.x == 0) (void)xb_add(&bar[XB_XCNT(b.x)], 1u);
    return b;
}
__device__ __forceinline__ void xcd_barrier_complete(unsigned* bar, unsigned x, unsigned& nloc, unsigned& nx) {
    const unsigned G = gridDim.x * gridDim.y * gridDim.z;
    unsigned sum, cnt, mine, sp = 0u;
    for (;;) {
        sum = 0u; cnt = 0u; mine = 0u;
#pragma unroll
        for (unsigned j = 0; j < 16; ++j) { const unsigned c = xb_ld(&bar[XB_XCNT(j)]); sum += c; cnt += (c > 0u) ? 1u : 0u; mine = (j == x) ? c : mine; }
        if (sum == G) break;
        __builtin_amdgcn_s_sleep(1);
        if ((++sp & 255u) == 0u) { if (xb_ld(&bar[XB_TMO])) break; if (sp > XB_SPIN_CAP) { atomicAdd(&bar[XB_TMO], 1u); break; } }
    }
    nloc = mine > 0u ? mine : 1u; nx = cnt > 0u ? cnt : 1u;
}

__device__ __forceinline__ void xcd_barrier(const XcdBarrier& b) {
    asm volatile("s_waitcnt vmcnt(0)" ::: "memory");
    __syncthreads();
    if (threadIdx.x == 0) {
        unsigned* bar = b.bar;
        __builtin_amdgcn_s_waitcnt(0);
        unsigned nloc = b.st[0], nx = b.st[1];
        if (nloc == 0u) { xcd_barrier_complete(bar, b.x, nloc, nx); b.st[0] = nloc; b.st[1] = nx; }
        const unsigned old = xb_add(&bar[XB_XSUB(b.x)], 1u);
        const unsigned gen = old / nloc;
        if (old + 1u == (gen + 1u) * nloc) {
            __builtin_amdgcn_fence(__ATOMIC_RELEASE, "agent");
            asm volatile("s_waitcnt vmcnt(0)" ::: "memory");
            const unsigned og = xb_add(&bar[XB_TOP], 1u);
            const unsigned tg = og / nx;
            if (og + 1u == (tg + 1u) * nx) xb_add(&bar[XB_TOPGEN], 1u);
            else XB_SPIN(xb_ld(&bar[XB_TOPGEN]) == tg, bar);
            __builtin_amdgcn_fence(__ATOMIC_ACQUIRE, "agent");
            xb_add(&bar[XB_XGEN(b.x)], 1u);
            asm volatile("s_waitcnt vmcnt(0)" ::: "memory");
        } else {
            XB_SPIN(xb_ld(&bar[XB_XGEN(b.x)]) == gen, bar);
            __builtin_amdgcn_fence(__ATOMIC_ACQUIRE, "agent");
            asm volatile("s_waitcnt vmcnt(0)" ::: "memory");
        }
    }
    __syncthreads();
}

__device__ __forceinline__ void xcd_barrier_local(const XcdBarrier& b) {
    asm volatile("s_waitcnt vmcnt(0)" ::: "memory");
    __syncthreads();
    if (threadIdx.x == 0) {
        unsigned* bar = b.bar;
        __builtin_amdgcn_s_waitcnt(0);
        const unsigned nloc = b.st[0];
        const unsigned old = xb_add(&bar[XB_XSUB(b.x)], 1u);
        const unsigned gen = old / nloc;
        if (old + 1u == (gen + 1u) * nloc) xb_add(&bar[XB_XGEN(b.x)], 1u);
        else XB_SPIN(xb_ld(&bar[XB_XGEN(b.x)]) == gen, bar);
        __builtin_amdgcn_fence(__ATOMIC_ACQUIRE, "agent");
        asm volatile("s_waitcnt vmcnt(0)" ::: "memory");
    }
    __syncthreads();
}

struct Frame {
    LAS unsigned char* lds;
    int tid, lane, wave, vcu, G;
    const float *x, *g_pre1, *w_in, *conv_w, *w_cout, *w_aout, *rel_bias, *w_o, *g_post1, *g_pre2, *w1, *w2, *g_post2;
    float* out;
    bf16 *Win_t, *Wc_t, *Wa_t, *Wo_t, *W1_t, *W2_t;
    bf16 *XN, *PROJ, *U, *O, *M1, *MIX, *HB, *FB, *X1B, *GT;
    float *T5, *KM, *RS2, *RS1; unsigned* convctr;
    unsigned char* part;
};

__device__ __forceinline__ float wave_sum(float v) {
#pragma unroll
    for (int o = 1; o < 64; o <<= 1) v += __shfl_xor(v, o);
    return v;
}
__device__ __forceinline__ void p0_transpose_item(const float* W, int K, int N, bf16* WT, LAS float* scr, int item, int lane, int ldk = 0, int koff = 0, bool gate_il = false, const float* kgain = nullptr) {
    if (ldk == 0) ldk = K;
    const int nblk = N / 32, kb = item / nblk, nb = item % nblk, k0 = 64 * kb, n0 = 32 * nb;
    int nd0 = n0;
    if (gate_il && n0 < C_Q) { if (n0 < C_GB) nd0 = 256 * (n0 >> 7) + (n0 & 127); else if (n0 < C_GC) nd0 = C_GBN + (n0 - C_GB); else nd0 = 256 * ((n0 - C_GC) >> 7) + 128 + ((n0 - C_GC) & 127); }
    if (gate_il && n0 >= C_GCONV) { const int blk = n0 >= C_GATTN ? 1 : 0, cc = n0 - (blk ? C_GATTN : C_GCONV); nd0 = C_GCONV + 256 * (cc >> 7) + 128 * blk + (cc & 127); }
    float t[32];
#pragma unroll
    for (int i = 0; i < 32; ++i) t[i] = __builtin_nontemporal_load(W + (size_t)(k0 + 2 * i + (lane >> 5)) * N + n0 + (lane & 31));
    const int c = lane & 7;
    float g8[8];
    if (kgain) { const f32x4 ga = *(const GAS f32x4*)(kgain + k0 + 8 * c), gb = *(const GAS f32x4*)(kgain + k0 + 8 * c + 4);
        g8[0] = ga.x; g8[1] = ga.y; g8[2] = ga.z; g8[3] = ga.w; g8[4] = gb.x; g8[5] = gb.y; g8[6] = gb.z; g8[7] = gb.w; }
    else {
#pragma unroll
        for (int e = 0; e < 8; ++e) g8[e] = 1.0f; }
    __builtin_amdgcn_sched_barrier(0);
#pragma unroll
    for (int i = 0; i < 32; ++i) scr[(2 * i + (lane >> 5)) * 33 + (lane & 31)] = t[i];
    LDS_WAIT(); asm volatile("" ::: "memory");
#pragma unroll
    for (int j = 0; j < 4; ++j) { const int n = (lane >> 3) + 8 * j; const LAS float* s = scr + (8 * c) * 33 + n;
        v4u o; o.x = pk2(s[0 * 33] * g8[0], s[1 * 33] * g8[1]); o.y = pk2(s[2 * 33] * g8[2], s[3 * 33] * g8[3]); o.z = pk2(s[4 * 33] * g8[4], s[5 * 33] * g8[5]); o.w = pk2(s[6 * 33] * g8[6], s[7 * 33] * g8[7]);
        *(GAS v4u*)(WT + (size_t)(nd0 + n) * ldk + koff + k0 + 8 * c) = o; }
    LDS_WAIT(); asm volatile("" ::: "memory");
}
__device__ __forceinline__ void rms_row_to_bf16(const float* xrow, const float* gain, bf16* orow, int lane) {
    const GAS f32x4* xr = (const GAS f32x4*)xrow + lane; const GAS f32x4* gr = (const GAS f32x4*)gain + lane;
    f32x4 v[4]; float s = 0.f;
#pragma unroll
    for (int j = 0; j < 4; ++j) { v[j] = xr[64 * j]; s += (v[j].x * v[j].x + v[j].y * v[j].y) + (v[j].z * v[j].z + v[j].w * v[j].w); }
    const float rs = 1.0f / sqrtf(wave_sum(s) * (1.f / DM) + RMS_EPS);
    GAS v2u* o8 = (GAS v2u*)orow + lane;
#pragma unroll
    for (int j = 0; j < 4; ++j) { const f32x4 g = gr[64 * j]; v2u w; w.x = pk2(v[j].x * rs * g.x, v[j].y * rs * g.y); w.y = pk2(v[j].z * rs * g.z, v[j].w * rs * g.w); o8[64 * j] = w; }
}
__device__ __forceinline__ void p0_prologue(Frame& F) {
    LAS float* scr = (LAS float*)(F.lds + F.wave * 16384);
    const int gw = F.vcu * NWAVES + F.wave, NGW = F.G * NWAVES;
    constexpr int I_IN = (DM / 64) * (NIN / 32), I_C = (CW / 64) * (DM / 32), I_A = (AW / 64) * (DM / 32), I_O = (DM / 64) * (DM / 32), I_1 = (DM / 64) * (FF / 32), I_2 = (FF / 64) * (DM / 32);
    constexpr int NITEMS = I_IN + I_C + I_A + I_O + I_1 + I_2;
    for (int it = gw; it < NITEMS; it += NGW) {
        int r = it;
        if (r < I_IN) { p0_transpose_item(F.w_in, DM, NIN, F.Win_t, scr, r, F.lane, 0, 0, true, F.g_pre1); continue; } r -= I_IN;
        if (r < I_C) { p0_transpose_item(F.w_cout, CW, DM, F.Wc_t, scr, r, F.lane, CW + AW, 0); continue; } r -= I_C;
        if (r < I_A) { p0_transpose_item(F.w_aout, AW, DM, F.Wc_t, scr, r, F.lane, CW + AW, CW); continue; } r -= I_A;
        if (r < I_O) { p0_transpose_item(F.w_o, DM, DM, F.Wo_t, scr, r, F.lane); continue; } r -= I_O;
        if (r < I_1) { p0_transpose_item(F.w1, DM, FF, F.W1_t, scr, r, F.lane, 0, 0, false, F.g_pre2); continue; } r -= I_1;
        p0_transpose_item(F.w2, FF, DM, F.W2_t, scr, r, F.lane);
    }
    for (int m = gw; m < M; m += 2 * NGW) {
        const int m2 = m + NGW; const GAS f32x4* xa = (const GAS f32x4*)(F.x + (size_t)m * DM) + F.lane; const GAS f32x4* xb = (const GAS f32x4*)(F.x + (size_t)m2 * DM) + F.lane;
        f32x4 va[4], vb[4]; float sa = 0.f, sb = 0.f;
#pragma unroll
        for (int j = 0; j < 4; ++j) { va[j] = __builtin_nontemporal_load(xa + 64 * j); vb[j] = __builtin_nontemporal_load(xb + 64 * j); }
#pragma unroll
        for (int j = 0; j < 4; ++j) { sa += (va[j].x * va[j].x + va[j].y * va[j].y) + (va[j].z * va[j].z + va[j].w * va[j].w); sb += (vb[j].x * vb[j].x + vb[j].y * vb[j].y) + (vb[j].z * vb[j].z + vb[j].w * vb[j].w); }
        const float ra = 1.0f / sqrtf(wave_sum(sa) * (1.f / DM) + RMS_EPS), rb = 1.0f / sqrtf(wave_sum(sb) * (1.f / DM) + RMS_EPS);
        if (F.lane == 0) { F.RS1[m] = ra; F.RS1[m2] = rb; }
        GAS v2u* oa = (GAS v2u*)(F.XN + (size_t)m * DM) + F.lane; GAS v2u* ob = (GAS v2u*)(F.XN + (size_t)m2 * DM) + F.lane;
#pragma unroll
        for (int j = 0; j < 4; ++j) { v2u w; w.x = pk2(va[j].x, va[j].y); w.y = pk2(va[j].z, va[j].w); oa[64 * j] = w;
            w.x = pk2(vb[j].x, vb[j].y); w.y = pk2(vb[j].z, vb[j].w); ob[64 * j] = w; }
    }
    for (int e = F.vcu * 512 + F.tid; e < (M / MBLK) * 512; e += F.G * 512) F.KM[e] = 0.f;
    for (int e = F.vcu * 512 + F.tid; e < NH * 1024; e += F.G * 512) {
        const int h = e >> 10, d = e & 1023; int bk;
        if (d < 16) bk = d; else { bk = 16; const int thr[15] = {21, 27, 35, 46, 59, 77, 99, 128, 166, 216, 280, 363, 470, 609, 790};
#pragma unroll
            for (int k = 0; k < 15; ++k) bk += (d >= thr[k]) ? 1 : 0; }
        F.T5[e] = F.rel_bias[h * 32 + bk] * LOG2E;
    }
}

__device__ __forceinline__ void conv_tail(Frame& F) {
    const int c = F.lane * 8;
    float w0[8], w1[8], w2[8];
#pragma unroll
    for (int e = 0; e < 8; ++e) { w0[e] = F.conv_w[c + e]; w1[e] = F.conv_w[CW + c + e]; w2[e] = F.conv_w[2 * CW + c + e]; }
#pragma unroll 1
    for (;;) {
        const bool grp = (F.G % 8) == 0; const int gx = (int)blockIdx.x & 7;
        int rr = 0; if (F.lane == 0) rr = (int)__hip_atomic_fetch_add(F.convctr + (grp ? 64 * gx : 0), 1u, __ATOMIC_RELAXED, __HIP_MEMORY_SCOPE_AGENT);
        rr = __builtin_amdgcn_readfirstlane(rr);
        if (rr >= (grp ? SEQ / 32 : M / 32)) break;
        const int t0 = (grp ? gx * SEQ : 0) + rr * 32; const bf16* P = F.PROJ + (size_t)t0 * PPITCH + c;
        float um2[8], um1[8];
        if ((t0 % SEQ) == 0) {
#pragma unroll
            for (int e = 0; e < 8; ++e) { um2[e] = 0.f; um1[e] = 0.f; }
        } else {
            const v4u xa = *(const GAS v4u*)(P - 2 * PPITCH + C_U), xb = *(const GAS v4u*)(P - PPITCH + C_U);
            um2[0] = bflo(xa.x); um2[1] = bfhi(xa.x); um2[2] = bflo(xa.y); um2[3] = bfhi(xa.y); um2[4] = bflo(xa.z); um2[5] = bfhi(xa.z); um2[6] = bflo(xa.w); um2[7] = bfhi(xa.w);
            um1[0] = bflo(xb.x); um1[1] = bfhi(xb.x); um1[2] = bflo(xb.y); um1[3] = bfhi(xb.y); um1[4] = bflo(xb.z); um1[5] = bfhi(xb.z); um1[6] = bflo(xb.w); um1[7] = bfhi(xb.w);
        }
        bf16* Up = F.U + (size_t)t0 * (CW + AW) + c;
#pragma unroll 1
        for (int r0 = 0; r0 < 32; r0 += 4) {
            v4u xv[4], bv[4];
#pragma unroll
            for (int k = 0; k < 4; ++k) { const bf16* Pr = P + (size_t)(r0 + k) * PPITCH; xv[k] = __builtin_nontemporal_load((const GAS v4u*)(Pr + C_U)); bv[k] = __builtin_nontemporal_load((const GAS v4u*)(Pr + C_GBN)); }
#pragma unroll
            for (int k = 0; k < 4; ++k) {
                float u[8], b[8];
                u[0] = bflo(xv[k].x); u[1] = bfhi(xv[k].x); u[2] = bflo(xv[k].y); u[3] = bfhi(xv[k].y); u[4] = bflo(xv[k].z); u[5] = bfhi(xv[k].z); u[6] = bflo(xv[k].w); u[7] = bfhi(xv[k].w);
                b[0] = bflo(bv[k].x); b[1] = bfhi(bv[k].x); b[2] = bflo(bv[k].y); b[3] = bfhi(bv[k].y); b[4] = bflo(bv[k].z); b[5] = bfhi(bv[k].z); b[6] = bflo(bv[k].w); b[7] = bfhi(bv[k].w);
                float o[8];
#pragma unroll
                for (int e = 0; e < 8; ++e) { o[e] = b[e] * (w0[e] * um2[e] + w1[e] * um1[e] + w2[e] * u[e]); um2[e] = um1[e]; um1[e] = u[e]; }
                v4u w; w.x = pk2(o[0], o[1]); w.y = pk2(o[2], o[3]); w.z = pk2(o[4], o[5]); w.w = pk2(o[6], o[7]);
                *(GAS v4u*)(Up + (size_t)(r0 + k) * (CW + AW)) = w; }
        }
    }
}

__device__ __forceinline__ void p6_norms(Frame& F) {
    const int gw = F.vcu * NWAVES + F.wave, NGW = F.G * NWAVES; const bool BL = (F.G == 256); const int R2 = BL ? SEQ / 2 : NGW;
    const GAS f32x4* g1 = (const GAS f32x4*)F.g_post1 + F.lane;
    f32x4 gg[4];
#pragma unroll
    for (int j = 0; j < 4; ++j) gg[j] = g1[64 * j];
    for (int jj = 0; jj < M / (2 * NGW); ++jj) { const int m0 = BL ? (F.vcu >> 5) * SEQ + (F.vcu & 31) * NWAVES + F.wave + jj * 256 : gw + jj * 2 * NGW;
        f32x4 v[2][4], xv[2][4]; float s[2] = {0.f, 0.f};
#pragma unroll
        for (int rr = 0; rr < 2; ++rr) { const size_t m = (size_t)(m0 + rr * R2);
            const GAS v2u* mr = (const GAS v2u*)(F.MIX + m * DM) + F.lane; const GAS v2u* xr = (const GAS v2u*)(F.XN + m * DM) + F.lane;
#pragma unroll
            for (int j = 0; j < 4; ++j) { const v2u w = __builtin_nontemporal_load(mr + 64 * j); const v2u xw = __builtin_nontemporal_load(xr + 64 * j); xv[rr][j] = (f32x4){bflo(xw.x), bfhi(xw.x), bflo(xw.y), bfhi(xw.y)}; v[rr][j] = (f32x4){bflo(w.x), bfhi(w.x), bflo(w.y), bfhi(w.y)}; } }
#pragma unroll
        for (int rr = 0; rr < 2; ++rr)
#pragma unroll
            for (int j = 0; j < 4; ++j) s[rr] += (v[rr][j].x * v[rr][j].x + v[rr][j].y * v[rr][j].y) + (v[rr][j].z * v[rr][j].z + v[rr][j].w * v[rr][j].w);
        float rs[2], s2[2] = {0.f, 0.f};
#pragma unroll
        for (int rr = 0; rr < 2; ++rr) rs[rr] = 1.0f / sqrtf(wave_sum(s[rr]) * (1.f / DM) + RMS_EPS);
#pragma unroll
        for (int rr = 0; rr < 2; ++rr) { const size_t m = (size_t)(m0 + rr * R2); GAS v2u* x1row = (GAS v2u*)(F.X1B + m * DM) + F.lane;
#pragma unroll
            for (int j = 0; j < 4; ++j) { const f32x4 g = gg[j]; v[rr][j] = xv[rr][j] + v[rr][j] * rs[rr] * g; v2u w; w.x = pk2(v[rr][j].x, v[rr][j].y); w.y = pk2(v[rr][j].z, v[rr][j].w); x1row[64 * j] = w;
                s2[rr] += (v[rr][j].x * v[rr][j].x + v[rr][j].y * v[rr][j].y) + (v[rr][j].z * v[rr][j].z + v[rr][j].w * v[rr][j].w); } }
#pragma unroll
        for (int rr = 0; rr < 2; ++rr) { const size_t m = (size_t)(m0 + rr * R2); const float rs2 = 1.0f / sqrtf(wave_sum(s2[rr]) * (1.f / DM) + RMS_EPS);
            if (F.lane == 0) F.RS2[m] = rs2; }
    }
}
__device__ __forceinline__ void p9_final(Frame& F) {
    const int gw = F.vcu * NWAVES + F.wave, NGW = F.G * NWAVES; const bool BL = (F.G == 256); const int R2 = BL ? SEQ / 2 : NGW;
    const GAS f32x4* g1 = (const GAS f32x4*)F.g_post2 + F.lane;
    f32x4 gg[4];
#pragma unroll
    for (int j = 0; j < 4; ++j) gg[j] = g1[64 * j];
    for (int jj = 0; jj < M / (2 * NGW); ++jj) { const int m0 = BL ? (F.vcu >> 5) * SEQ + (F.vcu & 31) * NWAVES + F.wave + jj * 256 : gw + jj * 2 * NGW;
        f32x4 v[2][4]; v2u xw[2][4]; float s[2] = {0.f, 0.f};
#pragma unroll
        for (int rr = 0; rr < 2; ++rr) { const size_t m = (size_t)(m0 + rr * R2);
            const GAS v2u* fr = (const GAS v2u*)(F.FB + m * DM) + F.lane; const GAS v2u* x1row = (const GAS v2u*)(F.X1B + m * DM) + F.lane;
#pragma unroll
            for (int j = 0; j < 4; ++j) { const v2u w = __builtin_nontemporal_load(fr + 64 * j); xw[rr][j] = __builtin_nontemporal_load(x1row + 64 * j); v[rr][j] = (f32x4){bflo(w.x), bfhi(w.x), bflo(w.y), bfhi(w.y)}; } }
#pragma unroll
        for (int rr = 0; rr < 2; ++rr)
#pragma unroll
            for (int j = 0; j < 4; ++j) s[rr] += (v[rr][j].x * v[rr][j].x + v[rr][j].y * v[rr][j].y) + (v[rr][j].z * v[rr][j].z + v[rr][j].w * v[rr][j].w);
#pragma unroll
        for (int rr = 0; rr < 2; ++rr) { const size_t m = (size_t)(m0 + rr * R2); const float rs = 1.0f / sqrtf(wave_sum(s[rr]) * (1.f / DM) + RMS_EPS);
            GAS f32x4* orow = (GAS f32x4*)(F.out + m * DM) + F.lane;
#pragma unroll
            for (int j = 0; j < 4; ++j) { const f32x4 g = gg[j]; const f32x4 x1 = (f32x4){bflo(xw[rr][j].x), bfhi(xw[rr][j].x), bflo(xw[rr][j].y), bfhi(xw[rr][j].y)}; orow[64 * j] = x1 + v[rr][j] * rs * g; } }
    }
}

namespace moba2 {
constexpr int NSLOT = 3, SLOTB = 16384;
constexpr int L_RING = 0;
constexpr int L_OST = NSLOT * SLOTB;
constexpr int L_QST = L_OST + NWAVES * 4096;
constexpr int TXMAX = 1343, TLEN = TXMAX + 65;
constexpr int L_TB = L_QST + NWAVES * 4096;
constexpr int L_LIST = L_TB + 2 * TLEN * 4;
constexpr int L_SEL = L_LIST + 15360;
constexpr int L_WSF = L_SEL + 10240;
constexpr int L_CNT = L_WSF + NWAVES * 256;
constexpr int L_RTAB = L_CNT + 512;
constexpr int L_MISC = L_RTAB + 384;
constexpr int L_END = L_MISC + 64;
static_assert(L_END <= LDS_BARST, "attention LDS map");
__device__ __forceinline__ int crow(int r, int hi) { return (r & 3) + 8 * (r >> 2) + 4 * hi; }
typedef short v4i16_t __attribute__((ext_vector_type(4)));
__device__ __forceinline__ s16x4 vtr(const LAS unsigned char* p) { return __builtin_bit_cast(s16x4, __builtin_amdgcn_ds_read_tr16_b64_v4i16((LAS v4i16_t*)p)); }
typedef float f32x2_t __attribute__((ext_vector_type(2))); typedef __bf16 bf16x2_t __attribute__((ext_vector_type(2)));
__device__ __forceinline__ unsigned cvtpk(float lo, float hi) { f32x2_t v = {lo, hi}; bf16x2_t b = __builtin_convertvector(v, bf16x2_t); return __builtin_bit_cast(unsigned, b); }

__device__ __forceinline__ void unit(Frame& F, int b, int h, int lo, int hi_blk) {
    LAS unsigned char* lds = F.lds;
    LAS float* tb = (LAS float*)(lds + L_TB); LAS unsigned short* list = (LAS unsigned short*)(lds + L_LIST); LAS unsigned* selw = (LAS unsigned*)(lds + L_SEL);
    LAS float* wsf = (LAS float*)(lds + L_WSF) + F.wave * 64;
    LAS int* cnt = (LAS int*)(lds + L_CNT); LAS int* off = cnt + 32; LAS int* cur = cnt + 64; LAS unsigned* rtab = (LAS unsigned*)(lds + L_RTAB); LAS int* misc = (LAS int*)(lds + L_MISC);
    const int lane = F.lane, r32 = lane & 31, hi = lane >> 5, tid = F.tid, w = F.wave;
    const int nblk = hi_blk - lo, nq = nblk * MBLK;
    const size_t tokb = (size_t)b * SEQ;
    bf16* PO = (bf16*)F.out; float* PL = (float*)F.part;
    if (tid < 96) cnt[tid] = 0;
    { constexpr int NTB = (2 * TLEN + 511) / 512; float tv[NTB];
#pragma unroll
      for (int k = 0; k < NTB; ++k) { const int e = tid + 512 * k, sft = e >= TLEN ? 1 : 0, x = e - sft * TLEN + sft; int d = TXMAX - x; d = d < 0 ? 0 : (d > 1023 ? 1023 : d); tv[k] = F.T5[h * 1024 + d]; }
      __builtin_amdgcn_sched_barrier(0);
#pragma unroll
      for (int k = 0; k < NTB; ++k) { const int e = tid + 512 * k, sft = e >= TLEN ? 1 : 0, x = e - sft * TLEN + sft, d = TXMAX - x; if (e < 2 * TLEN) tb[e] = d < 0 ? -INFINITY : tv[k]; } }
    __syncthreads();
    {
        bf16x8 kmh[4], kml[4];
        f32x4 kav[4], kbv[4];
#pragma unroll
        for (int d0 = 0; d0 < 4; ++d0) { const float* kmp = F.KM + ((size_t)(b * NBLK + r32) * 512 + h * 64 + d0 * 16 + hi * 8); kav[d0] = *(const GAS f32x4*)kmp; kbv[d0] = *(const GAS f32x4*)(kmp + 4); }
        __builtin_amdgcn_sched_barrier(0);
#pragma unroll
        for (int d0 = 0; d0 < 4; ++d0) {
            const f32x4 ka = kav[d0], kb = kbv[d0];
            const float kf[8] = {ka.x, ka.y, ka.z, ka.w, kb.x, kb.y, kb.z, kb.w}; unsigned hb[8], lb[8];
#pragma unroll
            for (int e = 0; e < 8; ++e) { hb[e] = f2bf(kf[e]); lb[e] = f2bf(kf[e] - __uint_as_float(hb[e] << 16)); }
            v4u hw, lw; hw.x = hb[0] | (hb[1] << 16); hw.y = hb[2] | (hb[3] << 16); hw.z = hb[4] | (hb[5] << 16); hw.w = hb[6] | (hb[7] << 16);
            lw.x = lb[0] | (lb[1] << 16); lw.y = lb[2] | (lb[3] << 16); lw.z = lb[4] | (lb[5] << 16); lw.w = lb[6] | (lb[7] << 16);
            kmh[d0] = __builtin_bit_cast(bf16x8, hw); kml[d0] = __builtin_bit_cast(bf16x8, lw);
        }
        const bf16* qsel = F.PROJ + (tokb + (size_t)lo * MBLK + r32) * PPITCH + C_Q + h * 64 + hi * 8;
        bf16x8 qc[4];
#pragma unroll
        for (int d0 = 0; d0 < 4; ++d0) qc[d0] = *(const GAS bf16x8*)(qsel + (size_t)(w * 32) * PPITCH + d0 * 16);
#pragma unroll 1
        for (int tq = w; tq < nq / 32; tq += NWAVES) {
            const int i = lo + (tq >> 3); const int qu = tq * 32 + r32;
            const int tn = (tq + NWAVES < nq / 32) ? tq + NWAVES : tq;
            bf16x8 qn[4];
#pragma unroll
            for (int d0 = 0; d0 < 4; ++d0) qn[d0] = *(const GAS bf16x8*)(qsel + (size_t)(tn * 32) * PPITCH + d0 * 16);
            __builtin_amdgcn_sched_barrier(0);
            f32x16 g = f32x16{};
#pragma unroll
            for (int d0 = 0; d0 < 4; ++d0) { const bf16x8 qf = qc[d0];
                g = __builtin_amdgcn_mfma_f32_32x32x16_bf16(kmh[d0], qf, g, 0, 0, 0); g = __builtin_amdgcn_mfma_f32_32x32x16_bf16(kml[d0], qf, g, 0, 0, 0); }
#pragma unroll
            for (int d0 = 0; d0 < 4; ++d0) qc[d0] = qn[d0];
            float v0 = -INFINITY, v1 = -INFINITY, v2 = -INFINITY; int j0 = 0, j1 = 0, j2 = 0;
#define MOBA_INS(xg_, jj_) do { const float xg = (xg_); const int jj = (jj_); const bool c0 = xg > v0, c1 = xg > v1, c2 = xg > v2; \
            const float nv2 = c1 ? v1 : (c2 ? xg : v2), nv1 = c0 ? v0 : (c1 ? xg : v1), nv0 = c0 ? xg : v0; \
            const int nj2 = c1 ? j1 : (c2 ? jj : j2), nj1 = c0 ? j0 : (c1 ? jj : j1), nj0 = c0 ? jj : j0; \
            v0 = nv0; v1 = nv1; v2 = nv2; j0 = nj0; j1 = nj1; j2 = nj2; } while (0)
#pragma unroll
            for (int r = 0; r < 16; ++r) { const int jc = crow(r, hi); MOBA_INS(jc < i ? g[r] : -INFINITY, jc); }
            { const float u0 = __shfl_xor(v0, 32), u1 = __shfl_xor(v1, 32), u2 = __shfl_xor(v2, 32); const int k0 = __shfl_xor(j0, 32), k1 = __shfl_xor(j1, 32), k2 = __shfl_xor(j2, 32);
              MOBA_INS(u0, k0); MOBA_INS(u1, k1); MOBA_INS(u2, k2); }
#undef MOBA_INS
            if (hi == 0) {
                const int nsel = i < 3 ? i : 3;
                selw[qu] = (unsigned)j0 | ((unsigned)j1 << 5) | ((unsigned)j2 << 10);
                if (nsel > 0) __hip_atomic_fetch_add(cnt + j0, 1, __ATOMIC_RELAXED, __HIP_MEMORY_SCOPE_WORKGROUP);
                if (nsel > 1) __hip_atomic_fetch_add(cnt + j1, 1, __ATOMIC_RELAXED, __HIP_MEMORY_SCOPE_WORKGROUP);
                if (nsel > 2) __hip_atomic_fetch_add(cnt + j2, 1, __ATOMIC_RELAXED, __HIP_MEMORY_SCOPE_WORKGROUP);
            }
        }
    }
    __syncthreads();
    if (w == 0) {
        const int c = lane < 32 ? cnt[lane & 31] : 0; const int nt = (c + 31) >> 5, nr = (nt + 7) >> 3;
        int inc = c, incr = nr;
#pragma unroll
        for (int o2 = 1; o2 < 32; o2 <<= 1) { const int t = __shfl_up(inc, o2), t2 = __shfl_up(incr, o2); if ((lane & 31) >= o2) { inc += t; incr += t2; } }
        if (lane < 32) { off[lane] = inc - c; cur[lane] = inc - c;
            for (int r = 0; r < nr; ++r) rtab[nblk + incr - nr + r] = (unsigned)lane | ((unsigned)(r * 8) << 8) | ((unsigned)nt << 16); }
        if (lane < nblk) rtab[lane] = (unsigned)(lo + lane) | 0x80000000u;
        if (lane == 31) misc[0] = nblk + incr;
    }
    __syncthreads();
    for (int qu = tid; qu < nq; qu += 512) {
        const int i = lo + (qu >> 8); const int nsel = i < 3 ? i : 3; const unsigned s = selw[qu];
        if (nsel > 0) { const int p = __hip_atomic_fetch_add(cur + (s & 31), 1, __ATOMIC_RELAXED, __HIP_MEMORY_SCOPE_WORKGROUP); list[p] = (unsigned short)(qu | (0 << 12)); }
        if (nsel > 1) { const int p = __hip_atomic_fetch_add(cur + ((s >> 5) & 31), 1, __ATOMIC_RELAXED, __HIP_MEMORY_SCOPE_WORKGROUP); list[p] = (unsigned short)(qu | (1 << 12)); }
        if (nsel > 2) { const int p = __hip_atomic_fetch_add(cur + ((s >> 10) & 31), 1, __ATOMIC_RELAXED, __HIP_MEMORY_SCOPE_WORKGROUP); list[p] = (unsigned short)(qu | (2 << 12)); }
    }
    __syncthreads();
    const int nrounds = __builtin_amdgcn_readfirstlane(misc[0]), NT = nrounds * 4;
    const char* kvh = (const char*)(F.PROJ + tokb * PPITCH + h * 64);
    const int kkey = 8 * w + (lane >> 3), kch = (lane & 7) ^ ((kkey >> 1) & 7);
    const int vkey = 16 * (w & 3) + (lane >> 2);
    const unsigned ksrc_off = (unsigned)(kkey * PPITCH + C_K + kch * 8) * 2u, vsrc_off = (unsigned)(vkey * PPITCH + C_V + (w >> 2) * 32 + (lane & 3) * 8) * 2u;
    const unsigned lds0 = (unsigned)(uintptr_t)lds;
#define MOBA_GLDS(gsrc_, dst_) do { unsigned keep_; asm volatile("s_mov_b32 %0, m0\n\ts_mov_b32 m0, %2\n\ts_nop 0\n\tglobal_load_lds_dwordx4 %1, off\n\ts_mov_b32 m0, %0" : "=&s"(keep_) : "v"(gsrc_), "s"(dst_) : "memory"); } while (0)
#define MOBA_DMA(jj_, kt_, sl_) do { const char* tb_ = kvh + (size_t)((jj_) * MBLK + (kt_) * 64) * (PPITCH * 2); \
        const unsigned kd_ = (unsigned)__builtin_amdgcn_readfirstlane(lds0 + L_RING + (sl_) * SLOTB + w * 1024), vd_ = (unsigned)__builtin_amdgcn_readfirstlane(lds0 + L_RING + (sl_) * SLOTB + 8192 + w * 1024); \
        MOBA_GLDS(tb_ + ksrc_off, kd_); MOBA_GLDS(tb_ + vsrc_off, vd_); } while (0)
    const int koff = r32 * 128, ksw = (r32 >> 1) & 7;
    const int voff = (4 * hi + ((lane & 15) >> 2)) * 64 + ((lane >> 4) & 1) * 32 + (lane & 3) * 8;
    LAS unsigned char* ost = lds + L_OST + w * 4096;
    LAS int* prow_s = (LAS int*)(wsf + 32);
    bool active = false, near = false, stored_prev = false; int dq = 0, kt_max = 3, jcur = 0, jnext = 0;
    bool n_active = false, n_near = false; int n_dq = 0, n_prow = -1, n_ktmax = 3;
    bf16x8 qf[4]; float mhat = 0.f, l = 0.f, c0 = 0.f, bfar = 0.f; f32x16 o[2]; bool first = true;
    o[0] = f32x16{}; o[1] = f32x16{};
    const unsigned qst0 = lds0 + L_QST + w * 4096; const LAS unsigned char* qst = lds + L_QST + w * 4096;
    bf16* trash = (bf16*)(F.part + 16 * MiB) + (size_t)(blockIdx.x * NWAVES + w) * 2048;
    const char* qbase = (const char*)(F.PROJ + (tokb + (size_t)lo * MBLK) * PPITCH + C_Q + h * 64) + (lane & 7) * 16;
    const int prow_base = (int)(((tokb + (size_t)lo * MBLK) * NH + h) * 4);
#define MOBA_PREP(R_) do { const unsigned re = (unsigned)__builtin_amdgcn_readfirstlane((int)rtab[(R_)]); const int j = re & 31; const bool own = (re >> 31) != 0; int qu, slot, base = 0, lim = 0; bool vld; \
        jnext = j; \
        if (own) { n_active = true; vld = true; qu = (j - lo) * MBLK + w * 32 + r32; slot = 3; n_near = true; n_ktmax = w >> 1; n_dq = w * 32 + r32; } \
        else { const int t0 = (re >> 8) & 255, nt = (re >> 16) & 255; const int tile = t0 + w; n_active = tile < nt; \
            const int cj = __builtin_amdgcn_readfirstlane(cnt[j]), pos = tile * 32 + r32; vld = n_active && pos < cj; base = __builtin_amdgcn_readfirstlane(off[j]) + (n_active ? tile * 32 : 0); lim = n_active ? cj - tile * 32 : 1; \
            const unsigned le = list[base + (vld ? r32 : 0)]; qu = le & 4095; slot = le >> 12; \
            const int i = lo + (qu >> 8); n_ktmax = 3; n_dq = (i - j) * MBLK + (qu & 255); n_near = __any((j + 5 > i) && n_active) != 0; } \
        n_prow = vld ? prow_base + qu * (NH * 4) + slot : -1; \
        _Pragma("unroll") for (int n_ = 0; n_ < 4; ++n_) { const int rho = 8 * n_ + (lane >> 3); int qr; \
            if (own) qr = (j - lo) * MBLK + w * 32 + rho; else qr = list[base + (rho < lim ? rho : 0)] & 4095; \
            const char* src = qbase + (unsigned)qr * (unsigned)(PPITCH * 2); \
            const unsigned qd_ = (unsigned)__builtin_amdgcn_readfirstlane(qst0 + n_ * 1024); MOBA_GLDS(src, qd_); } } while (0)
    MOBA_PREP(0); jcur = jnext;
    MOBA_DMA(jcur, 0, 0); MOBA_DMA(jcur, 1, 1);
    asm volatile("s_waitcnt vmcnt(0)" ::: "memory");
#pragma unroll 1
    for (int T = 0; T < NT; ++T) {
        const int kt = T & 3;
        if (kt == 2) asm volatile("s_waitcnt vmcnt(2) lgkmcnt(0)" ::: "memory");
        else if (kt == 3) asm volatile("s_waitcnt vmcnt(6) lgkmcnt(0)" ::: "memory");
        else if (__builtin_amdgcn_readfirstlane((int)stored_prev)) asm volatile("s_waitcnt vmcnt(7) lgkmcnt(0)" ::: "memory");
        else asm volatile("s_waitcnt vmcnt(2) lgkmcnt(0)" ::: "memory");
        __builtin_amdgcn_s_barrier(); asm volatile("" ::: "memory");
        if (kt == 2) { const int Rn = (T >> 2) + 1; MOBA_PREP(Rn < nrounds ? Rn : nrounds - 1); }
        { const int sl = (T + 2) % NSLOT; if (kt < 2) MOBA_DMA(jcur, kt + 2, sl); else MOBA_DMA(jnext, kt - 2, sl); }
        if (kt == 0) {
            active = n_active; near = n_near; dq = n_dq; kt_max = n_ktmax;
            if (hi == 0) prow_s[r32] = n_prow;
#pragma unroll
            for (int d0 = 0; d0 < 4; ++d0) qf[d0] = *(const LAS bf16x8*)(qst + r32 * 128 + (2 * d0 + hi) * 16);
            bfar = near ? 0.f : tb[TXMAX - 1023]; mhat = 0.f; l = 0.f; c0 = bfar; first = true; o[0] = f32x16{}; o[1] = f32x16{};
        }
        if (kt == 3) jcur = jnext;
        if (kt == 1) stored_prev = false;
        if (active && kt <= kt_max) {
            const LAS unsigned char* buf = lds + L_RING + (T % NSLOT) * SLOTB;
            bf16x8 ka[4], kb[4];
#pragma unroll
            for (int d0 = 0; d0 < 4; ++d0) { const int co = ((2 * d0 + hi) ^ ksw) * 16; ka[d0] = *(const LAS bf16x8*)(buf + koff + co); kb[d0] = *(const LAS bf16x8*)(buf + 4096 + koff + co); }
            f32x16 p0, p1;
#pragma unroll
            for (int r = 0; r < 16; ++r) { p0[r] = c0; p1[r] = c0; }
            __builtin_amdgcn_s_setprio(1);
#pragma unroll
            for (int d0 = 0; d0 < 4; ++d0) { p0 = __builtin_amdgcn_mfma_f32_32x32x16_bf16(ka[d0], qf[d0], p0, 0, 0, 0); p1 = __builtin_amdgcn_mfma_f32_32x32x16_bf16(kb[d0], qf[d0], p1, 0, 0, 0); }
            __builtin_amdgcn_s_setprio(0);
            s16x4 va[8], vc[8];
#pragma unroll
            for (int n = 0; n < 4; ++n) { const LAS unsigned char* vb = buf + 8192 + n * 1024 + voff; va[n] = vtr(vb); vc[n] = vtr(vb + 512); }
            __builtin_amdgcn_sched_barrier(0);
            if (near) {
                int D0 = dq - 64 * kt - 4 * hi; D0 = D0 > 1279 ? 1279 : D0;
                const int x0 = TXMAX - D0, sft = x0 & 1;
                const LAS float* tp = tb + sft * TLEN + (x0 - sft);
#pragma unroll
                for (int g4 = 0; g4 < 4; ++g4) {
                    const f32x2 a0 = *(const LAS f32x2*)(tp + 8 * g4), a1 = *(const LAS f32x2*)(tp + 8 * g4 + 2), b0 = *(const LAS f32x2*)(tp + 32 + 8 * g4), b1 = *(const LAS f32x2*)(tp + 32 + 8 * g4 + 2);
                    p0[4 * g4] += a0.x; p0[4 * g4 + 1] += a0.y; p0[4 * g4 + 2] += a1.x; p0[4 * g4 + 3] += a1.y;
                    p1[4 * g4] += b0.x; p1[4 * g4 + 1] += b0.y; p1[4 * g4 + 2] += b1.x; p1[4 * g4 + 3] += b1.y; }
            }
            float rm;
            { float ma = __builtin_fmaxf(p0[0], p1[0]), mb = __builtin_fmaxf(p0[1], p1[1]);
#pragma unroll
              for (int r = 2; r < 16; r += 2) { asm("v_max3_f32 %0, %1, %2, %3" : "=v"(ma) : "v"(ma), "v"(p0[r]), "v"(p1[r])); asm("v_max3_f32 %0, %1, %2, %3" : "=v"(mb) : "v"(mb), "v"(p0[r + 1]), "v"(p1[r + 1])); }
              rm = __builtin_fmaxf(ma, mb); }
            rm = fmaxf(rm, __shfl_xor(rm, 32));
            if (first || __any(rm > 8.0f)) {
                const float dl = first ? rm : fmaxf(rm, 0.f);
                mhat += dl;
#pragma unroll
                for (int r = 0; r < 16; ++r) { p0[r] -= dl; p1[r] -= dl; }
                const float f = __builtin_amdgcn_exp2f(-dl); l *= f;
                if (!first) {
                    if (hi == 0) wsf[r32] = f;
#pragma unroll
                    for (int r = 0; r < 16; ++r) { const float fr = wsf[crow(r, hi)]; o[0][r] *= fr; o[1][r] *= fr; }
                }
                c0 = bfar - mhat; first = false;
            }
            float sacc = 0.f;
#pragma unroll
            for (int r = 0; r < 16; ++r) { p0[r] = __builtin_amdgcn_exp2f(p0[r]); p1[r] = __builtin_amdgcn_exp2f(p1[r]); sacc += p0[r] + p1[r]; }
            l += sacc;
            v4u pw[4];
            pw[0].x = cvtpk(p0[0], p0[1]); pw[0].y = cvtpk(p0[2], p0[3]); pw[0].z = cvtpk(p0[4], p0[5]); pw[0].w = cvtpk(p0[6], p0[7]);
            pw[1].x = cvtpk(p0[8], p0[9]); pw[1].y = cvtpk(p0[10], p0[11]); pw[1].z = cvtpk(p0[12], p0[13]); pw[1].w = cvtpk(p0[14], p0[15]);
            pw[2].x = cvtpk(p1[0], p1[1]); pw[2].y = cvtpk(p1[2], p1[3]); pw[2].z = cvtpk(p1[4], p1[5]); pw[2].w = cvtpk(p1[6], p1[7]);
            pw[3].x = cvtpk(p1[8], p1[9]); pw[3].y = cvtpk(p1[10], p1[11]); pw[3].z = cvtpk(p1[12], p1[13]); pw[3].w = cvtpk(p1[14], p1[15]);
#pragma unroll
            for (int n = 4; n < 8; ++n) { const LAS unsigned char* vb = buf + 8192 + n * 1024 + voff; va[n] = vtr(vb); vc[n] = vtr(vb + 512); }
            __builtin_amdgcn_s_setprio(1);
#pragma unroll
            for (int d0 = 0; d0 < 2; ++d0)
#pragma unroll
                for (int s = 0; s < 4; ++s) { const int n = d0 * 4 + s;
                    const bf16x8 vf = (bf16x8){va[n][0], va[n][1], va[n][2], va[n][3], vc[n][0], vc[n][1], vc[n][2], vc[n][3]};
                    o[d0] = __builtin_amdgcn_mfma_f32_32x32x16_bf16(__builtin_bit_cast(bf16x8, pw[s]), vf, o[d0], 0, 0, 0); }
            __builtin_amdgcn_s_setprio(0);
        }
        if (kt == 3 && active) {
            l += __shfl_xor(l, 32);
            LAS unsigned* so = (LAS unsigned*)ost;
#pragma unroll
            for (int r = 0; r < 16; ++r) so[crow(r, hi) * 32 + r32] = cvtpk(o[0][r], o[1][r]);
#pragma unroll
            for (int it = 0; it < 4; ++it) { const int row = it * 8 + (lane >> 3), ch = lane & 7;
                const v4u v = *(const LAS v4u*)(ost + row * 128 + ch * 16);
                const int pr = prow_s[row];
                bf16* dst = pr >= 0 ? PO + (size_t)pr * 64 + ch * 8 : trash + row * 64 + ch * 8;
                *(GAS v4u*)dst = v; }
            { const int pr = prow_s[r32]; float* pl = (hi == 0 && pr >= 0) ? PL + (size_t)pr * 2 : (float*)trash + lane * 2; *(GAS f32x2*)pl = (f32x2){mhat, l}; }
            stored_prev = true;
        }
    }
#undef MOBA_DMA
#undef MOBA_GLDS
#undef MOBA_PREP
    VM_WAIT(); LDS_WAIT(); __syncthreads();
#pragma unroll 1
    for (int id0 = tid; id0 < nq * 8; id0 += 2048) {
        f32x4 La[4], Lb[4]; v4u pv[4][4]; size_t tokv[4]; int nselv[4];
#pragma unroll
        for (int u = 0; u < 4; ++u) { const int id = id0 + 512 * u, qu = id >> 3; const int i = lo + (qu >> 8); nselv[u] = i < 3 ? i : 3;
            tokv[u] = tokb + (size_t)lo * MBLK + qu; const size_t pr = (tokv[u] * NH + h) * 4;
            La[u] = __builtin_nontemporal_load((const f32x4*)(PL + pr * 2)); Lb[u] = __builtin_nontemporal_load((const f32x4*)(PL + pr * 2 + 4));
#pragma unroll
            for (int s = 0; s < 4; ++s) pv[u][s] = __builtin_nontemporal_load((const v4u*)(PO + (pr + s) * 64 + (id & 7) * 8)); }
#pragma unroll
        for (int u = 0; u < 4; ++u) { const int id = id0 + 512 * u, ch = id & 7; const int nsel = nselv[u];
            const float Ms[4] = {La[u].x, La[u].z, Lb[u].x, Lb[u].z}, Ls[4] = {La[u].y, La[u].w, Lb[u].y, Lb[u].w}; float Mm = Ms[3];
#pragma unroll
            for (int s = 0; s < 3; ++s) if (s < nsel) Mm = fmaxf(Mm, Ms[s]);
            float acc[8]; float W = 0.f;
#pragma unroll
            for (int e = 0; e < 8; ++e) acc[e] = 0.f;
#pragma unroll
            for (int s = 0; s < 4; ++s) { if (s == 3 || s < nsel) { const float wgt = __builtin_amdgcn_exp2f(Ms[s] - Mm); W += wgt * Ls[s]; const v4u v = pv[u][s];
                acc[0] += wgt * bflo(v.x); acc[1] += wgt * bflo(v.y); acc[2] += wgt * bflo(v.z); acc[3] += wgt * bflo(v.w);
                acc[4] += wgt * bfhi(v.x); acc[5] += wgt * bfhi(v.y); acc[6] += wgt * bfhi(v.z); acc[7] += wgt * bfhi(v.w); } }
            const float rw = 1.0f / W; v2u oa, ob;
            oa.x = pk2(acc[0] * rw, acc[1] * rw); oa.y = pk2(acc[2] * rw, acc[3] * rw); ob.x = pk2(acc[4] * rw, acc[5] * rw); ob.y = pk2(acc[6] * rw, acc[7] * rw);
            bf16* orow = F.U + tokv[u] * (CW + AW) + CW + h * 64 + ch * 4;
            *(GAS v2u*)orow = oa; *(GAS v2u*)(orow + 32) = ob; }
    }
    __syncthreads();
}
__device__ __forceinline__ void phase(Frame& F) {
    const int nun = (BATCH * NH * 4 - (int)blockIdx.x + F.G - 1) / F.G;
#pragma unroll 1
    for (int n = 0; n < nun; ++n) {
        const int id = blockIdx.x + n * F.G; const int x = id & 7, k = (id >> 3) & 31; const int bh = 8 * x + (k >> 2), g = k & 3;
        const int lo = g == 0 ? 0 : (g == 1 ? 10 : (g == 2 ? 18 : 24)), hb = g == 0 ? 10 : (g == 1 ? 18 : (g == 2 ? 24 : 32));
        unit(F, bh >> 3, bh & 7, lo, hb);
    }
}
}

struct Args { const float* in[13]; float* out; unsigned char* ws; int ph_lo, ph_hi; };
__global__ void __launch_bounds__(NWAVES * 64, 2) fwd_kernel(Args args) {
    extern __shared__ __attribute__((aligned(16))) unsigned char lds[];
    Frame F;
    F.lds = (LAS unsigned char*)lds;
    F.tid = threadIdx.x; F.lane = F.tid & 63; F.wave = __builtin_amdgcn_readfirstlane(F.tid >> 6);
    F.G = gridDim.x; { const int bx = blockIdx.x; F.vcu = (F.G % 8 == 0) ? (bx % 8) * (F.G / 8) + bx / 8 : bx; }
    unsigned char* ws = args.ws;
    F.x = args.in[0]; F.g_pre1 = args.in[1]; F.w_in = args.in[2]; F.conv_w = args.in[3]; F.w_cout = args.in[4]; F.w_aout = args.in[5]; F.rel_bias = args.in[6];
    F.w_o = args.in[7]; F.g_post1 = args.in[8]; F.g_pre2 = args.in[9]; F.w1 = args.in[10]; F.w2 = args.in[11]; F.g_post2 = args.in[12]; F.out = args.out;
    F.Win_t = (bf16*)(ws + WS_WIN); F.Wc_t = (bf16*)(ws + WS_WC); F.Wa_t = (bf16*)(ws + WS_WA); F.Wo_t = (bf16*)(ws + WS_WO); F.W1_t = (bf16*)(ws + WS_W1); F.W2_t = (bf16*)(ws + WS_W2);
    F.XN = (bf16*)(ws + WS_XN); F.PROJ = (bf16*)(ws + WS_PROJ); F.U = (bf16*)(ws + WS_U); F.O = (bf16*)(ws + WS_O); F.M1 = (bf16*)args.out; F.MIX = (bf16*)(ws + WS_PROJ);
    F.HB = (bf16*)(ws + WS_H); F.FB = (bf16*)(ws + WS_PROJ); F.T5 = (float*)(ws + WS_T5); F.KM = (float*)(ws + WS_KM); F.part = ws + WS_PART; F.X1B = (bf16*)(ws + WS_U); F.convctr = (unsigned*)(ws + WS_CTL) + 1024; F.RS2 = (float*)(ws + WS_PART + 40 * MiB); F.RS1 = (float*)(ws + WS_PART + 41 * MiB); F.GT = (bf16*)(ws + WS_PROJ + 384 * MiB);
    const int lo = args.ph_lo, hi = args.ph_hi;
    { volatile LAS unsigned* st = (volatile LAS unsigned*)(F.lds + LDS_BARST); if (F.tid == 0) { st[0] = 0u; st[1] = 0u; } }
    __syncthreads();
    XcdBarrier bar = xcd_barrier_post((unsigned*)(ws + WS_CTL) + CW_BAR, (volatile LAS unsigned*)(F.lds + LDS_BARST));
    unsigned* gmask = (unsigned*)(ws + WS_CTL) + 2048;
    if (F.tid == 0) (void)__hip_atomic_fetch_or(gmask + 64 * (blockIdx.x & 7), 1u << bar.x, __ATOMIC_RELAXED, __HIP_MEMORY_SCOPE_AGENT);
    bool local = false;
#ifndef PH_MASK
#define PH_MASK 0x3ff
#endif
#define IN(k) ((((PH_MASK) >> (k)) & 1) && lo <= (k) && (k) < hi)
#define GRID_BAR(k) do { if (IN(k) && (IN((k) + 1) || ((k) == 1 && IN(3)))) { xcd_barrier(bar); } } while (0)
#define LOCAL_BAR(k) do { if (IN(k) && (IN((k) + 1) || ((k) == 1 && IN(3)))) { if (local) xcd_barrier_local(bar); else xcd_barrier(bar); } } while (0)
#ifndef REP_MASK
#define REP_MASK 0
#endif
#define RUNPH(k, ...) do { if (IN(k)) { __VA_ARGS__; if ((REP_MASK >> (k)) & 1) { xcd_barrier(bar); __VA_ARGS__; } } } while (0)
    RUNPH(0, p0_prologue(F)); GRID_BAR(0);
    if (lo == 0 && hi >= 10) {
        volatile LAS unsigned* st = (volatile LAS unsigned*)(F.lds + LDS_BARST);
        if (F.tid == 0) { unsigned ok = (gridDim.x == 256u) ? 1u : 0u, un = 0u;
#pragma unroll
            for (int k = 0; k < 8; ++k) { const unsigned m = xb_ld(gmask + 64 * k); ok &= (m != 0u && (m & (m - 1u)) == 0u) ? 1u : 0u; un |= m; }
            ok &= (__builtin_popcount(un) == 8) ? 1u : 0u; ok &= (st[0] == 32u) ? 1u : 0u;
            st[2] = ok; }
        __syncthreads();
        local = __builtin_amdgcn_readfirstlane((int)st[2]) != 0;
    }
    RUNPH(1, { pg8::Gemm g{F.XN, F.Win_t, M, NIN, DM}; pg8::StaticOrder S; S.init(M, NIN, F.G, (int)blockIdx.x);
        pg8::EpiB<pg8::EM_PROJ> E{F.PROJ, PPITCH, (const pg8::bf16_t*)F.GT, 0, 0, 0, F.KM, F.RS1};
        pg8::gemm_phase<pg8::EpiB<pg8::EM_PROJ>, pg8::StaticOrder, false, true>(F.lds, g, S, E); }); LOCAL_BAR(1);
    RUNPH(3, { moba2::phase(F); conv_tail(F); }); GRID_BAR(3);
    RUNPH(4, { pg8::Gemm g{F.U, F.Wc_t, M, DM, CW + AW}; pg8::StaticOrder S; S.init(M, DM, F.G, (int)blockIdx.x);
        pg8::EpiB<pg8::EM_GATE2> E{F.M1, DM, (const pg8::bf16_t*)F.GT, 0, 0, 0};
        pg8::gemm_phase<pg8::EpiB<pg8::EM_GATE2>, pg8::StaticOrder, true, true>(F.lds, g, S, E); }); LOCAL_BAR(4);
    RUNPH(5, { pg8::Gemm g{F.M1, F.Wo_t, M, DM, DM}; pg8::StaticOrder S; S.init(M, DM, F.G, (int)blockIdx.x);
        pg8::EpiB<pg8::EM_PLAIN> E{F.MIX, DM, nullptr, 0, 0};
        pg8::gemm_phase<pg8::EpiB<pg8::EM_PLAIN>, pg8::StaticOrder, true, true>(F.lds, g, S, E); }); GRID_BAR(5);
    RUNPH(6, p6_norms(F)); LOCAL_BAR(6);
    RUNPH(7, { pg8::Gemm g{F.X1B, F.W1_t, M, FF, DM}; pg8::StaticOrder S; S.init(M, FF, F.G, (int)blockIdx.x);
        pg8::EpiB<pg8::EM_RELU2> E{F.HB, FF, nullptr, 0, 0, 0, nullptr, F.RS2, FF / 256};
        pg8::gemm_phase<pg8::EpiB<pg8::EM_RELU2>, pg8::StaticOrder, false, true>(F.lds, g, S, E); }); LOCAL_BAR(7);
    RUNPH(8, { pg8::Gemm g{F.HB, F.W2_t, M, DM, FF}; pg8::StaticOrder S; S.init(M, DM, F.G, (int)blockIdx.x);
        pg8::EpiB<pg8::EM_PLAIN> E{F.FB, DM, nullptr, 0, 0};
        pg8::gemm_phase<pg8::EpiB<pg8::EM_PLAIN>, pg8::StaticOrder, true, true, true>(F.lds, g, S, E); }); LOCAL_BAR(8);
    if (IN(9)) { p9_final(F); }
#undef IN
#undef GRID_BAR
#undef LOCAL_BAR
}

#ifndef MK_N_LAUNCHES
#define MK_N_LAUNCHES 1
#endif
extern "C" void kernel_launch(void* const* d_in, const int* in_sizes, int n_in, void* d_out, int out_size, void* d_ws, size_t ws_size, hipStream_t stream) {
    static int grid = 0;
    if (grid == 0) {
        if (n_in != 13 || in_sizes[0] != M * DM || out_size != M * DM || ws_size < WS_END) { fprintf(stderr, "kernel_launch: unexpected shapes (n_in %d, in0 %d, out %d, ws %zu)\n", n_in, n_in > 0 ? in_sizes[0] : -1, out_size, ws_size); grid = -1; return; }
        int dev = 0, cus = 0, per_cu = 0;
        if (hipGetDevice(&dev) != hipSuccess || hipDeviceGetAttribute(&cus, hipDeviceAttributeMultiprocessorCount, dev) != hipSuccess) { grid = -1; return; }
        if (hipFuncSetAttribute((const void*)fwd_kernel, hipFuncAttributeMaxDynamicSharedMemorySize, LDS_BYTES) != hipSuccess) { fprintf(stderr, "kernel_launch: hipFuncSetAttribute failed\n"); grid = -1; return; }
        if (hipOccupancyMaxActiveBlocksPerMultiprocessor(&per_cu, (const void*)fwd_kernel, NWAVES * 64, LDS_BYTES) != hipSuccess || per_cu < 1) { fprintf(stderr, "kernel_launch: occupancy query says %d blocks per CU\n", per_cu); (void)hipGetLastError(); per_cu = 1; }
        if (per_cu > 1) per_cu = 1;
        grid = cus * per_cu;
    }
    if (grid < 0) return;
    if (hipMemsetAsync((char*)d_ws + WS_CTL, 0, CTL_ZERO_BYTES, stream) != hipSuccess) { fprintf(stderr, "kernel_launch: hipMemsetAsync failed\n"); return; }
    Args a{};
    for (int i = 0; i < 13; ++i) a.in[i] = (const float*)d_in[i];
    a.out = (float*)d_out; a.ws = (unsigned char*)d_ws;
#if MK_N_LAUNCHES == 1
    a.ph_lo = 0; a.ph_hi = N_PHASES;
    void* kargs[] = {&a};
    hipError_t e = hipLaunchCooperativeKernel((const void*)fwd_kernel, dim3(grid), dim3(NWAVES * 64), kargs, LDS_BYTES, stream);
    if (e != hipSuccess) fprintf(stderr, "kernel_launch: cooperative launch failed: %s (grid %d)\n", hipGetErrorString(e), grid);
#else
    for (int p = 0; p < N_PHASES; ++p) { a.ph_lo = p; a.ph_hi = p + 1;
        void* kargs[] = {&a};
        hipError_t e = hipLaunchCooperativeKernel((const void*)fwd_kernel, dim3(grid), dim3(NWAVES * 64), kargs, LDS_BYTES, stream);
        if (e != hipSuccess) { fprintf(stderr, "kernel_launch: launch %d failed: %s\n", p, hipGetErrorString(e)); break; } }
#endif
}
```

```cpp
#include <hip/hip_runtime.h>
#include <cstdio>
#include <cstdint>
namespace pg8 {
#define PG8_LAS __attribute__((address_space(3)))
typedef unsigned short bf16_t;
typedef short bf16x8 __attribute__((ext_vector_type(8)));
typedef float f32x4 __attribute__((ext_vector_type(4)));
typedef unsigned u32x4 __attribute__((ext_vector_type(4)));
constexpr int BM = 256, BK = 64, HALF = 128, HTB = HALF * BK * 2  , STAGE_BYTES = 8 * HTB, NXCD = 8, WGM = 8;

__host__ __device__ __forceinline__ int lds_byte(int r, int c) { const int st = (r >> 4) * 2 + (c >> 5), rr = r & 15, cc = c & 31, ob = rr * 64 + cc * 2; return st * 1024 + (ob ^ (((ob >> 9) & 1) << 5)); }
__host__ __device__ __forceinline__ void stage_rc(int b, int& R, int& C) { const int st = b / 1024, sb = b % 1024, swz = sb ^ (((sb >> 9) & 1) << 5); R = (st >> 1) * 16 + swz / 64; C = (st & 1) * 32 + (swz % 64) / 2; }
__host__ __device__ __forceinline__ int perm32(int rho) { const int n = rho >> 4, i = rho & 15; return 8 * (i >> 2) + 4 * n + (i & 3); }

struct Unit { int pm, pn; };
struct Gemm { const bf16_t* A; const bf16_t* Bt; int M, N, K; };

struct StaticOrder {
    int nM, nN, nwg, G, c;
    __host__ __device__ void init(int M, int N, int G_, int c_) { nM = M / BM; nN = N / BM; nwg = nM * nN; G = G_; c = c_; }
    __host__ __device__ bool next(int i, Unit& u) const {
        const long L = (long)i * G + c; if (L >= nwg) return false;
        int wgid = (int)L; { const int q = nwg / NXCD, r = nwg % NXCD, xcd = wgid % NXCD, off = wgid / NXCD; wgid = (xcd < r ? xcd * (q + 1) : r * (q + 1) + (xcd - r) * q) + off; }
        const int nig = WGM * nN, gid = wgid / nig, fm = gid * WGM, gsz = (nM - fm) < WGM ? (nM - fm) : WGM;
        u.pm = fm + ((wgid % nig) % gsz); u.pn = (wgid % nig) / gsz; return true;
    }
    __device__ __forceinline__ void a_ready(const Unit&) const {}
    __device__ __forceinline__ void done(const Unit&) const {}
};

__device__ __forceinline__ unsigned cvt_pk_bf16(float lo, float hi) { unsigned r; asm volatile("v_cvt_pk_bf16_f32 %0, %1, %2" : "=v"(r) : "v"(lo), "v"(hi)); return r; }
typedef float f32x2 __attribute__((ext_vector_type(2)));
__device__ __forceinline__ float bf_lo(unsigned w) { return __uint_as_float(w << 16); }
__device__ __forceinline__ float bf_hi(unsigned w) { return __uint_as_float(w & 0xffff0000u); }
constexpr float QSCALE = 0.125f * 1.4426950408889634f;
enum { EM_PROJ = 0, EM_GATE = 1, EM_GATEADD = 2, EM_PLAIN = 3, EM_RELU2 = 4, EM_GATE2 = 5 };
template <int MODE> struct EpiB {
    static constexpr bool PERM = true, AFTER_DRAIN = false, HAS_MID = (MODE == EM_GATE2), ROWS = (MODE == EM_PROJ || MODE == EM_RELU2), PREFETCH = (MODE == EM_GATE2);
    bf16_t* O; int ldc; const bf16_t* G; int ldg; int goff; int goff2 = 0; float* KMp = nullptr; const float* rowscale = nullptr; int otile = 0;
    __device__ __forceinline__ void operator()(f32x4 (&acc)[2][2][4][2], const Unit& u, int wr, int wc, int fr, int fq, const PG8_LAS float* rsl = nullptr) const {
        const int row0 = u.pm * BM + wr * 64 + fr, col0 = u.pn * BM + wc * 32 + 8 * fq;
        float rsq[2][4];
        if (MODE == EM_PROJ) {
#pragma unroll
            for (int ai = 0; ai < 2; ++ai)
#pragma unroll
                for (int m = 0; m < 4; ++m) { const float r_ = rsl[wr * 64 + fr + ai * HALF + m * 16];
#pragma unroll
                    for (int bj = 0; bj < 2; ++bj) { acc[ai][bj][m][0] = acc[ai][bj][m][0] * r_; acc[ai][bj][m][1] = acc[ai][bj][m][1] * r_; } } }
        if (MODE == EM_RELU2) {
#pragma unroll
            for (int ai = 0; ai < 2; ++ai)
#pragma unroll
                for (int m = 0; m < 4; ++m) { const float r_ = rsl[wr * 64 + fr + ai * HALF + m * 16]; rsq[ai][m] = r_ * r_; } }
        u32x4 gpre[2][4][2];
        if (MODE == EM_GATE2) {
#pragma unroll
            for (int ai = 0; ai < 2; ++ai)
#pragma unroll
                for (int m = 0; m < 4; ++m)
#pragma unroll
                    for (int bj = 0; bj < 2; ++bj) gpre[ai][m][bj] = *(const u32x4*)(G + (((((((size_t)u.pm * 8 + (2 * u.pn + bj)) * 2 + 1) * 2 + ai) * 4 + m) * 8 + (wr * 4 + wc)) * 64 + (fq * 16 + fr)) * 8); }
        int pmode = 0; if (MODE == EM_PROJ) { pmode = (u.pn >= 12) ? 2 : ((u.pn == 6 || u.pn == 7) ? 1 : (u.pn < 4 ? 3 : 0)); }
        if (MODE == EM_PROJ) { if (u.pn == 8 || u.pn == 9) {
            float cs[2][2][4];
#pragma unroll
            for (int bj = 0; bj < 2; ++bj)
#pragma unroll
                for (int n = 0; n < 2; ++n)
#pragma unroll
                    for (int e = 0; e < 4; ++e) { float t = 0.f;
#pragma unroll
                        for (int ai = 0; ai < 2; ++ai)
#pragma unroll
                            for (int m = 0; m < 4; ++m) t += acc[ai][bj][m][n][e];
                        t += __shfl_xor(t, 1); t += __shfl_xor(t, 2); t += __shfl_xor(t, 4); t += __shfl_xor(t, 8); cs[bj][n][e] = t; }
            if (fr == 0) { float* kp = KMp + (size_t)u.pm * 512 + (u.pn - 8) * BM + wc * 32 + 8 * fq;
#pragma unroll
                for (int bj = 0; bj < 2; ++bj)
#pragma unroll
                    for (int n = 0; n < 2; ++n)
#pragma unroll
                        for (int e = 0; e < 4; ++e) atomicAdd(kp + bj * HALF + 4 * n + e, cs[bj][n][e]); }
        } }
#pragma unroll
        for (int ai = 0; ai < 2; ++ai)
#pragma unroll
            for (int m = 0; m < 4; ++m) { const size_t row = (size_t)(row0 + ai * HALF + m * 16);
#pragma unroll
                for (int bj = 0; bj < 2; ++bj) { f32x4 v0 = acc[ai][bj][m][0], v1 = acc[ai][bj][m][1]; const int col = col0 + bj * HALF;
                    if (MODE == EM_PROJ) {
                        if (pmode == 3) { if (bj == 1) continue; v0 = v0 * acc[ai][1][m][0]; v1 = v1 * acc[ai][1][m][1]; }
                        if (pmode == 1) { v0 = v0 * QSCALE; v1 = v1 * QSCALE; }
                        else if (pmode == 2) {
                            const f32x4 a0 = acc[ai][1][m][0], a1 = acc[ai][1][m][1];
#pragma unroll
                            for (int e = 0; e < 4; ++e) {
                                const float ea0 = 1.0f + __builtin_amdgcn_exp2f(-1.4426950408889634f * a0[e]), ea1 = 1.0f + __builtin_amdgcn_exp2f(-1.4426950408889634f * a1[e]);
                                if (bj == 0) { v0[e] = ea0 * __builtin_amdgcn_rcpf(1.0f + __builtin_amdgcn_exp2f(-1.4426950408889634f * v0[e])); v1[e] = ea1 * __builtin_amdgcn_rcpf(1.0f + __builtin_amdgcn_exp2f(-1.4426950408889634f * v1[e])); }
                                else { v0[e] = __builtin_amdgcn_rcpf(ea0); v1[e] = __builtin_amdgcn_rcpf(ea1); } }
                        }
                    }
                    if (MODE == EM_RELU2) {
#pragma unroll
                        for (int e = 0; e < 4; ++e) { float a, b; asm("v_max_f32 %0, 0, %1" : "=v"(a) : "v"(v0[e])); asm("v_max_f32 %0, 0, %1" : "=v"(b) : "v"(v1[e])); v0[e] = a * a * rsq[ai][m]; v1[e] = b * b * rsq[ai][m]; }
                    }
                    if (MODE == EM_GATE || MODE == EM_GATEADD || MODE == EM_GATE2) {
                        const u32x4 g = (MODE == EM_GATE2) ? gpre[ai][m][bj] : *(const u32x4*)(G + row * (size_t)ldg + (goff + col));
                        v0[0] *= bf_lo(g.x); v0[1] *= bf_hi(g.x); v0[2] *= bf_lo(g.y); v0[3] *= bf_hi(g.y);
                        v1[0] *= bf_lo(g.z); v1[1] *= bf_hi(g.z); v1[2] *= bf_lo(g.w); v1[3] *= bf_hi(g.w);
                        if (MODE == EM_GATEADD) { const u32x4 o = *(const u32x4*)(O + row * (size_t)ldc + col);
                            v0[0] += bf_lo(o.x); v0[1] += bf_hi(o.x); v0[2] += bf_lo(o.y); v0[3] += bf_hi(o.y);
                            v1[0] += bf_lo(o.z); v1[1] += bf_hi(o.z); v1[2] += bf_lo(o.w); v1[3] += bf_hi(o.w); }
                    }
                    u32x4 w; w.x = cvt_pk_bf16(v0[0], v0[1]); w.y = cvt_pk_bf16(v0[2], v0[3]); w.z = cvt_pk_bf16(v1[0], v1[1]); w.w = cvt_pk_bf16(v1[2], v1[3]);
                    if (MODE == EM_PROJ && pmode == 2) {
                        const size_t vi = ((((((size_t)u.pm * 8 + (u.pn - 12)) * 2 + bj) * 2 + ai) * 4 + m) * 8 + (wr * 4 + wc)) * 64 + (fq * 16 + fr);
                        __builtin_nontemporal_store(w, (u32x4*)((bf16_t*)G + vi * 8));
                    } else if (otile > 0) {
                        __builtin_nontemporal_store(w, (u32x4*)(O + ((size_t)u.pm * otile + u.pn) * 65536 + (size_t)(row - (size_t)u.pm * BM) * 256 + (col - u.pn * BM)));
                    } else if (MODE == EM_PROJ)
                    __builtin_nontemporal_store(w, (u32x4*)(O + row * (size_t)ldc + ((pmode == 3) ? (HALF * u.pn + wc * 32 + 8 * fq) : col)));
                    else
                    *(u32x4*)(O + row * (size_t)ldc + col) = w; }
                if (MODE == EM_GATE || MODE == EM_GATEADD) asm volatile("" ::: "memory"); }
    }
    __device__ __forceinline__ void prefetch(const Unit& u, int s_, PG8_LAS unsigned char* dump, int wid, int lane) const {
        { s_ &= 31;
          const int kind = s_ >> 4, ai = (s_ >> 3) & 1, m = (s_ >> 1) & 3, bj = s_ & 1;
            const bf16_t* src = G + (((((((size_t)u.pm * 8 + (2 * u.pn + bj)) * 2 + kind) * 2 + ai) * 4 + m) * 8 + wid) * 64 + lane) * 8;
            __builtin_amdgcn_global_load_lds((const unsigned*)src, (PG8_LAS unsigned*)dump, 16, 0, 0); }
    }
    __device__ __forceinline__ void mid(f32x4 (&acc)[2][2][4][2], const Unit& u, int wr, int wc, int fr, int fq) const {
        const bf16_t* gp = G + ((((size_t)u.pm * 8 + 2 * u.pn) * 2 * 2 * 4 * 8 + (wr * 4 + wc)) * 64 + (fq * 16 + fr)) * 8;
#pragma unroll
        for (int ai = 0; ai < 2; ++ai) {
            asm volatile("" : "+v"(gp));
            u32x4 g1[4][2];
#pragma unroll
            for (int m = 0; m < 4; ++m)
#pragma unroll
                for (int bj = 0; bj < 2; ++bj) g1[m][bj] = *(const u32x4*)(gp + ((size_t)bj * (2 * 2 * 4 * 8) + (ai * 4 + m) * 8) * 64 * 8);
#pragma unroll
            for (int m = 0; m < 4; ++m)
#pragma unroll
                for (int bj = 0; bj < 2; ++bj) { const u32x4 g = g1[m][bj];
                    f32x4& v0 = acc[ai][bj][m][0]; f32x4& v1 = acc[ai][bj][m][1];
                    v0[0] *= bf_lo(g.x); v0[1] *= bf_hi(g.x); v0[2] *= bf_lo(g.y); v0[3] *= bf_hi(g.y);
                    v1[0] *= bf_lo(g.z); v1[1] *= bf_hi(g.z); v1[2] *= bf_lo(g.w); v1[3] *= bf_hi(g.w); }
            asm volatile("" ::: "memory"); }
    }
};
template <class Epi, class Sched, bool ALIGN_EPI = false, bool SP2 = false, bool ATILE = false>
__device__ __forceinline__ void gemm_phase(PG8_LAS unsigned char* lds, const Gemm g, const Sched& S, const Epi& E) {
    const int tid = threadIdx.x, wid = __builtin_amdgcn_readfirstlane(tid >> 6), lane = tid & 63, wr = wid >> 2, wc = wid & 3, fr = lane & 15, fq = lane >> 4;
    const int K = g.K, nt = K / BK;
    unsigned voffA[2], voffB[2];
#pragma unroll
    for (int i = 0; i < 2; ++i) { int R, C; stage_rc(tid * 16 + i * 8192, R, C); const int Rb = Epi::PERM ? ((R & ~31) + perm32(R & 31)) : R;
        voffA[i] = (unsigned)(R * (ATILE ? 256 : K) + C) * 2u; voffB[i] = (unsigned)(Rb * K + C) * 2u; }
    const size_t kstep = (size_t)(BK * 2);
    const size_t hstep = (size_t)HALF * K * 2;
    const size_t tstep = 2 * hstep;
    const size_t hstepA = ATILE ? (size_t)HALF * 256 * 2 : hstep;
#define PG8_AK(t_) (ATILE ? ((size_t)((t_) >> 2) * 131072 + (size_t)((t_) & 3) * 128) : (size_t)(t_) * kstep)
    const unsigned ldsw = (unsigned)wid * 1024u;
    const int aoff = lds_byte(wr * 64 + fr, fq * 8), boff = lds_byte(wc * 32 + fr, fq * 8);
#define PG8_SA(b, h) (((b) * 2 + (h)) * HTB)
#define PG8_SB(b, h) ((4 + (b) * 2 + (h)) * HTB)
#define PG8_STAGE(bufoff, gbase, voff) do { _Pragma("unroll") for (int _i = 0; _i < 2; ++_i) \
        __builtin_amdgcn_global_load_lds((const unsigned*)((const char*)(gbase) + (voff)[_i]), (PG8_LAS unsigned*)(lds + (bufoff) + ldsw + _i * 8192), 16, 0, 0); } while (0)
#define PG8_LDA(dst, b, h) do { _Pragma("unroll") for (int m = 0; m < 4; ++m) _Pragma("unroll") for (int k = 0; k < 2; ++k) dst[m][k] = *(const PG8_LAS bf16x8*)(lds + PG8_SA(b, h) + aoff + m * 2048 + k * 1024); } while (0)
#define PG8_LDB(dst, b, h) do { _Pragma("unroll") for (int n = 0; n < 2; ++n) _Pragma("unroll") for (int k = 0; k < 2; ++k) dst[n][k] = *(const PG8_LAS bf16x8*)(lds + PG8_SB(b, h) + boff + n * 2048 + k * 1024); } while (0)
#define PG8_MMA(ai, bj, At, Bt) do { __builtin_amdgcn_s_setprio(1); _Pragma("unroll") for (int m = 0; m < 4; ++m) _Pragma("unroll") for (int n = 0; n < 2; ++n) _Pragma("unroll") for (int k = 0; k < 2; ++k) \
        acc[ai][bj][m][n] = __builtin_amdgcn_mfma_f32_16x16x32_bf16(Bt[n][k], At[m][k], acc[ai][bj][m][n], 0, 0, 0); __builtin_amdgcn_s_setprio(0); } while (0)
#define PG8_WAIT_V(n) asm volatile("s_waitcnt vmcnt(" #n ")" ::: "memory")
#define PG8_WAIT_L(n) asm volatile("s_waitcnt lgkmcnt(" #n ")" ::: "memory")
#define PG8_WAIT_VP do { if constexpr (Epi::PREFETCH) PG8_WAIT_V(10); else PG8_WAIT_V(8); } while (0)
#define PG8_PF(s_) do { if constexpr (Epi::PREFETCH) E.prefetch(cur, (s_), lds + STAGE_BYTES + 4096 + wid * 1024, wid, lane); } while (0)
#define PG8_BAR __builtin_amdgcn_s_barrier()
#define PG8_SCHED __builtin_amdgcn_sched_barrier(0)
    Unit cur, nxt; int ui = 0;
    if (!S.next(0, cur)) return;
    f32x4 acc[2][2][4][2];
#pragma unroll
    for (int a = 0; a < 2; ++a)
#pragma unroll
        for (int b = 0; b < 2; ++b)
#pragma unroll
            for (int m = 0; m < 4; ++m)
#pragma unroll
                for (int n = 0; n < 2; ++n) acc[a][b][m][n] = (f32x4){0.f, 0.f, 0.f, 0.f};
    bf16x8 At[4][2], B0[2][2], B1[2][2];
    const char* cA = (const char*)g.A + (size_t)cur.pm * tstep; const char* cB = (const char*)g.Bt + (size_t)cur.pn * tstep;
    S.a_ready(cur);
    const PG8_LAS float* rsl = nullptr;
#define PG8_ROWS(unit_, par_) do { if constexpr (Epi::ROWS) { const float* gsrc_ = E.rowscale + (size_t)(unit_).pm * BM + (wid & 3) * 64 + lane; \
        __builtin_amdgcn_global_load_lds((const unsigned*)gsrc_, (PG8_LAS unsigned*)(lds + STAGE_BYTES + (par_) * 2048 + (wid >> 2) * 1024 + (wid & 3) * 256), 4, 0, 0); \
        rsl = (const PG8_LAS float*)(lds + STAGE_BYTES + (par_) * 2048); } } while (0)
    PG8_ROWS(cur, 0);
    if constexpr (SP2) {
        PG8_STAGE(PG8_SB(0, 0), cB, voffB); PG8_STAGE(PG8_SB(0, 1), cB + hstep, voffB); PG8_STAGE(PG8_SA(0, 0), cA, voffA); PG8_STAGE(PG8_SA(0, 1), cA + hstepA, voffA);
        if (wr == 1) PG8_BAR;
        PG8_WAIT_V(2); PG8_BAR;
        PG8_STAGE(PG8_SB(1, 0), cB + kstep, voffB); PG8_STAGE(PG8_SA(1, 0), cA + kstep, voffA); PG8_STAGE(PG8_SB(1, 1), cB + hstep + kstep, voffB);
        PG8_WAIT_V(6); PG8_BAR;
    } else {
        PG8_STAGE(PG8_SB(0, 0), cB, voffB); PG8_STAGE(PG8_SA(0, 0), cA, voffA); PG8_STAGE(PG8_SB(0, 1), cB + hstep, voffB); PG8_STAGE(PG8_SA(0, 1), cA + hstepA, voffA);
        if (wr == 1) PG8_BAR;
        PG8_WAIT_V(4); PG8_BAR;
        PG8_STAGE(PG8_SB(1, 0), cB + kstep, voffB); PG8_STAGE(PG8_SA(1, 0), cA + kstep, voffA); PG8_STAGE(PG8_SB(1, 1), cB + hstep + kstep, voffB);
        PG8_WAIT_V(6); PG8_BAR;
    }
    for (;;) {
        const bool has_next = S.next(ui + 1, nxt);
        const char* nA = has_next ? (const char*)g.A + (size_t)nxt.pm * tstep : cA; const char* nB = has_next ? (const char*)g.Bt + (size_t)nxt.pn * tstep : cB;
        for (int t = 0; t < nt; t += 2) {
            const bool last = (t == nt - 2);
            const char* a1 = cA + PG8_AK(t + 1);
            const char* a2 = last ? nA : cA + PG8_AK(t + 2); const char* b2 = last ? nB : cB + (size_t)(t + 2) * kstep;
            const char* a3 = a2 + kstep; const char* b3 = b2 + kstep;
            if (last && has_next) S.a_ready(nxt);
            if constexpr (Epi::HAS_MID) { if (t == nt / 2) E.mid(acc, cur, wr, wc, fr, fq); }
            if constexpr (SP2) {
            PG8_LDB(B0, 0, 0); PG8_LDB(B1, 0, 1); PG8_SCHED; PG8_LDA(At, 0, 0); PG8_STAGE(PG8_SA(1, 1), a1 + hstepA, voffA); PG8_PF(2 * t);
            PG8_WAIT_VP; PG8_WAIT_L(0); PG8_BAR; PG8_MMA(0, 0, At, B0); PG8_MMA(0, 1, At, B1); PG8_BAR; PG8_SCHED;
            PG8_LDA(At, 0, 1); PG8_STAGE(PG8_SB(0, 0), b2, voffB); PG8_STAGE(PG8_SB(0, 1), b2 + hstep, voffB); PG8_STAGE(PG8_SA(0, 0), a2, voffA); PG8_PF(2 * t + 1);
            PG8_WAIT_VP; PG8_WAIT_L(0); PG8_BAR; PG8_MMA(1, 0, At, B0); PG8_MMA(1, 1, At, B1); PG8_BAR; PG8_SCHED;
            PG8_LDB(B0, 1, 0); PG8_LDB(B1, 1, 1); PG8_SCHED; PG8_LDA(At, 1, 0); PG8_STAGE(PG8_SA(0, 1), a2 + hstepA, voffA); PG8_PF(2 * t + 2);
            PG8_WAIT_VP; PG8_WAIT_L(0); PG8_BAR; PG8_MMA(0, 0, At, B0); PG8_MMA(0, 1, At, B1); PG8_BAR; PG8_SCHED;
            PG8_LDA(At, 1, 1); PG8_STAGE(PG8_SB(1, 0), b3, voffB); PG8_STAGE(PG8_SB(1, 1), b3 + hstep, voffB); PG8_STAGE(PG8_SA(1, 0), a3, voffA); PG8_PF(2 * t + 3);
            PG8_WAIT_VP; PG8_WAIT_L(0); PG8_BAR; PG8_MMA(1, 0, At, B0); PG8_MMA(1, 1, At, B1); PG8_BAR; PG8_SCHED;
            } else {
            PG8_LDB(B0, 0, 0); PG8_SCHED; PG8_LDA(At, 0, 0); PG8_STAGE(PG8_SA(1, 1), a1 + hstepA, voffA);
            PG8_WAIT_L(8); PG8_BAR; PG8_WAIT_L(0); PG8_MMA(0, 0, At, B0); PG8_BAR; PG8_SCHED;
            PG8_LDB(B1, 0, 1); PG8_STAGE(PG8_SB(0, 0), b2, voffB);
            PG8_BAR; PG8_WAIT_L(0); PG8_MMA(0, 1, At, B1); PG8_BAR;
            PG8_LDA(At, 0, 1); PG8_STAGE(PG8_SA(0, 0), a2, voffA);
            PG8_BAR; PG8_WAIT_L(0); PG8_MMA(1, 0, At, B0); PG8_BAR; PG8_SCHED;
            PG8_STAGE(PG8_SB(0, 1), b2 + hstep, voffB);
            PG8_WAIT_V(6); PG8_BAR; PG8_MMA(1, 1, At, B1); PG8_BAR;
            PG8_LDB(B0, 1, 0); PG8_SCHED; PG8_LDA(At, 1, 0); PG8_STAGE(PG8_SA(0, 1), a2 + hstepA, voffA);
            PG8_WAIT_L(8); PG8_BAR; PG8_WAIT_L(0); PG8_MMA(0, 0, At, B0); PG8_BAR; PG8_SCHED;
            PG8_LDB(B1, 1, 1); PG8_STAGE(PG8_SB(1, 0), b3, voffB);
            PG8_BAR; PG8_WAIT_L(0); PG8_MMA(0, 1, At, B1); PG8_BAR;
            PG8_LDA(At, 1, 1); PG8_STAGE(PG8_SA(1, 0), a3, voffA);
            PG8_BAR; PG8_WAIT_L(0); PG8_MMA(1, 0, At, B0); PG8_BAR; PG8_SCHED;
            PG8_STAGE(PG8_SB(1, 1), b3 + hstep, voffB);
            PG8_WAIT_V(6); PG8_BAR; PG8_MMA(1, 1, At, B1); PG8_BAR;
            }
        }
        if constexpr (ALIGN_EPI) { if (wr == 0) PG8_BAR; }
        if constexpr (!Epi::AFTER_DRAIN) { if constexpr (Epi::ROWS) E(acc, cur, wr, wc, fr, fq, rsl); else E(acc, cur, wr, wc, fr, fq); S.done(cur); }
        if (!has_next) break;
#pragma unroll
        for (int a = 0; a < 2; ++a)
#pragma unroll
            for (int b = 0; b < 2; ++b)
#pragma unroll
                for (int m = 0; m < 4; ++m)
#pragma unroll
                    for (int n = 0; n < 2; ++n) acc[a][b][m][n] = (f32x4){0.f, 0.f, 0.f, 0.f};
        cur = nxt; cA = nA; cB = nB; ++ui;
        PG8_ROWS(cur, ui & 1);
        if constexpr (ALIGN_EPI) { if (wr == 1) PG8_BAR; }
    }
    PG8_WAIT_V(0);
    if constexpr (!ALIGN_EPI) { if (wr == 0) PG8_BAR; }
    PG8_BAR;
    if constexpr (Epi::AFTER_DRAIN) { E.fused(acc, cur, wr, wc, fr, fq, lds, wid, lane); S.done(cur); }
#undef PG8_ROWS
#undef PG8_AK
#undef PG8_SA
#undef PG8_SB
#undef PG8_STAGE
#undef PG8_LDA
#undef PG8_LDB
#undef PG8_MMA
#undef PG8_WAIT_V
#undef PG8_WAIT_L
#undef PG8_WAIT_VP
#undef PG8_PF
#undef PG8_BAR
#undef PG8_SCHED
}
}

constexpr int NWAVES = 8;
constexpr int PPITCH = 3072;
constexpr int BATCH = 8, SEQ = 8192, DM = 1024, NIN = 5120, CW = 512, AW = 512, FF = 4096, NH = 8, HD = 64, MBLK = 256, NBLK = SEQ / MBLK;
constexpr int M = BATCH * SEQ;
constexpr int C_U = 0, C_GBN = 1024;
constexpr int C_XIN = 0, C_GB = 512, C_GC = 1024, C_Q = 1536, C_K = 2048, C_V = 2560, C_GCONV = 3072, C_GATTN = 4096;
constexpr float RMS_EPS = 1e-6f, LOG2E = 1.4426950408889634f;
constexpr int N_PHASES = 10;

constexpr size_t MiB = 1u << 20;
constexpr size_t WS_CTL = 0, CTL_ZERO_BYTES = 65536;
constexpr int CW_BAR = 4096;
constexpr size_t WS_T5 = 1 * MiB, WS_KM = 1 * MiB + 65536;
constexpr size_t WS_WIN = 2 * MiB, WS_WC = 12 * MiB, WS_WA = 13 * MiB, WS_WO = 14 * MiB, WS_W1 = 16 * MiB, WS_W2 = 24 * MiB;
constexpr size_t WS_XN = 32 * MiB;
constexpr size_t WS_PROJ = 160 * MiB;
constexpr size_t WS_H = 288 * MiB;
constexpr size_t WS_U = 800 * MiB, WS_O = 864 * MiB;
constexpr size_t WS_PART = 928 * MiB, PART_STRIDE = 131072 + 4096;
constexpr size_t WS_END = 1024 * MiB;

constexpr int LDS_BYTES = 155648;
constexpr int LDS_BARST = LDS_BYTES - 64;

#define GAS __attribute__((address_space(1)))
#define LAS __attribute__((address_space(3)))
typedef unsigned short bf16;
typedef unsigned v4u __attribute__((ext_vector_type(4)));
typedef unsigned v2u __attribute__((ext_vector_type(2)));
typedef float f32x4 __attribute__((ext_vector_type(4)));
typedef float f32x2 __attribute__((ext_vector_type(2)));
typedef float f32x16 __attribute__((ext_vector_type(16)));
typedef short bf16x8 __attribute__((ext_vector_type(8)));
typedef short s16x4 __attribute__((ext_vector_type(4)));
#define LDS_WAIT() asm volatile("s_waitcnt lgkmcnt(0)" ::: "memory")
#define VM_WAIT() asm volatile("s_waitcnt vmcnt(0)" ::: "memory")
__device__ __forceinline__ unsigned f2bf(float f) { unsigned u = __builtin_bit_cast(unsigned, f); return (u + 0x7fffu + ((u >> 16) & 1u)) >> 16; }
__device__ __forceinline__ unsigned pk2(float lo, float hi) { return f2bf(lo) | (f2bf(hi) << 16); }
__device__ __forceinline__ float bflo(unsigned w) { return __uint_as_float(w << 16); }
__device__ __forceinline__ float bfhi(unsigned w) { return __uint_as_float(w & 0xffff0000u); }

#define XB_TMO      128
#define XB_XCNT(j)  (256  + 64 * (j))
#define XB_XSUB(j)  (1280 + 64 * (j))
#define XB_XGEN(j)  (2304 + 64 * (j))
#define XB_TOP      3328
#define XB_TOPGEN   3392
#define XCD_BAR_WORDS 3456
#define XB_SPIN_CAP (1u << 18)

__device__ __forceinline__ unsigned xb_ld(unsigned* p)              { return __hip_atomic_load(p, __ATOMIC_RELAXED, __HIP_MEMORY_SCOPE_AGENT); }
__device__ __forceinline__ unsigned xb_add(unsigned* p, unsigned v) { return __hip_atomic_fetch_add(p, v, __ATOMIC_RELAXED, __HIP_MEMORY_SCOPE_AGENT); }
__device__ __forceinline__ unsigned xb_xcc_id() { return (unsigned)__builtin_amdgcn_s_getreg((3 << 11) | 20) & 0xFu; }
#define XB_SPIN(cond, bar) do { unsigned _sp = 0; while (cond) { __builtin_amdgcn_s_sleep(1); \
    if ((++_sp & 255u) == 0u) { if (xb_ld(&(bar)[XB_TMO])) break; if (_sp > XB_SPIN_CAP) { atomicAdd(&(bar)[XB_TMO], 1u); break; } } } } while (0)

struct XcdBarrier {
    unsigned* bar; unsigned x;
    volatile LAS unsigned* st;
};

__device__ __forceinline__ XcdBarrier xcd_barrier_post(unsigned* bar, volatile LAS unsigned* st) {
    XcdBarrier b; b.bar = bar; b.x = xb_xcc_id(); b.st = st;
    if (threadIdx.x == 0) (void)xb_add(&bar[XB_XCNT(b.x)], 1u);
    return b;
}
__device__ __forceinline__ void xcd_barrier_complete(unsigned* bar, unsigned x, unsigned& nloc, unsigned& nx) {
    const unsigned G = gridDim.x * gridDim.y * gridDim.z;
    unsigned sum, cnt, mine, sp = 0u;
    for (;;) {
        sum = 0u; cnt = 0u; mine = 0u;
#pragma unroll
        for (unsigned j = 0; j < 16; ++j) { const unsigned c = xb_ld(&bar[XB_XCNT(j)]); sum += c; cnt += (c > 0u) ? 1u : 0u; mine = (j == x) ? c : mine; }
        if (sum == G) break;
        __builtin_amdgcn_s_sleep(1);
        if ((++sp & 255u) == 0u) { if (xb_ld(&bar[XB_TMO])) break; if (sp > XB_SPIN_CAP) { atomicAdd(&bar[XB_TMO], 1u); break; } }
    }
    nloc = mine > 0u ? mine : 1u; nx = cnt > 0u ? cnt : 1u;
}

__device__ __forceinline__ void xcd_barrier(const XcdBarrier& b) {
    asm volatile("s_waitcnt vmcnt(0)" ::: "memory");
    __syncthreads();
    if (threadIdx.x == 0) {
        unsigned* bar = b.bar;
        __builtin_amdgcn_s_waitcnt(0);
        unsigned nloc = b.st[0], nx = b.st[1];
        if (nloc == 0u) { xcd_barrier_complete(bar, b.x, nloc, nx); b.st[0] = nloc; b.st[1] = nx; }
        const unsigned old = xb_add(&bar[XB_XSUB(b.x)], 1u);
        const unsigned gen = old / nloc;
        if (old + 1u == (gen + 1u) * nloc) {
            __builtin_amdgcn_fence(__ATOMIC_RELEASE, "agent");
            asm volatile("s_waitcnt vmcnt(0)" ::: "memory");
            const unsigned og = xb_add(&bar[XB_TOP], 1u);
            const unsigned tg = og / nx;
            if (og + 1u == (tg + 1u) * nx) xb_add(&bar[XB_TOPGEN], 1u);
            else XB_SPIN(xb_ld(&bar[XB_TOPGEN]) == tg, bar);
            __builtin_amdgcn_fence(__ATOMIC_ACQUIRE, "agent");
            xb_add(&bar[XB_XGEN(b.x)], 1u);
            asm volatile("s_waitcnt vmcnt(0)" ::: "memory");
        } else {
            XB_SPIN(xb_ld(&bar[XB_XGEN(b.x)]) == gen, bar);
            __builtin_amdgcn_fence(__ATOMIC_ACQUIRE, "agent");
            asm volatile("s_waitcnt vmcnt(0)" ::: "memory");
        }
    }
    __syncthreads();
}

__device__ __forceinline__ void xcd_barrier_local(const XcdBarrier& b) {
    asm volatile("s_waitcnt vmcnt(0)" ::: "memory");
    __syncthreads();
    if (threadIdx.x == 0) {
        unsigned* bar = b.bar;
        __builtin_amdgcn_s_waitcnt(0);
        const unsigned nloc = b.st[0];
        const unsigned old = xb_add(&bar[XB_XSUB(b.x)], 1u);
        const unsigned gen = old / nloc;
        if (old + 1u == (gen + 1u) * nloc) xb_add(&bar[XB_XGEN(b.x)], 1u);
        else XB_SPIN(xb_ld(&bar[XB_XGEN(b.x)]) == gen, bar);
        __builtin_amdgcn_fence(__ATOMIC_ACQUIRE, "agent");
        asm volatile("s_waitcnt vmcnt(0)" ::: "memory");
    }
    __syncthreads();
}

struct Frame {
    LAS unsigned char* lds;
    int tid, lane, wave, vcu, G;
    const float *x, *g_pre1, *w_in, *conv_w, *w_cout, *w_aout, *rel_bias, *w_o, *g_post1, *g_pre2, *w1, *w2, *g_post2;
    float* out;
    bf16 *Win_t, *Wc_t, *Wa_t, *Wo_t, *W1_t, *W2_t;
    bf16 *XN, *PROJ, *U, *O, *M1, *MIX, *HB, *FB, *X1B, *GT;
    float *T5, *KM, *RS2, *RS1; unsigned* convctr;
    unsigned char* part;
};

__device__ __forceinline__ float wave_sum(float v) {
#pragma unroll
    for (int o = 1; o < 64; o <<= 1) v += __shfl_xor(v, o);
    return v;
}
__device__ __forceinline__ void p0_transpose_item(const float* W, int K, int N, bf16* WT, LAS float* scr, int item, int lane, int ldk = 0, int koff = 0, bool gate_il = false, const float* kgain = nullptr) {
    if (ldk == 0) ldk = K;
    const int nblk = N / 32, kb = item / nblk, nb = item % nblk, k0 = 64 * kb, n0 = 32 * nb;
    int nd0 = n0;
    if (gate_il && n0 < C_Q) { if (n0 < C_GB) nd0 = 256 * (n0 >> 7) + (n0 & 127); else if (n0 < C_GC) nd0 = C_GBN + (n0 - C_GB); else nd0 = 256 * ((n0 - C_GC) >> 7) + 128 + ((n0 - C_GC) & 127); }
    if (gate_il && n0 >= C_GCONV) { const int blk = n0 >= C_GATTN ? 1 : 0, cc = n0 - (blk ? C_GATTN : C_GCONV); nd0 = C_GCONV + 256 * (cc >> 7) + 128 * blk + (cc & 127); }
    float t[32];
#pragma unroll
    for (int i = 0; i < 32; ++i) t[i] = __builtin_nontemporal_load(W + (size_t)(k0 + 2 * i + (lane >> 5)) * N + n0 + (lane & 31));
    const int c = lane & 7;
    float g8[8];
    if (kgain) { const f32x4 ga = *(const GAS f32x4*)(kgain + k0 + 8 * c), gb = *(const GAS f32x4*)(kgain + k0 + 8 * c + 4);
        g8[0] = ga.x; g8[1] = ga.y; g8[2] = ga.z; g8[3] = ga.w; g8[4] = gb.x; g8[5] = gb.y; g8[6] = gb.z; g8[7] = gb.w; }
    else {
#pragma unroll
        for (int e = 0; e < 8; ++e) g8[e] = 1.0f; }
    __builtin_amdgcn_sched_barrier(0);
#pragma unroll
    for (int i = 0; i < 32; ++i) scr[(2 * i + (lane >> 5)) * 33 + (lane & 31)] = t[i];
    LDS_WAIT(); asm volatile("" ::: "memory");
#pragma unroll
    for (int j = 0; j < 4; ++j) { const int n = (lane >> 3) + 8 * j; const LAS float* s = scr + (8 * c) * 33 + n;
        v4u o; o.x = pk2(s[0 * 33] * g8[0], s[1 * 33] * g8[1]); o.y = pk2(s[2 * 33] * g8[2], s[3 * 33] * g8[3]); o.z = pk2(s[4 * 33] * g8[4], s[5 * 33] * g8[5]); o.w = pk2(s[6 * 33] * g8[6], s[7 * 33] * g8[7]);
        *(GAS v4u*)(WT + (size_t)(nd0 + n) * ldk + koff + k0 + 8 * c) = o; }
    LDS_WAIT(); asm volatile("" ::: "memory");
}
__device__ __forceinline__ void rms_row_to_bf16(const float* xrow, const float* gain, bf16* orow, int lane) {
    const GAS f32x4* xr = (const GAS f32x4*)xrow + lane; const GAS f32x4* gr = (const GAS f32x4*)gain + lane;
    f32x4 v[4]; float s = 0.f;
#pragma unroll
    for (int j = 0; j < 4; ++j) { v[j] = xr[64 * j]; s += (v[j].x * v[j].x + v[j].y * v[j].y) + (v[j].z * v[j].z + v[j].w * v[j].w); }
    const float rs = 1.0f / sqrtf(wave_sum(s) * (1.f / DM) + RMS_EPS);
    GAS v2u* o8 = (GAS v2u*)orow + lane;
#pragma unroll
    for (int j = 0; j < 4; ++j) { const f32x4 g = gr[64 * j]; v2u w; w.x = pk2(v[j].x * rs * g.x, v[j].y * rs * g.y); w.y = pk2(v[j].z * rs * g.z, v[j].w * rs * g.w); o8[64 * j] = w; }
}
__device__ __forceinline__ void p0_prologue(Frame& F) {
    LAS float* scr = (LAS float*)(F.lds + F.wave * 16384);
    const int gw = F.vcu * NWAVES + F.wave, NGW = F.G * NWAVES;
    constexpr int I_IN = (DM / 64) * (NIN / 32), I_C = (CW / 64) * (DM / 32), I_A = (AW / 64) * (DM / 32), I_O = (DM / 64) * (DM / 32), I_1 = (DM / 64) * (FF / 32), I_2 = (FF / 64) * (DM / 32);
    constexpr int NITEMS = I_IN + I_C + I_A + I_O + I_1 + I_2;
    for (int it = gw; it < NITEMS; it += NGW) {
        int r = it;
        if (r < I_IN) { p0_transpose_item(F.w_in, DM, NIN, F.Win_t, scr, r, F.lane, 0, 0, true, F.g_pre1); continue; } r -= I_IN;
        if (r < I_C) { p0_transpose_item(F.w_cout, CW, DM, F.Wc_t, scr, r, F.lane, CW + AW, 0); continue; } r -= I_C;
        if (r < I_A) { p0_transpose_item(F.w_aout, AW, DM, F.Wc_t, scr, r, F.lane, CW + AW, CW); continue; } r -= I_A;
        if (r < I_O) { p0_transpose_item(F.w_o, DM, DM, F.Wo_t, scr, r, F.lane); continue; } r -= I_O;
        if (r < I_1) { p0_transpose_item(F.w1, DM, FF, F.W1_t, scr, r, F.lane, 0, 0, false, F.g_pre2); continue; } r -= I_1;
        p0_transpose_item(F.w2, FF, DM, F.W2_t, scr, r, F.lane);
    }
    for (int m = gw; m < M; m += 2 * NGW) {
        const int m2 = m + NGW; const GAS f32x4* xa = (const GAS f32x4*)(F.x + (size_t)m * DM) + F.lane; const GAS f32x4* xb = (const GAS f32x4*)(F.x + (size_t)m2 * DM) + F.lane;
        f32x4 va[4], vb[4]; float sa = 0.f, sb = 0.f;
#pragma unroll
        for (int j = 0; j < 4; ++j) { va[j] = __builtin_nontemporal_load(xa + 64 * j); vb[j] = __builtin_nontemporal_load(xb + 64 * j); }
#pragma unroll
        for (int j = 0; j < 4; ++j) { sa += (va[j].x * va[j].x + va[j].y * va[j].y) + (va[j].z * va[j].z + va[j].w * va[j].w); sb += (vb[j].x * vb[j].x + vb[j].y * vb[j].y) + (vb[j].z * vb[j].z + vb[j].w * vb[j].w); }
        const float ra = 1.0f / sqrtf(wave_sum(sa) * (1.f / DM) + RMS_EPS), rb = 1.0f / sqrtf(wave_sum(sb) * (1.f / DM) + RMS_EPS);
        if (F.lane == 0) { F.RS1[m] = ra; F.RS1[m2] = rb; }
        GAS v2u* oa = (GAS v2u*)(F.XN + (size_t)m * DM) + F.lane; GAS v2u* ob = (GAS v2u*)(F.XN + (size_t)m2 * DM) + F.lane;
#pragma unroll
        for (int j = 0; j < 4; ++j) { v2u w; w.x = pk2(va[j].x, va[j].y); w.y = pk2(va[j].z, va[j].w); oa[64 * j] = w;
            w.x = pk2(vb[j].x, vb[j].y); w.y = pk2(vb[j].z, vb[j].w); ob[64 * j] = w; }
    }
    for (int e = F.vcu * 512 + F.tid; e < (M / MBLK) * 512; e += F.G * 512) F.KM[e] = 0.f;
    for (int e = F.vcu * 512 + F.tid; e < NH * 1024; e += F.G * 512) {
        const int h = e >> 10, d = e & 1023; int bk;
        if (d < 16) bk = d; else { bk = 16; const int thr[15] = {21, 27, 35, 46, 59, 77, 99, 128, 166, 216, 280, 363, 470, 609, 790};
#pragma unroll
            for (int k = 0; k < 15; ++k) bk += (d >= thr[k]) ? 1 : 0; }
        F.T5[e] = F.rel_bias[h * 32 + bk] * LOG2E;
    }
}

__device__ __forceinline__ void conv_tail(Frame& F) {
    const int c = F.lane * 8;
    float w0[8], w1[8], w2[8];
#pragma unroll
    for (int e = 0; e < 8; ++e) { w0[e] = F.conv_w[c + e]; w1[e] = F.conv_w[CW + c + e]; w2[e] = F.conv_w[2 * CW + c + e]; }
#pragma unroll 1
    for (;;) {
        const bool grp = (F.G % 8) == 0; const int gx = (int)blockIdx.x & 7;
        int rr = 0; if (F.lane == 0) rr = (int)__hip_atomic_fetch_add(F.convctr + (grp ? 64 * gx : 0), 1u, __ATOMIC_RELAXED, __HIP_MEMORY_SCOPE_AGENT);
        rr = __builtin_amdgcn_readfirstlane(rr);
        if (rr >= (grp ? SEQ / 32 : M / 32)) break;
        const int t0 = (grp ? gx * SEQ : 0) + rr * 32; const bf16* P = F.PROJ + (size_t)t0 * PPITCH + c;
        float um2[8], um1[8];
        if ((t0 % SEQ) == 0) {
#pragma unroll
            for (int e = 0; e < 8; ++e) { um2[e] = 0.f; um1[e] = 0.f; }
        } else {
            const v4u xa = *(const GAS v4u*)(P - 2 * PPITCH + C_U), xb = *(const GAS v4u*)(P - PPITCH + C_U);
            um2[0] = bflo(xa.x); um2[1] = bfhi(xa.x); um2[2] = bflo(xa.y); um2[3] = bfhi(xa.y); um2[4] = bflo(xa.z); um2[5] = bfhi(xa.z); um2[6] = bflo(xa.w); um2[7] = bfhi(xa.w);
            um1[0] = bflo(xb.x); um1[1] = bfhi(xb.x); um1[2] = bflo(xb.y); um1[3] = bfhi(xb.y); um1[4] = bflo(xb.z); um1[5] = bfhi(xb.z); um1[6] = bflo(xb.w); um1[7] = bfhi(xb.w);
        }
        bf16* Up = F.U + (size_t)t0 * (CW + AW) + c;
#pragma unroll 1
        for (int r0 = 0; r0 < 32; r0 += 4) {
            v4u xv[4], bv[4];
#pragma unroll
            for (int k = 0; k < 4; ++k) { const bf16* Pr = P + (size_t)(r0 + k) * PPITCH; xv[k] = __builtin_nontemporal_load((const GAS v4u*)(Pr + C_U)); bv[k] = __builtin_nontemporal_load((const GAS v4u*)(Pr + C_GBN)); }
#pragma unroll
            for (int k = 0; k < 4; ++k) {
                float u[8], b[8];
                u[0] = bflo(xv[k].x); u[1] = bfhi(xv[k].x); u[2] = bflo(xv[k].y); u[3] = bfhi(xv[k].y); u[4] = bflo(xv[k].z); u[5] = bfhi(xv[k].z); u[6] = bflo(xv[k].w); u[7] = bfhi(xv[k].w);
                b[0] = bflo(bv[k].x); b[1] = bfhi(bv[k].x); b[2] = bflo(bv[k].y); b[3] = bfhi(bv[k].y); b[4] = bflo(bv[k].z); b[5] = bfhi(bv[k].z); b[6] = bflo(bv[k].w); b[7] = bfhi(bv[k].w);
                float o[8];
#pragma unroll
                for (int e = 0; e < 8; ++e) { o[e] = b[e] * (w0[e] * um2[e] + w1[e] * um1[e] + w2[e] * u[e]); um2[e] = um1[e]; um1[e] = u[e]; }
                v4u w; w.x = pk2(o[0], o[1]); w.y = pk2(o[2], o[3]); w.z = pk2(o[4], o[5]); w.w = pk2(o[6], o[7]);
                *(GAS v4u*)(Up + (size_t)(r0 + k) * (CW + AW)) = w; }
        }
    }
}

__device__ __forceinline__ void p6_norms(Frame& F) {
    const int gw = F.vcu * NWAVES + F.wave, NGW = F.G * NWAVES; const bool BL = (F.G == 256); const int R2 = BL ? SEQ / 2 : NGW;
    const GAS f32x4* g1 = (const GAS f32x4*)F.g_post1 + F.lane;
    f32x4 gg[4];
#pragma unroll
    for (int j = 0; j < 4; ++j) gg[j] = g1[64 * j];
    for (int jj = 0; jj < M / (2 * NGW); ++jj) { const int m0 = BL ? (F.vcu >> 5) * SEQ + (F.vcu & 31) * NWAVES + F.wave + jj * 256 : gw + jj * 2 * NGW;
        f32x4 v[2][4], xv[2][4]; float s[2] = {0.f, 0.f};
#pragma unroll
        for (int rr = 0; rr < 2; ++rr) { const size_t m = (size_t)(m0 + rr * R2);
            const GAS v2u* mr = (const GAS v2u*)(F.MIX + m * DM) + F.lane; const GAS v2u* xr = (const GAS v2u*)(F.XN + m * DM) + F.lane;
#pragma unroll
            for (int j = 0; j < 4; ++j) { const v2u w = __builtin_nontemporal_load(mr + 64 * j); const v2u xw = __builtin_nontemporal_load(xr + 64 * j); xv[rr][j] = (f32x4){bflo(xw.x), bfhi(xw.x), bflo(xw.y), bfhi(xw.y)}; v[rr][j] = (f32x4){bflo(w.x), bfhi(w.x), bflo(w.y), bfhi(w.y)}; } }
#pragma unroll
        for (int rr = 0; rr < 2; ++rr)
#pragma unroll
            for (int j = 0; j < 4; ++j) s[rr] += (v[rr][j].x * v[rr][j].x + v[rr][j].y * v[rr][j].y) + (v[rr][j].z * v[rr][j].z + v[rr][j].w * v[rr][j].w);
        float rs[2], s2[2] = {0.f, 0.f};
#pragma unroll
        for (int rr = 0; rr < 2; ++rr) rs[rr] = 1.0f / sqrtf(wave_sum(s[rr]) * (1.f / DM) + RMS_EPS);
#pragma unroll
        for (int rr = 0; rr < 2; ++rr) { const size_t m = (size_t)(m0 + rr * R2); GAS v2u* x1row = (GAS v2u*)(F.X1B + m * DM) + F.lane;
#pragma unroll
            for (int j = 0; j < 4; ++j) { const f32x4 g = gg[j]; v[rr][j] = xv[rr][j] + v[rr][j] * rs[rr] * g; v2u w; w.x = pk2(v[rr][j].x, v[rr][j].y); w.y = pk2(v[rr][j].z, v[rr][j].w); x1row[64 * j] = w;
                s2[rr] += (v[rr][j].x * v[rr][j].x + v[rr][j].y * v[rr][j].y) + (v[rr][j].z * v[rr][j].z + v[rr][j].w * v[rr][j].w); } }
#pragma unroll
        for (int rr = 0; rr < 2; ++rr) { const size_t m = (size_t)(m0 + rr * R2); const float rs2 = 1.0f / sqrtf(wave_sum(s2[rr]) * (1.f / DM) + RMS_EPS);
            if (F.lane == 0) F.RS2[m] = rs2; }
    }
}
__device__ __forceinline__ void p9_final(Frame& F) {
    const int gw = F.vcu * NWAVES + F.wave, NGW = F.G * NWAVES; const bool BL = (F.G == 256); const int R2 = BL ? SEQ / 2 : NGW;
    const GAS f32x4* g1 = (const GAS f32x4*)F.g_post2 + F.lane;
    f32x4 gg[4];
#pragma unroll
    for (int j = 0; j < 4; ++j) gg[j] = g1[64 * j];
    for (int jj = 0; jj < M / (2 * NGW); ++jj) { const int m0 = BL ? (F.vcu >> 5) * SEQ + (F.vcu & 31) * NWAVES + F.wave + jj * 256 : gw + jj * 2 * NGW;
        f32x4 v[2][4]; v2u xw[2][4]; float s[2] = {0.f, 0.f};
#pragma unroll
        for (int rr = 0; rr < 2; ++rr) { const size_t m = (size_t)(m0 + rr * R2);
            const GAS v2u* fr = (const GAS v2u*)(F.FB + m * DM) + F.lane; const GAS v2u* x1row = (const GAS v2u*)(F.X1B + m * DM) + F.lane;
#pragma unroll
            for (int j = 0; j < 4; ++j) { const v2u w = __builtin_nontemporal_load(fr + 64 * j); xw[rr][j] = __builtin_nontemporal_load(x1row + 64 * j); v[rr][j] = (f32x4){bflo(w.x), bfhi(w.x), bflo(w.y), bfhi(w.y)}; } }
#pragma unroll
        for (int rr = 0; rr < 2; ++rr)
#pragma unroll
            for (int j = 0; j < 4; ++j) s[rr] += (v[rr][j].x * v[rr][j].x + v[rr][j].y * v[rr][j].y) + (v[rr][j].z * v[rr][j].z + v[rr][j].w * v[rr][j].w);
#pragma unroll
        for (int rr = 0; rr < 2; ++rr) { const size_t m = (size_t)(m0 + rr * R2); const float rs = 1.0f / sqrtf(wave_sum(s[rr]) * (1.f / DM) + RMS_EPS);
            GAS f32x4* orow = (GAS f32x4*)(F.out + m * DM) + F.lane;
#pragma unroll
            for (int j = 0; j < 4; ++j) { const f32x4 g = gg[j]; const f32x4 x1 = (f32x4){bflo(xw[rr][j].x), bfhi(xw[rr][j].x), bflo(xw[rr][j].y), bfhi(xw[rr][j].y)}; orow[64 * j] = x1 + v[rr][j] * rs * g; } }
    }
}

namespace moba2 {
constexpr int NSLOT = 3, SLOTB = 16384;
constexpr int L_RING = 0;
constexpr int L_OST = NSLOT * SLOTB;
constexpr int L_QST = L_OST + NWAVES * 4096;
constexpr int TXMAX = 1343, TLEN = TXMAX + 65;
constexpr int L_TB = L_QST + NWAVES * 4096;
constexpr int L_LIST = L_TB + 2 * TLEN * 4;
constexpr int L_SEL = L_LIST + 15360;
constexpr int L_WSF = L_SEL + 10240;
constexpr int L_CNT = L_WSF + NWAVES * 256;
constexpr int L_RTAB = L_CNT + 512;
constexpr int L_MISC = L_RTAB + 384;
constexpr int L_END = L_MISC + 64;
static_assert(L_END <= LDS_BARST, "attention LDS map");
__device__ __forceinline__ int crow(int r, int hi) { return (r & 3) + 8 * (r >> 2) + 4 * hi; }
typedef short v4i16_t __attribute__((ext_vector_type(4)));
__device__ __forceinline__ s16x4 vtr(const LAS unsigned char* p) { return __builtin_bit_cast(s16x4, __builtin_amdgcn_ds_read_tr16_b64_v4i16((LAS v4i16_t*)p)); }
typedef float f32x2_t __attribute__((ext_vector_type(2))); typedef __bf16 bf16x2_t __attribute__((ext_vector_type(2)));
__device__ __forceinline__ unsigned cvtpk(float lo, float hi) { f32x2_t v = {lo, hi}; bf16x2_t b = __builtin_convertvector(v, bf16x2_t); return __builtin_bit_cast(unsigned, b); }

__device__ __forceinline__ void unit(Frame& F, int b, int h, int lo, int hi_blk) {
    LAS unsigned char* lds = F.lds;
    LAS float* tb = (LAS float*)(lds + L_TB); LAS unsigned short* list = (LAS unsigned short*)(lds + L_LIST); LAS unsigned* selw = (LAS unsigned*)(lds + L_SEL);
    LAS float* wsf = (LAS float*)(lds + L_WSF) + F.wave * 64;
    LAS int* cnt = (LAS int*)(lds + L_CNT); LAS int* off = cnt + 32; LAS int* cur = cnt + 64; LAS unsigned* rtab = (LAS unsigned*)(lds + L_RTAB); LAS int* misc = (LAS int*)(lds + L_MISC);
    const int lane = F.lane, r32 = lane & 31, hi = lane >> 5, tid = F.tid, w = F.wave;
    const int nblk = hi_blk - lo, nq = nblk * MBLK;
    const size_t tokb = (size_t)b * SEQ;
    bf16* PO = (bf16*)F.out; float* PL = (float*)F.part;
    if (tid < 96) cnt[tid] = 0;
    { constexpr int NTB = (2 * TLEN + 511) / 512; float tv[NTB];
#pragma unroll
      for (int k = 0; k < NTB; ++k) { const int e = tid + 512 * k, sft = e >= TLEN ? 1 : 0, x = e - sft * TLEN + sft; int d = TXMAX - x; d = d < 0 ? 0 : (d > 1023 ? 1023 : d); tv[k] = F.T5[h * 1024 + d]; }
      __builtin_amdgcn_sched_barrier(0);
#pragma unroll
      for (int k = 0; k < NTB; ++k) { const int e = tid + 512 * k, sft = e >= TLEN ? 1 : 0, x = e - sft * TLEN + sft, d = TXMAX - x; if (e < 2 * TLEN) tb[e] = d < 0 ? -INFINITY : tv[k]; } }
    __syncthreads();
    {
        bf16x8 kmh[4], kml[4];
        f32x4 kav[4], kbv[4];
#pragma unroll
        for (int d0 = 0; d0 < 4; ++d0) { const float* kmp = F.KM + ((size_t)(b * NBLK + r32) * 512 + h * 64 + d0 * 16 + hi * 8); kav[d0] = *(const GAS f32x4*)kmp; kbv[d0] = *(const GAS f32x4*)(kmp + 4); }
        __builtin_amdgcn_sched_barrier(0);
#pragma unroll
        for (int d0 = 0; d0 < 4; ++d0) {
            const f32x4 ka = kav[d0], kb = kbv[d0];
            const float kf[8] = {ka.x, ka.y, ka.z, ka.w, kb.x, kb.y, kb.z, kb.w}; unsigned hb[8], lb[8];
#pragma unroll
            for (int e = 0; e < 8; ++e) { hb[e] = f2bf(kf[e]); lb[e] = f2bf(kf[e] - __uint_as_float(hb[e] << 16)); }
            v4u hw, lw; hw.x = hb[0] | (hb[1] << 16); hw.y = hb[2] | (hb[3] << 16); hw.z = hb[4] | (hb[5] << 16); hw.w = hb[6] | (hb[7] << 16);
            lw.x = lb[0] | (lb[1] << 16); lw.y = lb[2] | (lb[3] << 16); lw.z = lb[4] | (lb[5] << 16); lw.w = lb[6] | (lb[7] << 16);
            kmh[d0] = __builtin_bit_cast(bf16x8, hw); kml[d0] = __builtin_bit_cast(bf16x8, lw);
        }
        const bf16* qsel = F.PROJ + (tokb + (size_t)lo * MBLK + r32) * PPITCH + C_Q + h * 64 + hi * 8;
        bf16x8 qc[4];
#pragma unroll
        for (int d0 = 0; d0 < 4; ++d0) qc[d0] = *(const GAS bf16x8*)(qsel + (size_t)(w * 32) * PPITCH + d0 * 16);
#pragma unroll 1
        for (int tq = w; tq < nq / 32; tq += NWAVES) {
            const int i = lo + (tq >> 3); const int qu = tq * 32 + r32;
            const int tn = (tq + NWAVES < nq / 32) ? tq + NWAVES : tq;
            bf16x8 qn[4];
#pragma unroll
            for (int d0 = 0; d0 < 4; ++d0) qn[d0] = *(const GAS bf16x8*)(qsel + (size_t)(tn * 32) * PPITCH + d0 * 16);
            __builtin_amdgcn_sched_barrier(0);
            f32x16 g = f32x16{};
#pragma unroll
            for (int d0 = 0; d0 < 4; ++d0) { const bf16x8 qf = qc[d0];
                g = __builtin_amdgcn_mfma_f32_32x32x16_bf16(kmh[d0], qf, g, 0, 0, 0); g = __builtin_amdgcn_mfma_f32_32x32x16_bf16(kml[d0], qf, g, 0, 0, 0); }
#pragma unroll
            for (int d0 = 0; d0 < 4; ++d0) qc[d0] = qn[d0];
            float v0 = -INFINITY, v1 = -INFINITY, v2 = -INFINITY; int j0 = 0, j1 = 0, j2 = 0;
#define MOBA_INS(xg_, jj_) do { const float xg = (xg_); const int jj = (jj_); const bool c0 = xg > v0, c1 = xg > v1, c2 = xg > v2; \
            const float nv2 = c1 ? v1 : (c2 ? xg : v2), nv1 = c0 ? v0 : (c1 ? xg : v1), nv0 = c0 ? xg : v0; \
            const int nj2 = c1 ? j1 : (c2 ? jj : j2), nj1 = c0 ? j0 : (c1 ? jj : j1), nj0 = c0 ? jj : j0; \
            v0 = nv0; v1 = nv1; v2 = nv2; j0 = nj0; j1 = nj1; j2 = nj2; } while (0)
#pragma unroll
            for (int r = 0; r < 16; ++r) { const int jc = crow(r, hi); MOBA_INS(jc < i ? g[r] : -INFINITY, jc); }
            { const float u0 = __shfl_xor(v0, 32), u1 = __shfl_xor(v1, 32), u2 = __shfl_xor(v2, 32); const int k0 = __shfl_xor(j0, 32), k1 = __shfl_xor(j1, 32), k2 = __shfl_xor(j2, 32);
              MOBA_INS(u0, k0); MOBA_INS(u1, k1); MOBA_INS(u2, k2); }
#undef MOBA_INS
            if (hi == 0) {
                const int nsel = i < 3 ? i : 3;
                selw[qu] = (unsigned)j0 | ((unsigned)j1 << 5) | ((unsigned)j2 << 10);
                if (nsel > 0) __hip_atomic_fetch_add(cnt + j0, 1, __ATOMIC_RELAXED, __HIP_MEMORY_SCOPE_WORKGROUP);
                if (nsel > 1) __hip_atomic_fetch_add(cnt + j1, 1, __ATOMIC_RELAXED, __HIP_MEMORY_SCOPE_WORKGROUP);
                if (nsel > 2) __hip_atomic_fetch_add(cnt + j2, 1, __ATOMIC_RELAXED, __HIP_MEMORY_SCOPE_WORKGROUP);
            }
        }
    }
    __syncthreads();
    if (w == 0) {
        const int c = lane < 32 ? cnt[lane & 31] : 0; const int nt = (c + 31) >> 5, nr = (nt + 7) >> 3;
        int inc = c, incr = nr;
#pragma unroll
        for (int o2 = 1; o2 < 32; o2 <<= 1) { const int t = __shfl_up(inc, o2), t2 = __shfl_up(incr, o2); if ((lane & 31) >= o2) { inc += t; incr += t2; } }
        if (lane < 32) { off[lane] = inc - c; cur[lane] = inc - c;
            for (int r = 0; r < nr; ++r) rtab[nblk + incr - nr + r] = (unsigned)lane | ((unsigned)(r * 8) << 8) | ((unsigned)nt << 16); }
        if (lane < nblk) rtab[lane] = (unsigned)(lo + lane) | 0x80000000u;
        if (lane == 31) misc[0] = nblk + incr;
    }
    __syncthreads();
    for (int qu = tid; qu < nq; qu += 512) {
        const int i = lo + (qu >> 8); const int nsel = i < 3 ? i : 3; const unsigned s = selw[qu];
        if (nsel > 0) { const int p = __hip_atomic_fetch_add(cur + (s & 31), 1, __ATOMIC_RELAXED, __HIP_MEMORY_SCOPE_WORKGROUP); list[p] = (unsigned short)(qu | (0 << 12)); }
        if (nsel > 1) { const int p = __hip_atomic_fetch_add(cur + ((s >> 5) & 31), 1, __ATOMIC_RELAXED, __HIP_MEMORY_SCOPE_WORKGROUP); list[p] = (unsigned short)(qu | (1 << 12)); }
        if (nsel > 2) { const int p = __hip_atomic_fetch_add(cur + ((s >> 10) & 31), 1, __ATOMIC_RELAXED, __HIP_MEMORY_SCOPE_WORKGROUP); list[p] = (unsigned short)(qu | (2 << 12)); }
    }
    __syncthreads();
    const int nrounds = __builtin_amdgcn_readfirstlane(misc[0]), NT = nrounds * 4;
    const char* kvh = (const char*)(F.PROJ + tokb * PPITCH + h * 64);
    const int kkey = 8 * w + (lane >> 3), kch = (lane & 7) ^ ((kkey >> 1) & 7);
    const int vkey = 16 * (w & 3) + (lane >> 2);
    const unsigned ksrc_off = (unsigned)(kkey * PPITCH + C_K + kch * 8) * 2u, vsrc_off = (unsigned)(vkey * PPITCH + C_V + (w >> 2) * 32 + (lane & 3) * 8) * 2u;
    const unsigned lds0 = (unsigned)(uintptr_t)lds;
#define MOBA_GLDS(gsrc_, dst_) do { unsigned keep_; asm volatile("s_mov_b32 %0, m0\n\ts_mov_b32 m0, %2\n\ts_nop 0\n\tglobal_load_lds_dwordx4 %1, off\n\ts_mov_b32 m0, %0" : "=&s"(keep_) : "v"(gsrc_), "s"(dst_) : "memory"); } while (0)
#define MOBA_DMA(jj_, kt_, sl_) do { const char* tb_ = kvh + (size_t)((jj_) * MBLK + (kt_) * 64) * (PPITCH * 2); \
        const unsigned kd_ = (unsigned)__builtin_amdgcn_readfirstlane(lds0 + L_RING + (sl_) * SLOTB + w * 1024), vd_ = (unsigned)__builtin_amdgcn_readfirstlane(lds0 + L_RING + (sl_) * SLOTB + 8192 + w * 1024); \
        MOBA_GLDS(tb_ + ksrc_off, kd_); MOBA_GLDS(tb_ + vsrc_off, vd_); } while (0)
    const int koff = r32 * 128, ksw = (r32 >> 1) & 7;
    const int voff = (4 * hi + ((lane & 15) >> 2)) * 64 + ((lane >> 4) & 1) * 32 + (lane & 3) * 8;
    LAS unsigned char* ost = lds + L_OST + w * 4096;
    LAS int* prow_s = (LAS int*)(wsf + 32);
    bool active = false, near = false, stored_prev = false; int dq = 0, kt_max = 3, jcur = 0, jnext = 0;
    bool n_active = false, n_near = false; int n_dq = 0, n_prow = -1, n_ktmax = 3;
    bf16x8 qf[4]; float mhat = 0.f, l = 0.f, c0 = 0.f, bfar = 0.f; f32x16 o[2]; bool first = true;
    o[0] = f32x16{}; o[1] = f32x16{};
    const unsigned qst0 = lds0 + L_QST + w * 4096; const LAS unsigned char* qst = lds + L_QST + w * 4096;
    bf16* trash = (bf16*)(F.part + 16 * MiB) + (size_t)(blockIdx.x * NWAVES + w) * 2048;
    const char* qbase = (const char*)(F.PROJ + (tokb + (size_t)lo * MBLK) * PPITCH + C_Q + h * 64) + (lane & 7) * 16;
    const int prow_base = (int)(((tokb + (size_t)lo * MBLK) * NH + h) * 4);
#define MOBA_PREP(R_) do { const unsigned re = (unsigned)__builtin_amdgcn_readfirstlane((int)rtab[(R_)]); const int j = re & 31; const bool own = (re >> 31) != 0; int qu, slot, base = 0, lim = 0; bool vld; \
        jnext = j; \
        if (own) { n_active = true; vld = true; qu = (j - lo) * MBLK + w * 32 + r32; slot = 3; n_near = true; n_ktmax = w >> 1; n_dq = w * 32 + r32; } \
        else { const int t0 = (re >> 8) & 255, nt = (re >> 16) & 255; const int tile = t0 + w; n_active = tile < nt; \
            const int cj = __builtin_amdgcn_readfirstlane(cnt[j]), pos = tile * 32 + r32; vld = n_active && pos < cj; base = __builtin_amdgcn_readfirstlane(off[j]) + (n_active ? tile * 32 : 0); lim = n_active ? cj - tile * 32 : 1; \
            const unsigned le = list[base + (vld ? r32 : 0)]; qu = le & 4095; slot = le >> 12; \
            const int i = lo + (qu >> 8); n_ktmax = 3; n_dq = (i - j) * MBLK + (qu & 255); n_near = __any((j + 5 > i) && n_active) != 0; } \
        n_prow = vld ? prow_base + qu * (NH * 4) + slot : -1; \
        _Pragma("unroll") for (int n_ = 0; n_ < 4; ++n_) { const int rho = 8 * n_ + (lane >> 3); int qr; \
            if (own) qr = (j - lo) * MBLK + w * 32 + rho; else qr = list[base + (rho < lim ? rho : 0)] & 4095; \
            const char* src = qbase + (unsigned)qr * (unsigned)(PPITCH * 2); \
            const unsigned qd_ = (unsigned)__builtin_amdgcn_readfirstlane(qst0 + n_ * 1024); MOBA_GLDS(src, qd_); } } while (0)
    MOBA_PREP(0); jcur = jnext;
    MOBA_DMA(jcur, 0, 0); MOBA_DMA(jcur, 1, 1);
    asm volatile("s_waitcnt vmcnt(0)" ::: "memory");
#pragma unroll 1
    for (int T = 0; T < NT; ++T) {
        const int kt = T & 3;
        if (kt == 2) asm volatile("s_waitcnt vmcnt(2) lgkmcnt(0)" ::: "memory");
        else if (kt == 3) asm volatile("s_waitcnt vmcnt(6) lgkmcnt(0)" ::: "memory");
        else if (__builtin_amdgcn_readfirstlane((int)stored_prev)) asm volatile("s_waitcnt vmcnt(7) lgkmcnt(0)" ::: "memory");
        else asm volatile("s_waitcnt vmcnt(2) lgkmcnt(0)" ::: "memory");
        __builtin_amdgcn_s_barrier(); asm volatile("" ::: "memory");
        if (kt == 2) { const int Rn = (T >> 2) + 1; MOBA_PREP(Rn < nrounds ? Rn : nrounds - 1); }
        { const int sl = (T + 2) % NSLOT; if (kt < 2) MOBA_DMA(jcur, kt + 2, sl); else MOBA_DMA(jnext, kt - 2, sl); }
        if (kt == 0) {
            active = n_active; near = n_near; dq = n_dq; kt_max = n_ktmax;
            if (hi == 0) prow_s[r32] = n_prow;
#pragma unroll
            for (int d0 = 0; d0 < 4; ++d0) qf[d0] = *(const LAS bf16x8*)(qst + r32 * 128 + (2 * d0 + hi) * 16);
            bfar = near ? 0.f : tb[TXMAX - 1023]; mhat = 0.f; l = 0.f; c0 = bfar; first = true; o[0] = f32x16{}; o[1] = f32x16{};
        }
        if (kt == 3) jcur = jnext;
        if (kt == 1) stored_prev = false;
        if (active && kt <= kt_max) {
            const LAS unsigned char* buf = lds + L_RING + (T % NSLOT) * SLOTB;
            bf16x8 ka[4], kb[4];
#pragma unroll
            for (int d0 = 0; d0 < 4; ++d0) { const int co = ((2 * d0 + hi) ^ ksw) * 16; ka[d0] = *(const LAS bf16x8*)(buf + koff + co); kb[d0] = *(const LAS bf16x8*)(buf + 4096 + koff + co); }
            f32x16 p0, p1;
#pragma unroll
            for (int r = 0; r < 16; ++r) { p0[r] = c0; p1[r] = c0; }
            __builtin_amdgcn_s_setprio(1);
#pragma unroll
            for (int d0 = 0; d0 < 4; ++d0) { p0 = __builtin_amdgcn_mfma_f32_32x32x16_bf16(ka[d0], qf[d0], p0, 0, 0, 0); p1 = __builtin_amdgcn_mfma_f32_32x32x16_bf16(kb[d0], qf[d0], p1, 0, 0, 0); }
            __builtin_amdgcn_s_setprio(0);
            s16x4 va[8], vc[8];
#pragma unroll
            for (int n = 0; n < 4; ++n) { const LAS unsigned char* vb = buf + 8192 + n * 1024 + voff; va[n] = vtr(vb); vc[n] = vtr(vb + 512); }
            __builtin_amdgcn_sched_barrier(0);
            if (near) {
                int D0 = dq - 64 * kt - 4 * hi; D0 = D0 > 1279 ? 1279 : D0;
                const int x0 = TXMAX - D0, sft = x0 & 1;
                const LAS float* tp = tb + sft * TLEN + (x0 - sft);
#pragma unroll
                for (int g4 = 0; g4 < 4; ++g4) {
                    const f32x2 a0 = *(const LAS f32x2*)(tp + 8 * g4), a1 = *(const LAS f32x2*)(tp + 8 * g4 + 2), b0 = *(const LAS f32x2*)(tp + 32 + 8 * g4), b1 = *(const LAS f32x2*)(tp + 32 + 8 * g4 + 2);
                    p0[4 * g4] += a0.x; p0[4 * g4 + 1] += a0.y; p0[4 * g4 + 2] += a1.x; p0[4 * g4 + 3] += a1.y;
                    p1[4 * g4] += b0.x; p1[4 * g4 + 1] += b0.y; p1[4 * g4 + 2] += b1.x; p1[4 * g4 + 3] += b1.y; }
            }
            float rm;
            { float ma = __builtin_fmaxf(p0[0], p1[0]), mb = __builtin_fmaxf(p0[1], p1[1]);
#pragma unroll
              for (int r = 2; r < 16; r += 2) { asm("v_max3_f32 %0, %1, %2, %3" : "=v"(ma) : "v"(ma), "v"(p0[r]), "v"(p1[r])); asm("v_max3_f32 %0, %1, %2, %3" : "=v"(mb) : "v"(mb), "v"(p0[r + 1]), "v"(p1[r + 1])); }
              rm = __builtin_fmaxf(ma, mb); }
            rm = fmaxf(rm, __shfl_xor(rm, 32));
            if (first || __any(rm > 8.0f)) {
                const float dl = first ? rm : fmaxf(rm, 0.f);
                mhat += dl;
#pragma unroll
                for (int r = 0; r < 16; ++r) { p0[r] -= dl; p1[r] -= dl; }
                const float f = __builtin_amdgcn_exp2f(-dl); l *= f;
                if (!first) {
                    if (hi == 0) wsf[r32] = f;
#pragma unroll
                    for (int r = 0; r < 16; ++r) { const float fr = wsf[crow(r, hi)]; o[0][r] *= fr; o[1][r] *= fr; }
                }
                c0 = bfar - mhat; first = false;
            }
            float sacc = 0.f;
#pragma unroll
            for (int r = 0; r < 16; ++r) { p0[r] = __builtin_amdgcn_exp2f(p0[r]); p1[r] = __builtin_amdgcn_exp2f(p1[r]); sacc += p0[r] + p1[r]; }
            l += sacc;
            v4u pw[4];
            pw[0].x = cvtpk(p0[0], p0[1]); pw[0].y = cvtpk(p0[2], p0[3]); pw[0].z = cvtpk(p0[4], p0[5]); pw[0].w = cvtpk(p0[6], p0[7]);
            pw[1].x = cvtpk(p0[8], p0[9]); pw[1].y = cvtpk(p0[10], p0[11]); pw[1].z = cvtpk(p0[12], p0[13]); pw[1].w = cvtpk(p0[14], p0[15]);
            pw[2].x = cvtpk(p1[0], p1[1]); pw[2].y = cvtpk(p1[2], p1[3]); pw[2].z = cvtpk(p1[4], p1[5]); pw[2].w = cvtpk(p1[6], p1[7]);
            pw[3].x = cvtpk(p1[8], p1[9]); pw[3].y = cvtpk(p1[10], p1[11]); pw[3].z = cvtpk(p1[12], p1[13]); pw[3].w = cvtpk(p1[14], p1[15]);
#pragma unroll
            for (int n = 4; n < 8; ++n) { const LAS unsigned char* vb = buf + 8192 + n * 1024 + voff; va[n] = vtr(vb); vc[n] = vtr(vb + 512); }
            __builtin_amdgcn_s_setprio(1);
#pragma unroll
            for (int d0 = 0; d0 < 2; ++d0)
#pragma unroll
                for (int s = 0; s < 4; ++s) { const int n = d0 * 4 + s;
                    const bf16x8 vf = (bf16x8){va[n][0], va[n][1], va[n][2], va[n][3], vc[n][0], vc[n][1], vc[n][2], vc[n][3]};
                    o[d0] = __builtin_amdgcn_mfma_f32_32x32x16_bf16(__builtin_bit_cast(bf16x8, pw[s]), vf, o[d0], 0, 0, 0); }
            __builtin_amdgcn_s_setprio(0);
        }
        if (kt == 3 && active) {
            l += __shfl_xor(l, 32);
            LAS unsigned* so = (LAS unsigned*)ost;
#pragma unroll
            for (int r = 0; r < 16; ++r) so[crow(r, hi) * 32 + r32] = cvtpk(o[0][r], o[1][r]);
#pragma unroll
            for (int it = 0; it < 4; ++it) { const int row = it * 8 + (lane >> 3), ch = lane & 7;
                const v4u v = *(const LAS v4u*)(ost + row * 128 + ch * 16);
                const int pr = prow_s[row];
                bf16* dst = pr >= 0 ? PO + (size_t)pr * 64 + ch * 8 : trash + row * 64 + ch * 8;
                *(GAS v4u*)dst = v; }
            { const int pr = prow_s[r32]; float* pl = (hi == 0 && pr >= 0) ? PL + (size_t)pr * 2 : (float*)trash + lane * 2; *(GAS f32x2*)pl = (f32x2){mhat, l}; }
            stored_prev = true;
        }
    }
#undef MOBA_DMA
#undef MOBA_GLDS
#undef MOBA_PREP
    VM_WAIT(); LDS_WAIT(); __syncthreads();
#pragma unroll 1
    for (int id0 = tid; id0 < nq * 8; id0 += 2048) {
        f32x4 La[4], Lb[4]; v4u pv[4][4]; size_t tokv[4]; int nselv[4];
#pragma unroll
        for (int u = 0; u < 4; ++u) { const int id = id0 + 512 * u, qu = id >> 3; const int i = lo + (qu >> 8); nselv[u] = i < 3 ? i : 3;
            tokv[u] = tokb + (size_t)lo * MBLK + qu; const size_t pr = (tokv[u] * NH + h) * 4;
            La[u] = __builtin_nontemporal_load((const f32x4*)(PL + pr * 2)); Lb[u] = __builtin_nontemporal_load((const f32x4*)(PL + pr * 2 + 4));
#pragma unroll
            for (int s = 0; s < 4; ++s) pv[u][s] = __builtin_nontemporal_load((const v4u*)(PO + (pr + s) * 64 + (id & 7) * 8)); }
#pragma unroll
        for (int u = 0; u < 4; ++u) { const int id = id0 + 512 * u, ch = id & 7; const int nsel = nselv[u];
            const float Ms[4] = {La[u].x, La[u].z, Lb[u].x, Lb[u].z}, Ls[4] = {La[u].y, La[u].w, Lb[u].y, Lb[u].w}; float Mm = Ms[3];
#pragma unroll
            for (int s = 0; s < 3; ++s) if (s < nsel) Mm = fmaxf(Mm, Ms[s]);
            float acc[8]; float W = 0.f;
#pragma unroll
            for (int e = 0; e < 8; ++e) acc[e] = 0.f;
#pragma unroll
            for (int s = 0; s < 4; ++s) { if (s == 3 || s < nsel) { const float wgt = __builtin_amdgcn_exp2f(Ms[s] - Mm); W += wgt * Ls[s]; const v4u v = pv[u][s];
                acc[0] += wgt * bflo(v.x); acc[1] += wgt * bflo(v.y); acc[2] += wgt * bflo(v.z); acc[3] += wgt * bflo(v.w);
                acc[4] += wgt * bfhi(v.x); acc[5] += wgt * bfhi(v.y); acc[6] += wgt * bfhi(v.z); acc[7] += wgt * bfhi(v.w); } }
            const float rw = 1.0f / W; v2u oa, ob;
            oa.x = pk2(acc[0] * rw, acc[1] * rw); oa.y = pk2(acc[2] * rw, acc[3] * rw); ob.x = pk2(acc[4] * rw, acc[5] * rw); ob.y = pk2(acc[6] * rw, acc[7] * rw);
            bf16* orow = F.U + tokv[u] * (CW + AW) + CW + h * 64 + ch * 4;
            *(GAS v2u*)orow = oa; *(GAS v2u*)(orow + 32) = ob; }
    }
    __syncthreads();
}
__device__ __forceinline__ void phase(Frame& F) {
    const int nun = (BATCH * NH * 4 - (int)blockIdx.x + F.G - 1) / F.G;
#pragma unroll 1
    for (int n = 0; n < nun; ++n) {
        const int id = blockIdx.x + n * F.G; const int x = id & 7, k = (id >> 3) & 31; const int bh = 8 * x + (k >> 2), g = k & 3;
        const int lo = g == 0 ? 0 : (g == 1 ? 10 : (g == 2 ? 18 : 24)), hb = g == 0 ? 10 : (g == 1 ? 18 : (g == 2 ? 24 : 32));
        unit(F, bh >> 3, bh & 7, lo, hb);
    }
}
}

struct Args { const float* in[13]; float* out; unsigned char* ws; int ph_lo, ph_hi; };
__global__ void __launch_bounds__(NWAVES * 64, 2) fwd_kernel(Args args) {
    extern __shared__ __attribute__((aligned(16))) unsigned char lds[];
    Frame F;
    F.lds = (LAS unsigned char*)lds;
    F.tid = threadIdx.x; F.lane = F.tid & 63; F.wave = __builtin_amdgcn_readfirstlane(F.tid >> 6);
    F.G = gridDim.x; { const int bx = blockIdx.x; F.vcu = (F.G % 8 == 0) ? (bx % 8) * (F.G / 8) + bx / 8 : bx; }
    unsigned char* ws = args.ws;
    F.x = args.in[0]; F.g_pre1 = args.in[1]; F.w_in = args.in[2]; F.conv_w = args.in[3]; F.w_cout = args.in[4]; F.w_aout = args.in[5]; F.rel_bias = args.in[6];
    F.w_o = args.in[7]; F.g_post1 = args.in[8]; F.g_pre2 = args.in[9]; F.w1 = args.in[10]; F.w2 = args.in[11]; F.g_post2 = args.in[12]; F.out = args.out;
    F.Win_t = (bf16*)(ws + WS_WIN); F.Wc_t = (bf16*)(ws + WS_WC); F.Wa_t = (bf16*)(ws + WS_WA); F.Wo_t = (bf16*)(ws + WS_WO); F.W1_t = (bf16*)(ws + WS_W1); F.W2_t = (bf16*)(ws + WS_W2);
    F.XN = (bf16*)(ws + WS_XN); F.PROJ = (bf16*)(ws + WS_PROJ); F.U = (bf16*)(ws + WS_U); F.O = (bf16*)(ws + WS_O); F.M1 = (bf16*)args.out; F.MIX = (bf16*)(ws + WS_PROJ);
    F.HB = (bf16*)(ws + WS_H); F.FB = (bf16*)(ws + WS_PROJ); F.T5 = (float*)(ws + WS_T5); F.KM = (float*)(ws + WS_KM); F.part = ws + WS_PART; F.X1B = (bf16*)(ws + WS_U); F.convctr = (unsigned*)(ws + WS_CTL) + 1024; F.RS2 = (float*)(ws + WS_PART + 40 * MiB); F.RS1 = (float*)(ws + WS_PART + 41 * MiB); F.GT = (bf16*)(ws + WS_PROJ + 384 * MiB);
    const int lo = args.ph_lo, hi = args.ph_hi;
    { volatile LAS unsigned* st = (volatile LAS unsigned*)(F.lds + LDS_BARST); if (F.tid == 0) { st[0] = 0u; st[1] = 0u; } }
    __syncthreads();
    XcdBarrier bar = xcd_barrier_post((unsigned*)(ws + WS_CTL) + CW_BAR, (volatile LAS unsigned*)(F.lds + LDS_BARST));
    unsigned* gmask = (unsigned*)(ws + WS_CTL) + 2048;
    if (F.tid == 0) (void)__hip_atomic_fetch_or(gmask + 64 * (blockIdx.x & 7), 1u << bar.x, __ATOMIC_RELAXED, __HIP_MEMORY_SCOPE_AGENT);
    bool local = false;
#ifndef PH_MASK
#define PH_MASK 0x3ff
#endif
#define IN(k) ((((PH_MASK) >> (k)) & 1) && lo <= (k) && (k) < hi)
#define GRID_BAR(k) do { if (IN(k) && (IN((k) + 1) || ((k) == 1 && IN(3)))) { xcd_barrier(bar); } } while (0)
#define LOCAL_BAR(k) do { if (IN(k) && (IN((k) + 1) || ((k) == 1 && IN(3)))) { if (local) xcd_barrier_local(bar); else xcd_barrier(bar); } } while (0)
#ifndef REP_MASK
#define REP_MASK 0
#endif
#define RUNPH(k, ...) do { if (IN(k)) { __VA_ARGS__; if ((REP_MASK >> (k)) & 1) { xcd_barrier(bar); __VA_ARGS__; } } } while (0)
    RUNPH(0, p0_prologue(F)); GRID_BAR(0);
    if (lo == 0 && hi >= 10) {
        volatile LAS unsigned* st = (volatile LAS unsigned*)(F.lds + LDS_BARST);
        if (F.tid == 0) { unsigned ok = (gridDim.x == 256u) ? 1u : 0u, un = 0u;
#pragma unroll
            for (int k = 0; k < 8; ++k) { const unsigned m = xb_ld(gmask + 64 * k); ok &= (m != 0u && (m & (m - 1u)) == 0u) ? 1u : 0u; un |= m; }
            ok &= (__builtin_popcount(un) == 8) ? 1u : 0u; ok &= (st[0] == 32u) ? 1u : 0u;
            st[2] = ok; }
        __syncthreads();
        local = __builtin_amdgcn_readfirstlane((int)st[2]) != 0;
    }
    RUNPH(1, { pg8::Gemm g{F.XN, F.Win_t, M, NIN, DM}; pg8::StaticOrder S; S.init(M, NIN, F.G, (int)blockIdx.x);
        pg8::EpiB<pg8::EM_PROJ> E{F.PROJ, PPITCH, (const pg8::bf16_t*)F.GT, 0, 0, 0, F.KM, F.RS1};
        pg8::gemm_phase<pg8::EpiB<pg8::EM_PROJ>, pg8::StaticOrder, false, true>(F.lds, g, S, E); }); LOCAL_BAR(1);
    RUNPH(3, { moba2::phase(F); conv_tail(F); }); GRID_BAR(3);
    RUNPH(4, { pg8::Gemm g{F.U, F.Wc_t, M, DM, CW + AW}; pg8::StaticOrder S; S.init(M, DM, F.G, (int)blockIdx.x);
        pg8::EpiB<pg8::EM_GATE2> E{F.M1, DM, (const pg8::bf16_t*)F.GT, 0, 0, 0};
        pg8::gemm_phase<pg8::EpiB<pg8::EM_GATE2>, pg8::StaticOrder, true, true>(F.lds, g, S, E); }); LOCAL_BAR(4);
    RUNPH(5, { pg8::Gemm g{F.M1, F.Wo_t, M, DM, DM}; pg8::StaticOrder S; S.init(M, DM, F.G, (int)blockIdx.x);
        pg8::EpiB<pg8::EM_PLAIN> E{F.MIX, DM, nullptr, 0, 0};
        pg8::gemm_phase<pg8::EpiB<pg8::EM_PLAIN>, pg8::StaticOrder, true, true>(F.lds, g, S, E); }); GRID_BAR(5);
    RUNPH(6, p6_norms(F)); LOCAL_BAR(6);
    RUNPH(7, { pg8::Gemm g{F.X1B, F.W1_t, M, FF, DM}; pg8::StaticOrder S; S.init(M, FF, F.G, (int)blockIdx.x);
        pg8::EpiB<pg8::EM_RELU2> E{F.HB, FF, nullptr, 0, 0, 0, nullptr, F.RS2, FF / 256};
        pg8::gemm_phase<pg8::EpiB<pg8::EM_RELU2>, pg8::StaticOrder, false, true>(F.lds, g, S, E); }); LOCAL_BAR(7);
    RUNPH(8, { pg8::Gemm g{F.HB, F.W2_t, M, DM, FF}; pg8::StaticOrder S; S.init(M, DM, F.G, (int)blockIdx.x);
        pg8::EpiB<pg8::EM_PLAIN> E{F.FB, DM, nullptr, 0, 0};
        pg8::gemm_phase<pg8::EpiB<pg8::EM_PLAIN>, pg8::StaticOrder, true, true, true>(F.lds, g, S, E); }); LOCAL_BAR(8);
    if (IN(9)) { p9_final(F); }
#undef IN
#undef GRID_BAR
#undef LOCAL_BAR
}

#ifndef MK_N_LAUNCHES
#define MK_N_LAUNCHES 1
#endif
extern "C" void kernel_launch(void* const* d_in, const int* in_sizes, int n_in, void* d_out, int out_size, void* d_ws, size_t ws_size, hipStream_t stream) {
    static int grid = 0;
    if (grid == 0) {
        if (n_in != 13 || in_sizes[0] != M * DM || out_size != M * DM || ws_size < WS_END) { fprintf(stderr, "kernel_launch: unexpected shapes (n_in %d, in0 %d, out %d, ws %zu)\n", n_in, n_in > 0 ? in_sizes[0] : -1, out_size, ws_size); grid = -1; return; }
        int dev = 0, cus = 0, per_cu = 0;
        if (hipGetDevice(&dev) != hipSuccess || hipDeviceGetAttribute(&cus, hipDeviceAttributeMultiprocessorCount, dev) != hipSuccess) { grid = -1; return; }
        if (hipFuncSetAttribute((const void*)fwd_kernel, hipFuncAttributeMaxDynamicSharedMemorySize, LDS_BYTES) != hipSuccess) { fprintf(stderr, "kernel_launch: hipFuncSetAttribute failed\n"); grid = -1; return; }
        if (hipOccupancyMaxActiveBlocksPerMultiprocessor(&per_cu, (const void*)fwd_kernel, NWAVES * 64, LDS_BYTES) != hipSuccess || per_cu < 1) { fprintf(stderr, "kernel_launch: occupancy query says %d blocks per CU\n", per_cu); (void)hipGetLastError(); per_cu = 1; }
        if (per_cu > 1) per_cu = 1;
        grid = cus * per_cu;
    }
    if (grid < 0) return;
    if (hipMemsetAsync((char*)d_ws + WS_CTL, 0, CTL_ZERO_BYTES, stream) != hipSuccess) { fprintf(stderr, "kernel_launch: hipMemsetAsync failed\n"); return; }
    Args a{};
    for (int i = 0; i < 13; ++i) a.in[i] = (const float*)d_in[i];
    a.out = (float*)d_out; a.ws = (unsigned char*)d_ws;
#if MK_N_LAUNCHES == 1
    a.ph_lo = 0; a.ph_hi = N_PHASES;
    void* kargs[] = {&a};
    hipError_t e = hipLaunchCooperativeKernel((const void*)fwd_kernel, dim3(grid), dim3(NWAVES * 64), kargs, LDS_BYTES, stream);
    if (e != hipSuccess) fprintf(stderr, "kernel_launch: cooperative launch failed: %s (grid %d)\n", hipGetErrorString(e), grid);
#else
    for (int p = 0; p < N_PHASES; ++p) { a.ph_lo = p; a.ph_hi = p + 1;
        void* kargs[] = {&a};
        hipError_t e = hipLaunchCooperativeKernel((const void*)fwd_kernel, dim3(grid), dim3(NWAVES * 64), kargs, LDS_BYTES, stream);
        if (e != hipSuccess) { fprintf(stderr, "kernel_launch: launch %d failed: %s\n", p, hipGetErrorString(e)); break; } }
#endif
}
```

```cpp
#include <hip/hip_runtime.h>
#include <cstdio>
#include <cstdint>
namespace pg8 {
#define PG8_LAS __attribute__((address_space(3)))
typedef unsigned short bf16_t;
typedef short bf16x8 __attribute__((ext_vector_type(8)));
typedef float f32x4 __attribute__((ext_vector_type(4)));
typedef unsigned u32x4 __attribute__((ext_vector_type(4)));
constexpr int BM = 256, BK = 64, HALF = 128, HTB = HALF * BK * 2  , STAGE_BYTES = 8 * HTB, NXCD = 8, WGM = 8;

__host__ __device__ __forceinline__ int lds_byte(int r, int c) { const int st = (r >> 4) * 2 + (c >> 5), rr = r & 15, cc = c & 31, ob = rr * 64 + cc * 2; return st * 1024 + (ob ^ (((ob >> 9) & 1) << 5)); }
__host__ __device__ __forceinline__ void stage_rc(int b, int& R, int& C) { const int st = b / 1024, sb = b % 1024, swz = sb ^ (((sb >> 9) & 1) << 5); R = (st >> 1) * 16 + swz / 64; C = (st & 1) * 32 + (swz % 64) / 2; }
__host__ __device__ __forceinline__ int perm32(int rho) { const int n = rho >> 4, i = rho & 15; return 8 * (i >> 2) + 4 * n + (i & 3); }

struct Unit { int pm, pn; };
struct Gemm { const bf16_t* A; const bf16_t* Bt; int M, N, K; };

struct StaticOrder {
    int nM, nN, nwg, G, c;
    __host__ __device__ void init(int M, int N, int G_, int c_) { nM = M / BM; nN = N / BM; nwg = nM * nN; G = G_; c = c_; }
    __host__ __device__ bool next(int i, Unit& u) const {
        const long L = (long)i * G + c; if (L >= nwg) return false;
        int wgid = (int)L; { const int q = nwg / NXCD, r = nwg % NXCD, xcd = wgid % NXCD, off = wgid / NXCD; wgid = (xcd < r ? xcd * (q + 1) : r * (q + 1) + (xcd - r) * q) + off; }
        const int nig = WGM * nN, gid = wgid / nig, fm = gid * WGM, gsz = (nM - fm) < WGM ? (nM - fm) : WGM;
        u.pm = fm + ((wgid % nig) % gsz); u.pn = (wgid % nig) / gsz; return true;
    }
    __device__ __forceinline__ void a_ready(const Unit&) const {}
    __device__ __forceinline__ void done(const Unit&) const {}
};

__device__ __forceinline__ unsigned cvt_pk_bf16(float lo, float hi) { unsigned r; asm volatile("v_cvt_pk_bf16_f32 %0, %1, %2" : "=v"(r) : "v"(lo), "v"(hi)); return r; }
typedef float f32x2 __attribute__((ext_vector_type(2)));
__device__ __forceinline__ float bf_lo(unsigned w) { return __uint_as_float(w << 16); }
__device__ __forceinline__ float bf_hi(unsigned w) { return __uint_as_float(w & 0xffff0000u); }
constexpr float QSCALE = 0.125f * 1.4426950408889634f;
enum { EM_PROJ = 0, EM_GATE = 1, EM_GATEADD = 2, EM_PLAIN = 3, EM_RELU2 = 4, EM_GATE2 = 5 };
template <int MODE> struct EpiB {
    static constexpr bool PERM = true, AFTER_DRAIN = false, HAS_MID = (MODE == EM_GATE2), ROWS = (MODE == EM_PROJ || MODE == EM_RELU2), PREFETCH = (MODE == EM_GATE2);
    bf16_t* O; int ldc; const bf16_t* G; int ldg; int goff; int goff2 = 0; float* KMp = nullptr; const float* rowscale = nullptr; int otile = 0;
    __device__ __forceinline__ void operator()(f32x4 (&acc)[2][2][4][2], const Unit& u, int wr, int wc, int fr, int fq, const PG8_LAS float* rsl = nullptr) const {
        const int row0 = u.pm * BM + wr * 64 + fr, col0 = u.pn * BM + wc * 32 + 8 * fq;
        float rsq[2][4];
        if (MODE == EM_PROJ) {
#pragma unroll
            for (int ai = 0; ai < 2; ++ai)
#pragma unroll
                for (int m = 0; m < 4; ++m) { const float r_ = rsl[wr * 64 + fr + ai * HALF + m * 16];
#pragma unroll
                    for (int bj = 0; bj < 2; ++bj) { acc[ai][bj][m][0] = acc[ai][bj][m][0] * r_; acc[ai][bj][m][1] = acc[ai][bj][m][1] * r_; } } }
        if (MODE == EM_RELU2) {
#pragma unroll
            for (int ai = 0; ai < 2; ++ai)
#pragma unroll
                for (int m = 0; m < 4; ++m) { const float r_ = rsl[wr * 64 + fr + ai * HALF + m * 16]; rsq[ai][m] = r_ * r_; } }
        u32x4 gpre[2][4][2];
        if (MODE == EM_GATE2) {
#pragma unroll
            for (int ai = 0; ai < 2; ++ai)
#pragma unroll
                for (int m = 0; m < 4; ++m)
#pragma unroll
                    for (int bj = 0; bj < 2; ++bj) gpre[ai][m][bj] = *(const u32x4*)(G + (((((((size_t)u.pm * 8 + (2 * u.pn + bj)) * 2 + 1) * 2 + ai) * 4 + m) * 8 + (wr * 4 + wc)) * 64 + (fq * 16 + fr)) * 8); }
        int pmode = 0; if (MODE == EM_PROJ) { pmode = (u.pn >= 12) ? 2 : ((u.pn == 6 || u.pn == 7) ? 1 : (u.pn < 4 ? 3 : 0)); }
        if (MODE == EM_PROJ) { if (u.pn == 8 || u.pn == 9) {
            float cs[2][2][4];
#pragma unroll
            for (int bj = 0; bj < 2; ++bj)
#pragma unroll
                for (int n = 0; n < 2; ++n)
#pragma unroll
                    for (int e = 0; e < 4; ++e) { float t = 0.f;
#pragma unroll
                        for (int ai = 0; ai < 2; ++ai)
#pragma unroll
                            for (int m = 0; m < 4; ++m) t += acc[ai][bj][m][n][e];
                        t += __shfl_xor(t, 1); t += __shfl_xor(t, 2); t += __shfl_xor(t, 4); t += __shfl_xor(t, 8); cs[bj][n][e] = t; }
            if (fr == 0) { float* kp = KMp + (size_t)u.pm * 512 + (u.pn - 8) * BM + wc * 32 + 8 * fq;
#pragma unroll
                for (int bj = 0; bj < 2; ++bj)
#pragma unroll
                    for (int n = 0; n < 2; ++n)
#pragma unroll
                        for (int e = 0; e < 4; ++e) atomicAdd(kp + bj * HALF + 4 * n + e, cs[bj][n][e]); }
        } }
#pragma unroll
        for (int ai = 0; ai < 2; ++ai)
#pragma unroll
            for (int m = 0; m < 4; ++m) { const size_t row = (size_t)(row0 + ai * HALF + m * 16);
#pragma unroll
                for (int bj = 0; bj < 2; ++bj) { f32x4 v0 = acc[ai][bj][m][0], v1 = acc[ai][bj][m][1]; const int col = col0 + bj * HALF;
                    if (MODE == EM_PROJ) {
                        if (pmode == 3) { if (bj == 1) continue; v0 = v0 * acc[ai][1][m][0]; v1 = v1 * acc[ai][1][m][1]; }
                        if (pmode == 1) { v0 = v0 * QSCALE; v1 = v1 * QSCALE; }
                        else if (pmode == 2) {
                            const f32x4 a0 = acc[ai][1][m][0], a1 = acc[ai][1][m][1];
#pragma unroll
                            for (int e = 0; e < 4; ++e) {
                                const float ea0 = 1.0f + __builtin_amdgcn_exp2f(-1.4426950408889634f * a0[e]), ea1 = 1.0f + __builtin_amdgcn_exp2f(-1.4426950408889634f * a1[e]);
                                if (bj == 0) { v0[e] = ea0 * __builtin_amdgcn_rcpf(1.0f + __builtin_amdgcn_exp2f(-1.4426950408889634f * v0[e])); v1[e] = ea1 * __builtin_amdgcn_rcpf(1.0f + __builtin_amdgcn_exp2f(-1.4426950408889634f * v1[e])); }
                                else { v0[e] = __builtin_amdgcn_rcpf(ea0); v1[e] = __builtin_amdgcn_rcpf(ea1); } }
                        }
                    }
                    if (MODE == EM_RELU2) {
#pragma unroll
                        for (int e = 0; e < 4; ++e) { float a, b; asm("v_max_f32 %0, 0, %1" : "=v"(a) : "v"(v0[e])); asm("v_max_f32 %0, 0, %1" : "=v"(b) : "v"(v1[e])); v0[e] = a * a * rsq[ai][m]; v1[e] = b * b * rsq[ai][m]; }
                    }
                    if (MODE == EM_GATE || MODE == EM_GATEADD || MODE == EM_GATE2) {
                        const u32x4 g = (MODE == EM_GATE2) ? gpre[ai][m][bj] : *(const u32x4*)(G + row * (size_t)ldg + (goff + col));
                        v0[0] *= bf_lo(g.x); v0[1] *= bf_hi(g.x); v0[2] *= bf_lo(g.y); v0[3] *= bf_hi(g.y);
                        v1[0] *= bf_lo(g.z); v1[1] *= bf_hi(g.z); v1[2] *= bf_lo(g.w); v1[3] *= bf_hi(g.w);
                        if (MODE == EM_GATEADD) { const u32x4 o = *(const u32x4*)(O + row * (size_t)ldc + col);
                            v0[0] += bf_lo(o.x); v0[1] += bf_hi(o.x); v0[2] += bf_lo(o.y); v0[3] += bf_hi(o.y);
                            v1[0] += bf_lo(o.z); v1[1] += bf_hi(o.z); v1[2] += bf_lo(o.w); v1[3] += bf_hi(o.w); }
                    }
                    u32x4 w; w.x = cvt_pk_bf16(v0[0], v0[1]); w.y = cvt_pk_bf16(v0[2], v0[3]); w.z = cvt_pk_bf16(v1[0], v1[1]); w.w = cvt_pk_bf16(v1[2], v1[3]);
                    if (MODE == EM_PROJ && pmode == 2) {
                        const size_t vi = ((((((size_t)u.pm * 8 + (u.pn - 12)) * 2 + bj) * 2 + ai) * 4 + m) * 8 + (wr * 4 + wc)) * 64 + (fq * 16 + fr);
                        __builtin_nontemporal_store(w, (u32x4*)((bf16_t*)G + vi * 8));
                    } else if (otile > 0) {
                        __builtin_nontemporal_store(w, (u32x4*)(O + ((size_t)u.pm * otile + u.pn) * 65536 + (size_t)(row - (size_t)u.pm * BM) * 256 + (col - u.pn * BM)));
                    } else if (MODE == EM_PROJ)
                    __builtin_nontemporal_store(w, (u32x4*)(O + row * (size_t)ldc + ((pmode == 3) ? (HALF * u.pn + wc * 32 + 8 * fq) : col)));
                    else
                    *(u32x4*)(O + row * (size_t)ldc + col) = w; }
                if (MODE == EM_GATE || MODE == EM_GATEADD) asm volatile("" ::: "memory"); }
    }
    __device__ __forceinline__ void prefetch(const Unit& u, int s_, PG8_LAS unsigned char* dump, int wid, int lane) const {
        { s_ &= 31;
          const int kind = s_ >> 4, ai = (s_ >> 3) & 1, m = (s_ >> 1) & 3, bj = s_ & 1;
            const bf16_t* src = G + (((((((size_t)u.pm * 8 + (2 * u.pn + bj)) * 2 + kind) * 2 + ai) * 4 + m) * 8 + wid) * 64 + lane) * 8;
            __builtin_amdgcn_global_load_lds((const unsigned*)src, (PG8_LAS unsigned*)dump, 16, 0, 0); }
    }
    __device__ __forceinline__ void mid(f32x4 (&acc)[2][2][4][2], const Unit& u, int wr, int wc, int fr, int fq) const {
        const bf16_t* gp = G + ((((size_t)u.pm * 8 + 2 * u.pn) * 2 * 2 * 4 * 8 + (wr * 4 + wc)) * 64 + (fq * 16 + fr)) * 8;
#pragma unroll
        for (int ai = 0; ai < 2; ++ai) {
            asm volatile("" : "+v"(gp));
            u32x4 g1[4][2];
#pragma unroll
            for (int m = 0; m < 4; ++m)
#pragma unroll
                for (int bj = 0; bj < 2; ++bj) g1[m][bj] = *(const u32x4*)(gp + ((size_t)bj * (2 * 2 * 4 * 8) + (ai * 4 + m) * 8) * 64 * 8);
#pragma unroll
            for (int m = 0; m < 4; ++m)
#pragma unroll
                for (int bj = 0; bj < 2; ++bj) { const u32x4 g = g1[m][bj];
                    f32x4& v0 = acc[ai][bj][m][0]; f32x4& v1 = acc[ai][bj][m][1];
                    v0[0] *= bf_lo(g.x); v0[1] *= bf_hi(g.x); v0[2] *= bf_lo(g.y); v0[3] *= bf_hi(g.y);
                    v1[0] *= bf_lo(g.z); v1[1] *= bf_hi(g.z); v1[2] *= bf_lo(g.w); v1[3] *= bf_hi(g.w); }
            asm volatile("" ::: "memory"); }
    }
};
template <class Epi, class Sched, bool ALIGN_EPI = false, bool SP2 = false, bool ATILE = false>
__device__ __forceinline__ void gemm_phase(PG8_LAS unsigned char* lds, const Gemm g, const Sched& S, const Epi& E) {
    const int tid = threadIdx.x, wid = __builtin_amdgcn_readfirstlane(tid >> 6), lane = tid & 63, wr = wid >> 2, wc = wid & 3, fr = lane & 15, fq = lane >> 4;
    const int K = g.K, nt = K / BK;
    unsigned voffA[2], voffB[2];
#pragma unroll
    for (int i = 0; i < 2; ++i) { int R, C; stage_rc(tid * 16 + i * 8192, R, C); const int Rb = Epi::PERM ? ((R & ~31) + perm32(R & 31)) : R;
        voffA[i] = (unsigned)(R * (ATILE ? 256 : K) + C) * 2u; voffB[i] = (unsigned)(Rb * K + C) * 2u; }
    const size_t kstep = (size_t)(BK * 2);
    const size_t hstep = (size_t)HALF * K * 2;
    const size_t tstep = 2 * hstep;
    const size_t hstepA = ATILE ? (size_t)HALF * 256 * 2 : hstep;
#define PG8_AK(t_) (ATILE ? ((size_t)((t_) >> 2) * 131072 + (size_t)((t_) & 3) * 128) : (size_t)(t_) * kstep)
    const unsigned ldsw = (unsigned)wid * 1024u;
    const int aoff = lds_byte(wr * 64 + fr, fq * 8), boff = lds_byte(wc * 32 + fr, fq * 8);
#define PG8_SA(b, h) (((b) * 2 + (h)) * HTB)
#define PG8_SB(b, h) ((4 + (b) * 2 + (h)) * HTB)
#define PG8_STAGE(bufoff, gbase, voff) do { _Pragma("unroll") for (int _i = 0; _i < 2; ++_i) \
        __builtin_amdgcn_global_load_lds((const unsigned*)((const char*)(gbase) + (voff)[_i]), (PG8_LAS unsigned*)(lds + (bufoff) + ldsw + _i * 8192), 16, 0, 0); } while (0)
#define PG8_LDA(dst, b, h) do { _Pragma("unroll") for (int m = 0; m < 4; ++m) _Pragma("unroll") for (int k = 0; k < 2; ++k) dst[m][k] = *(const PG8_LAS bf16x8*)(lds + PG8_SA(b, h) + aoff + m * 2048 + k * 1024); } while (0)
#define PG8_LDB(dst, b, h) do { _Pragma("unroll") for (int n = 0; n < 2; ++n) _Pragma("unroll") for (int k = 0; k < 2; ++k) dst[n][k] = *(const PG8_LAS bf16x8*)(lds + PG8_SB(b, h) + boff + n * 2048 + k * 1024); } while (0)
#define PG8_MMA(ai, bj, At, Bt) do { __builtin_amdgcn_s_setprio(1); _Pragma("unroll") for (int m = 0; m < 4; ++m) _Pragma("unroll") for (int n = 0; n < 2; ++n) _Pragma("unroll") for (int k = 0; k < 2; ++k) \
        acc[ai][bj][m][n] = __builtin_amdgcn_mfma_f32_16x16x32_bf16(Bt[n][k], At[m][k], acc[ai][bj][m][n], 0, 0, 0); __builtin_amdgcn_s_setprio(0); } while (0)
#define PG8_WAIT_V(n) asm volatile("s_waitcnt vmcnt(" #n ")" ::: "memory")
#define PG8_WAIT_L(n) asm volatile("s_waitcnt lgkmcnt(" #n ")" ::: "memory")
#define PG8_WAIT_VP do { if constexpr (Epi::PREFETCH) PG8_WAIT_V(10); else PG8_WAIT_V(8); } while (0)
#define PG8_PF(s_) do { if constexpr (Epi::PREFETCH) E.prefetch(cur, (s_), lds + STAGE_BYTES + 4096 + wid * 1024, wid, lane); } while (0)
#define PG8_BAR __builtin_amdgcn_s_barrier()
#define PG8_SCHED __builtin_amdgcn_sched_barrier(0)
    Unit cur, nxt; int ui = 0;
    if (!S.next(0, cur)) return;
    f32x4 acc[2][2][4][2];
#pragma unroll
    for (int a = 0; a < 2; ++a)
#pragma unroll
        for (int b = 0; b < 2; ++b)
#pragma unroll
            for (int m = 0; m < 4; ++m)
#pragma unroll
                for (int n = 0; n < 2; ++n) acc[a][b][m][n] = (f32x4){0.f, 0.f, 0.f, 0.f};
    bf16x8 At[4][2], B0[2][2], B1[2][2];
    const char* cA = (const char*)g.A + (size_t)cur.pm * tstep; const char* cB = (const char*)g.Bt + (size_t)cur.pn * tstep;
    S.a_ready(cur);
    const PG8_LAS float* rsl = nullptr;
#define PG8_ROWS(unit_, par_) do { if constexpr (Epi::ROWS) { const float* gsrc_ = E.rowscale + (size_t)(unit_).pm * BM + (wid & 3) * 64 + lane; \
        __builtin_amdgcn_global_load_lds((const unsigned*)gsrc_, (PG8_LAS unsigned*)(lds + STAGE_BYTES + (par_) * 2048 + (wid >> 2) * 1024 + (wid & 3) * 256), 4, 0, 0); \
        rsl = (const PG8_LAS float*)(lds + STAGE_BYTES + (par_) * 2048); } } while (0)
    PG8_ROWS(cur, 0);
    if constexpr (SP2) {
        PG8_STAGE(PG8_SB(0, 0), cB, voffB); PG8_STAGE(PG8_SB(0, 1), cB + hstep, voffB); PG8_STAGE(PG8_SA(0, 0), cA, voffA); PG8_STAGE(PG8_SA(0, 1), cA + hstepA, voffA);
        if (wr == 1) PG8_BAR;
        PG8_WAIT_V(2); PG8_BAR;
        PG8_STAGE(PG8_SB(1, 0), cB + kstep, voffB); PG8_STAGE(PG8_SA(1, 0), cA + kstep, voffA); PG8_STAGE(PG8_SB(1, 1), cB + hstep + kstep, voffB);
        PG8_WAIT_V(6); PG8_BAR;
    } else {
        PG8_STAGE(PG8_SB(0, 0), cB, voffB); PG8_STAGE(PG8_SA(0, 0), cA, voffA); PG8_STAGE(PG8_SB(0, 1), cB + hstep, voffB); PG8_STAGE(PG8_SA(0, 1), cA + hstepA, voffA);
        if (wr == 1) PG8_BAR;
        PG8_WAIT_V(4); PG8_BAR;
        PG8_STAGE(PG8_SB(1, 0), cB + kstep, voffB); PG8_STAGE(PG8_SA(1, 0), cA + kstep, voffA); PG8_STAGE(PG8_SB(1, 1), cB + hstep + kstep, voffB);
        PG8_WAIT_V(6); PG8_BAR;
    }
    for (;;) {
        const bool has_next = S.next(ui + 1, nxt);
        const char* nA = has_next ? (const char*)g.A + (size_t)nxt.pm * tstep : cA; const char* nB = has_next ? (const char*)g.Bt + (size_t)nxt.pn * tstep : cB;
        for (int t = 0; t < nt; t += 2) {
            const bool last = (t == nt - 2);
            const char* a1 = cA + PG8_AK(t + 1);
            const char* a2 = last ? nA : cA + PG8_AK(t + 2); const char* b2 = last ? nB : cB + (size_t)(t + 2) * kstep;
            const char* a3 = a2 + kstep; const char* b3 = b2 + kstep;
            if (last && has_next) S.a_ready(nxt);
            if constexpr (Epi::HAS_MID) { if (t == nt / 2) E.mid(acc, cur, wr, wc, fr, fq); }
            if constexpr (SP2) {
            PG8_LDB(B0, 0, 0); PG8_LDB(B1, 0, 1); PG8_SCHED; PG8_LDA(At, 0, 0); PG8_STAGE(PG8_SA(1, 1), a1 + hstepA, voffA); PG8_PF(2 * t);
            PG8_WAIT_VP; PG8_WAIT_L(0); PG8_BAR; PG8_MMA(0, 0, At, B0); PG8_MMA(0, 1, At, B1); PG8_BAR; PG8_SCHED;
            PG8_LDA(At, 0, 1); PG8_STAGE(PG8_SB(0, 0), b2, voffB); PG8_STAGE(PG8_SB(0, 1), b2 + hstep, voffB); PG8_STAGE(PG8_SA(0, 0), a2, voffA); PG8_PF(2 * t + 1);
            PG8_WAIT_VP; PG8_WAIT_L(0); PG8_BAR; PG8_MMA(1, 0, At, B0); PG8_MMA(1, 1, At, B1); PG8_BAR; PG8_SCHED;
            PG8_LDB(B0, 1, 0); PG8_LDB(B1, 1, 1); PG8_SCHED; PG8_LDA(At, 1, 0); PG8_STAGE(PG8_SA(0, 1), a2 + hstepA, voffA); PG8_PF(2 * t + 2);
            PG8_WAIT_VP; PG8_WAIT_L(0); PG8_BAR; PG8_MMA(0, 0, At, B0); PG8_MMA(0, 1, At, B1); PG8_BAR; PG8_SCHED;
            PG8_LDA(At, 1, 1); PG8_STAGE(PG8_SB(1, 0), b3, voffB); PG8_STAGE(PG8_SB(1, 1), b3 + hstep, voffB); PG8_STAGE(PG8_SA(1, 0), a3, voffA); PG8_PF(2 * t + 3);
            PG8_WAIT_VP; PG8_WAIT_L(0); PG8_BAR; PG8_MMA(1, 0, At, B0); PG8_MMA(1, 1, At, B1); PG8_BAR; PG8_SCHED;
            } else {
            PG8_LDB(B0, 0, 0); PG8_SCHED; PG8_LDA(At, 0, 0); PG8_STAGE(PG8_SA(1, 1), a1 + hstepA, voffA);
            PG8_WAIT_L(8); PG8_BAR; PG8_WAIT_L(0); PG8_MMA(0, 0, At, B0); PG8_BAR; PG8_SCHED;
            PG8_LDB(B1, 0, 1); PG8_STAGE(PG8_SB(0, 0), b2, voffB);
            PG8_BAR; PG8_WAIT_L(0); PG8_MMA(0, 1, At, B1); PG8_BAR;
            PG8_LDA(At, 0, 1); PG8_STAGE(PG8_SA(0, 0), a2, voffA);
            PG8_BAR; PG8_WAIT_L(0); PG8_MMA(1, 0, At, B0); PG8_BAR; PG8_SCHED;
            PG8_STAGE(PG8_SB(0, 1), b2 + hstep, voffB);
            PG8_WAIT_V(6); PG8_BAR; PG8_MMA(1, 1, At, B1); PG8_BAR;
            PG8_LDB(B0, 1, 0); PG8_SCHED; PG8_LDA(At, 1, 0); PG8_STAGE(PG8_SA(0, 1), a2 + hstepA, voffA);
            PG8_WAIT_L(8); PG8_BAR; PG8_WAIT_L(0); PG8_MMA(0, 0, At, B0); PG8_BAR; PG8_SCHED;
            PG8_LDB(B1, 1, 1); PG8_STAGE(PG8_SB(1, 0), b3, voffB);
            PG8_BAR; PG8_WAIT_L(0); PG8_MMA(0, 1, At, B1); PG8_BAR;
            PG8_LDA(At, 1, 1); PG8_STAGE(PG8_SA(1, 0), a3, voffA);
            PG8_BAR; PG8_WAIT_L(0); PG8_MMA(1, 0, At, B0); PG8_BAR; PG8_SCHED;
            PG8_STAGE(PG8_SB(1, 1), b3 + hstep, voffB);
            PG8_WAIT_V(6); PG8_BAR; PG8_MMA(1, 1, At, B1); PG8_BAR;
            }
        }
        if constexpr (ALIGN_EPI) { if (wr == 0) PG8_BAR; }
        if constexpr (!Epi::AFTER_DRAIN) { if constexpr (Epi::ROWS) E(acc, cur, wr, wc, fr, fq, rsl); else E(acc, cur, wr, wc, fr, fq); S.done(cur); }
        if (!has_next) break;
#pragma unroll
        for (int a = 0; a < 2; ++a)
#pragma unroll
            for (int b = 0; b < 2; ++b)
#pragma unroll
                for (int m = 0; m < 4; ++m)
#pragma unroll
                    for (int n = 0; n < 2; ++n) acc[a][b][m][n] = (f32x4){0.f, 0.f, 0.f, 0.f};
        cur = nxt; cA = nA; cB = nB; ++ui;
        PG8_ROWS(cur, ui & 1);
        if constexpr (ALIGN_EPI) { if (wr == 1) PG8_BAR; }
    }
    PG8_WAIT_V(0);
    if constexpr (!ALIGN_EPI) { if (wr == 0) PG8_BAR; }
    PG8_BAR;
    if constexpr (Epi::AFTER_DRAIN) { E.fused(acc, cur, wr, wc, fr, fq, lds, wid, lane); S.done(cur); }
#undef PG8_ROWS
#undef PG8_AK
#undef PG8_SA
#undef PG8_SB
#undef PG8_STAGE
#undef PG8_LDA
#undef PG8_LDB
#undef PG8_MMA
#undef PG8_WAIT_V
#undef PG8_WAIT_L
#undef PG8_WAIT_VP
#undef PG8_PF
#undef PG8_BAR
#undef PG8_SCHED
}
}

constexpr int NWAVES = 8;
constexpr int PPITCH = 3072;
constexpr int BATCH = 8, SEQ = 8192, DM = 1024, NIN = 5120, CW = 512, AW = 512, FF = 4096, NH = 8, HD = 64, MBLK = 256, NBLK = SEQ / MBLK;
constexpr int M = BATCH * SEQ;
constexpr int C_U = 0, C_GBN = 1024;
constexpr int C_XIN = 0, C_GB = 512, C_GC = 1024, C_Q = 1536, C_K = 2048, C_V = 2560, C_GCONV = 3072, C_GATTN = 4096;
constexpr float RMS_EPS = 1e-6f, LOG2E = 1.4426950408889634f;
constexpr int N_PHASES = 10;

constexpr size_t MiB = 1u << 20;
constexpr size_t WS_CTL = 0, CTL_ZERO_BYTES = 65536;
constexpr int CW_BAR = 4096;
constexpr size_t WS_T5 = 1 * MiB, WS_KM = 1 * MiB + 65536;
constexpr size_t WS_WIN = 2 * MiB, WS_WC = 12 * MiB, WS_WA = 13 * MiB, WS_WO = 14 * MiB, WS_W1 = 16 * MiB, WS_W2 = 24 * MiB;
constexpr size_t WS_XN = 32 * MiB;
constexpr size_t WS_PROJ = 160 * MiB;
constexpr size_t WS_H = 288 * MiB;
constexpr size_t WS_U = 800 * MiB, WS_O = 864 * MiB;
constexpr size_t WS_PART = 928 * MiB, PART_STRIDE = 131072 + 4096;
constexpr size_t WS_END = 1024 * MiB;

constexpr int LDS_BYTES = 155648;
constexpr int LDS_BARST = LDS_BYTES - 64;

#define GAS __attribute__((address_space(1)))
#define LAS __attribute__((address_space(3)))
typedef unsigned short bf16;
typedef unsigned v4u __attribute__((ext_vector_type(4)));
typedef unsigned v2u __attribute__((ext_vector_type(2)));
typedef float f32x4 __attribute__((ext_vector_type(4)));
typedef float f32x2 __attribute__((ext_vector_type(2)));
typedef float f32x16 __attribute__((ext_vector_type(16)));
typedef short bf16x8 __attribute__((ext_vector_type(8)));
typedef short s16x4 __attribute__((ext_vector_type(4)));
#define LDS_WAIT() asm volatile("s_waitcnt lgkmcnt(0)" ::: "memory")
#define VM_WAIT() asm volatile("s_waitcnt vmcnt(0)" ::: "memory")
__device__ __forceinline__ unsigned f2bf(float f) { unsigned u = __builtin_bit_cast(unsigned, f); return (u + 0x7fffu + ((u >> 16) & 1u)) >> 16; }
__device__ __forceinline__ unsigned pk2(float lo, float hi) { return f2bf(lo) | (f2bf(hi) << 16); }
__device__ __forceinline__ float bflo(unsigned w) { return __uint_as_float(w << 16); }
__device__ __forceinline__ float bfhi(unsigned w) { return __uint_as_float(w & 0xffff0000u); }

#define XB_TMO      128
#define XB_XCNT(j)  (256  + 64 * (j))
#define XB_XSUB(j)  (1280 + 64 * (j))
#define XB_XGEN(j)  (2304 + 64 * (j))
#define XB_TOP      3328
#define XB_TOPGEN   3392
#define XCD_BAR_WORDS 3456
#define XB_SPIN_CAP (1u << 18)

__device__ __forceinline__ unsigned xb_ld(unsigned* p)              { return __hip_atomic_load(p, __ATOMIC_RELAXED, __HIP_MEMORY_SCOPE_AGENT); }
__device__ __forceinline__ unsigned xb_add(unsigned* p, unsigned v) { return __hip_atomic_fetch_add(p, v, __ATOMIC_RELAXED, __HIP_MEMORY_SCOPE_AGENT); }
__device__ __forceinline__ unsigned xb_xcc_id() { return (unsigned)__builtin_amdgcn_s_getreg((3 << 11) | 20) & 0xFu; }
#define XB_SPIN(cond, bar) do { unsigned _sp = 0; while (cond) { __builtin_amdgcn_s_sleep(1); \
    if ((++_sp & 255u) == 0u) { if (xb_ld(&(bar)[XB_TMO])) break; if (_sp > XB_SPIN_CAP) { atomicAdd(&(bar)[XB_TMO], 1u); break; } } } } while (0)

struct XcdBarrier {
    unsigned* bar; unsigned x;
    volatile LAS unsigned* st;
};

__device__ __forceinline__ XcdBarrier xcd_barrier_post(unsigned* bar, volatile LAS unsigned* st) {
    XcdBarrier b; b.bar = bar; b.x = xb_xcc_id(); b.st = st;
    if (threadIdx.x == 0) (void)xb_add(&bar[XB_XCNT(b.x)], 1u);
    return b;
}
__device__ __forceinline__ void xcd_barrier_complete(unsigned* bar, unsigned x, unsigned& nloc, unsigned& nx) {
    const unsigned G = gridDim.x * gridDim.y * gridDim.z;
    unsigned sum, cnt, mine, sp = 0u;
    for (;;) {
        sum = 0u; cnt = 0u; mine = 0u;
#pragma unroll
        for (unsigned j = 0; j < 16; ++j) { const unsigned c = xb_ld(&bar[XB_XCNT(j)]); sum += c; cnt += (c > 0u) ? 1u : 0u; mine = (j == x) ? c : mine; }
        if (sum == G) break;
        __builtin_amdgcn_s_sleep(1);
        if ((++sp & 255u) == 0u) { if (xb_ld(&bar[XB_TMO])) break; if (sp > XB_SPIN_CAP) { atomicAdd(&bar[XB_TMO], 1u); break; } }
    }
    nloc = mine > 0u ? mine : 1u; nx = cnt > 0u ? cnt : 1u;
}

__device__ __forceinline__ void xcd_barrier(const XcdBarrier& b) {
    asm volatile("s_waitcnt vmcnt(0)" ::: "memory");
    __syncthreads();
    if (threadIdx.x == 0) {
        unsigned* bar = b.bar;
        __builtin_amdgcn_s_waitcnt(0);
        unsigned nloc = b.st[0], nx = b.st[1];
        if (nloc == 0u) { xcd_barrier_complete(bar, b.x, nloc, nx); b.st[0] = nloc; b.st[1] = nx; }
        const unsigned old = xb_add(&bar[XB_XSUB(b.x)], 1u);
        const unsigned gen = old / nloc;
        if (old + 1u == (gen + 1u) * nloc) {
            __builtin_amdgcn_fence(__ATOMIC_RELEASE, "agent");
            asm volatile("s_waitcnt vmcnt(0)" ::: "memory");
            const unsigned og = xb_add(&bar[XB_TOP], 1u);
            const unsigned tg = og / nx;
            if (og + 1u == (tg + 1u) * nx) xb_add(&bar[XB_TOPGEN], 1u);
            else XB_SPIN(xb_ld(&bar[XB_TOPGEN]) == tg, bar);
            __builtin_amdgcn_fence(__ATOMIC_ACQUIRE, "agent");
            xb_add(&bar[XB_XGEN(b.x)], 1u);
            asm volatile("s_waitcnt vmcnt(0)" ::: "memory");
        } else {
            XB_SPIN(xb_ld(&bar[XB_XGEN(b.x)]) == gen, bar);
            __builtin_amdgcn_fence(__ATOMIC_ACQUIRE, "agent");
            asm volatile("s_waitcnt vmcnt(0)" ::: "memory");
        }
    }
    __syncthreads();
}

__device__ __forceinline__ void xcd_barrier_local(const XcdBarrier& b) {
    asm volatile("s_waitcnt vmcnt(0)" ::: "memory");
    __syncthreads();
    if (threadIdx.x == 0) {
        unsigned* bar = b.bar;
        __builtin_amdgcn_s_waitcnt(0);
        const unsigned nloc = b.st[0];
        const unsigned old = xb_add(&bar[XB_XSUB(b.x)], 1u);
        const unsigned gen = old / nloc;
        if (old + 1u == (gen + 1u) * nloc) xb_add(&bar[XB_XGEN(b.x)], 1u);
        else XB_SPIN(xb_ld(&bar[XB_XGEN(b.x)]) == gen, bar);
        __builtin_amdgcn_fence(__ATOMIC_ACQUIRE, "agent");
        asm volatile("s_waitcnt vmcnt(0)" ::: "memory");
    }
    __syncthreads();
}

struct Frame {
    LAS unsigned char* lds;
    int tid, lane, wave, vcu, G;
    const float *x, *g_pre1, *w_in, *conv_w, *w_cout, *w_aout, *rel_bias, *w_o, *g_post1, *g_pre2, *w1, *w2, *g_post2;
    float* out;
    bf16 *Win_t, *Wc_t, *Wa_t, *Wo_t, *W1_t, *W2_t;
    bf16 *XN, *PROJ, *U, *O, *M1, *MIX, *HB, *FB, *X1B, *GT;
    float *T5, *KM, *RS2, *RS1; unsigned* convctr;
    unsigned char* part;
};

__device__ __forceinline__ float wave_sum(float v) {
#pragma unroll
    for (int o = 1; o < 64; o <<= 1) v += __shfl_xor(v, o);
    return v;
}
__device__ __forceinline__ void p0_transpose_item(const float* W, int K, int N, bf16* WT, LAS float* scr, int item, int lane, int ldk = 0, int koff = 0, bool gate_il = false, const float* kgain = nullptr) {
    if (ldk == 0) ldk = K;
    const int nblk = N / 32, kb = item / nblk, nb = item % nblk, k0 = 64 * kb, n0 = 32 * nb;
    int nd0 = n0;
    if (gate_il && n0 < C_Q) { if (n0 < C_GB) nd0 = 256 * (n0 >> 7) + (n0 & 127); else if (n0 < C_GC) nd0 = C_GBN + (n0 - C_GB); else nd0 = 256 * ((n0 - C_GC) >> 7) + 128 + ((n0 - C_GC) & 127); }
    if (gate_il && n0 >= C_GCONV) { const int blk = n0 >= C_GATTN ? 1 : 0, cc = n0 - (blk ? C_GATTN : C_GCONV); nd0 = C_GCONV + 256 * (cc >> 7) + 128 * blk + (cc & 127); }
    float t[32];
#pragma unroll
    for (int i = 0; i < 32; ++i) t[i] = __builtin_nontemporal_load(W + (size_t)(k0 + 2 * i + (lane >> 5)) * N + n0 + (lane & 31));
    const int c = lane & 7;
    float g8[8];
    if (kgain) { const f32x4 ga = *(const GAS f32x4*)(kgain + k0 + 8 * c), gb = *(const GAS f32x4*)(kgain + k0 + 8 * c + 4);
        g8[0] = ga.x; g8[1] = ga.y; g8[2] = ga.z; g8[3] = ga.w; g8[4] = gb.x; g8[5] = gb.y; g8[6] = gb.z; g8[7] = gb.w; }
    else {
#pragma unroll
        for (int e = 0; e < 8; ++e) g8[e] = 1.0f; }
    __builtin_amdgcn_sched_barrier(0);
#pragma unroll
    for (int i = 0; i < 32; ++i) scr[(2 * i + (lane >> 5)) * 33 + (lane & 31)] = t[i];
    LDS_WAIT(); asm volatile("" ::: "memory");
#pragma unroll
    for (int j = 0; j < 4; ++j) { const int n = (lane >> 3) + 8 * j; const LAS float* s = scr + (8 * c) * 33 + n;
        v4u o; o.x = pk2(s[0 * 33] * g8[0], s[1 * 33] * g8[1]); o.y = pk2(s[2 * 33] * g8[2], s[3 * 33] * g8[3]); o.z = pk2(s[4 * 33] * g8[4], s[5 * 33] * g8[5]); o.w = pk2(s[6 * 33] * g8[6], s[7 * 33] * g8[7]);
        *(GAS v4u*)(WT + (size_t)(nd0 + n) * ldk + koff + k0 + 8 * c) = o; }
    LDS_WAIT(); asm volatile("" ::: "memory");
}
__device__ __forceinline__ void rms_row_to_bf16(const float* xrow, const float* gain, bf16* orow, int lane) {
    const GAS f32x4* xr = (const GAS f32x4*)xrow + lane; const GAS f32x4* gr = (const GAS f32x4*)gain + lane;
    f32x4 v[4]; float s = 0.f;
#pragma unroll
    for (int j = 0; j < 4; ++j) { v[j] = xr[64 * j]; s += (v[j].x * v[j].x + v[j].y * v[j].y) + (v[j].z * v[j].z + v[j].w * v[j].w); }
    const float rs = 1.0f / sqrtf(wave_sum(s) * (1.f / DM) + RMS_EPS);
    GAS v2u* o8 = (GAS v2u*)orow + lane;
#pragma unroll
    for (int j = 0; j < 4; ++j) { const f32x4 g = gr[64 * j]; v2u w; w.x = pk2(v[j].x * rs * g.x, v[j].y * rs * g.y); w.y = pk2(v[j].z * rs * g.z, v[j].w * rs * g.w); o8[64 * j] = w; }
}
__device__ __forceinline__ void p0_prologue(Frame& F) {
    LAS float* scr = (LAS float*)(F.lds + F.wave * 16384);
    const int gw = F.vcu * NWAVES + F.wave, NGW = F.G * NWAVES;
    constexpr int I_IN = (DM / 64) * (NIN / 32), I_C = (CW / 64) * (DM / 32), I_A = (AW / 64) * (DM / 32), I_O = (DM / 64) * (DM / 32), I_1 = (DM / 64) * (FF / 32), I_2 = (FF / 64) * (DM / 32);
    constexpr int NITEMS = I_IN + I_C + I_A + I_O + I_1 + I_2;
    for (int it = gw; it < NITEMS; it += NGW) {
        int r = it;
        if (r < I_IN) { p0_transpose_item(F.w_in, DM, NIN, F.Win_t, scr, r, F.lane, 0, 0, true, F.g_pre1); continue; } r -= I_IN;
        if (r < I_C) { p0_transpose_item(F.w_cout, CW, DM, F.Wc_t, scr, r, F.lane, CW + AW, 0); continue; } r -= I_C;
        if (r < I_A) { p0_transpose_item(F.w_aout, AW, DM, F.Wc_t, scr, r, F.lane, CW + AW, CW); continue; } r -= I_A;
        if (r < I_O) { p0_transpose_item(F.w_o, DM, DM, F.Wo_t, scr, r, F.lane); continue; } r -= I_O;
        if (r < I_1) { p0_transpose_item(F.w1, DM, FF, F.W1_t, scr, r, F.lane, 0, 0, false, F.g_pre2); continue; } r -= I_1;
        p0_transpose_item(F.w2, FF, DM, F.W2_t, scr, r, F.lane);
    }
    for (int m = gw; m < M; m += 2 * NGW) {
        const int m2 = m + NGW; const GAS f32x4* xa = (const GAS f32x4*)(F.x + (size_t)m * DM) + F.lane; const GAS f32x4* xb = (const GAS f32x4*)(F.x + (size_t)m2 * DM) + F.lane;
        f32x4 va[4], vb[4]; float sa = 0.f, sb = 0.f;
#pragma unroll
        for (int j = 0; j < 4; ++j) { va[j] = __builtin_nontemporal_load(xa + 64 * j); vb[j] = __builtin_nontemporal_load(xb + 64 * j); }
#pragma unroll
        for (int j = 0; j < 4; ++j) { sa += (va[j].x * va[j].x + va[j].y * va[j].y) + (va[j].z * va[j].z + va[j].w * va[j].w); sb += (vb[j].x * vb[j].x + vb[j].y * vb[j].y) + (vb[j].z * vb[j].z + vb[j].w * vb[j].w); }
        const float ra = 1.0f / sqrtf(wave_sum(sa) * (1.f / DM) + RMS_EPS), rb = 1.0f / sqrtf(wave_sum(sb) * (1.f / DM) + RMS_EPS);
        if (F.lane == 0) { F.RS1[m] = ra; F.RS1[m2] = rb; }
        GAS v2u* oa = (GAS v2u*)(F.XN + (size_t)m * DM) + F.lane; GAS v2u* ob = (GAS v2u*)(F.XN + (size_t)m2 * DM) + F.lane;
#pragma unroll
        for (int j = 0; j < 4; ++j) { v2u w; w.x = pk2(va[j].x, va[j].y); w.y = pk2(va[j].z, va[j].w); oa[64 * j] = w;
            w.x = pk2(vb[j].x, vb[j].y); w.y = pk2(vb[j].z, vb[j].w); ob[64 * j] = w; }
    }
    for (int e = F.vcu * 512 + F.tid; e < (M / MBLK) * 512; e += F.G * 512) F.KM[e] = 0.f;
    for (int e = F.vcu * 512 + F.tid; e < NH * 1024; e += F.G * 512) {
        const int h = e >> 10, d = e & 1023; int bk;
        if (d < 16) bk = d; else { bk = 16; const int thr[15] = {21, 27, 35, 46, 59, 77, 99, 128, 166, 216, 280, 363, 470, 609, 790};
#pragma unroll
            for (int k = 0; k < 15; ++k) bk += (d >= thr[k]) ? 1 : 0; }
        F.T5[e] = F.rel_bias[h * 32 + bk] * LOG2E;
    }
}

__device__ __forceinline__ void conv_tail(Frame& F) {
    const int c = F.lane * 8;
    float w0[8], w1[8], w2[8];
#pragma unroll
    for (int e = 0; e < 8; ++e) { w0[e] = F.conv_w[c + e]; w1[e] = F.conv_w[CW + c + e]; w2[e] = F.conv_w[2 * CW + c + e]; }
#pragma unroll 1
    for (;;) {
        const bool grp = (F.G % 8) == 0; const int gx = (int)blockIdx.x & 7;
        int rr = 0; if (F.lane == 0) rr = (int)__hip_atomic_fetch_add(F.convctr + (grp ? 64 * gx : 0), 1u, __ATOMIC_RELAXED, __HIP_MEMORY_SCOPE_AGENT);
        rr = __builtin_amdgcn_readfirstlane(rr);
        if (rr >= (grp ? SEQ / 32 : M / 32)) break;
        const int t0 = (grp ? gx * SEQ : 0) + rr * 32; const bf16* P = F.PROJ + (size_t)t0 * PPITCH + c;
        float um2[8], um1[8];
        if ((t0 % SEQ) == 0) {
#pragma unroll
            for (int e = 0; e < 8; ++e) { um2[e] = 0.f; um1[e] = 0.f; }
        } else {
            const v4u xa = *(const GAS v4u*)(P - 2 * PPITCH + C_U), xb = *(const GAS v4u*)(P - PPITCH + C_U);
            um2[0] = bflo(xa.x); um2[1] = bfhi(xa.x); um2[2] = bflo(xa.y); um2[3] = bfhi(xa.y); um2[4] = bflo(xa.z); um2[5] = bfhi(xa.z); um2[6] = bflo(xa.w); um2[7] = bfhi(xa.w);
            um1[0] = bflo(xb.x); um1[1] = bfhi(xb.x); um1[2] = bflo(xb.y); um1[3] = bfhi(xb.y); um1[4] = bflo(xb.z); um1[5] = bfhi(xb.z); um1[6] = bflo(xb.w); um1[7] = bfhi(xb.w);
        }
        bf16* Up = F.U + (size_t)t0 * (CW + AW) + c;
#pragma unroll 1
        for (int r0 = 0; r0 < 32; r0 += 4) {
            v4u xv[4], bv[4];
#pragma unroll
            for (int k = 0; k < 4; ++k) { const bf16* Pr = P + (size_t)(r0 + k) * PPITCH; xv[k] = __builtin_nontemporal_load((const GAS v4u*)(Pr + C_U)); bv[k] = __builtin_nontemporal_load((const GAS v4u*)(Pr + C_GBN)); }
#pragma unroll
            for (int k = 0; k < 4; ++k) {
                float u[8], b[8];
                u[0] = bflo(xv[k].x); u[1] = bfhi(xv[k].x); u[2] = bflo(xv[k].y); u[3] = bfhi(xv[k].y); u[4] = bflo(xv[k].z); u[5] = bfhi(xv[k].z); u[6] = bflo(xv[k].w); u[7] = bfhi(xv[k].w);
                b[0] = bflo(bv[k].x); b[1] = bfhi(bv[k].x); b[2] = bflo(bv[k].y); b[3] = bfhi(bv[k].y); b[4] = bflo(bv[k].z); b[5] = bfhi(bv[k].z); b[6] = bflo(bv[k].w); b[7] = bfhi(bv[k].w);
                float o[8];
#pragma unroll
                for (int e = 0; e < 8; ++e) { o[e] = b[e] * (w0[e] * um2[e] + w1[e] * um1[e] + w2[e] * u[e]); um2[e] = um1[e]; um1[e] = u[e]; }
                v4u w; w.x = pk2(o[0], o[1]); w.y = pk2(o[2], o[3]); w.z = pk2(o[4], o[5]); w.w = pk2(o[6], o[7]);
                *(GAS v4u*)(Up + (size_t)(r0 + k) * (CW + AW)) = w; }
        }
    }
}

__device__ __forceinline__ void p6_norms(Frame& F) {
    const int gw = F.vcu * NWAVES + F.wave, NGW = F.G * NWAVES; const bool BL = (F.G == 256); const int R2 = BL ? SEQ / 2 : NGW;
    const GAS f32x4* g1 = (const GAS f32x4*)F.g_post1 + F.lane;
    f32x4 gg[4];
#pragma unroll
    for (int j = 0; j < 4; ++j) gg[j] = g1[64 * j];
    for (int jj = 0; jj < M / (2 * NGW); ++jj) { const int m0 = BL ? (F.vcu >> 5) * SEQ + (F.vcu & 31) * NWAVES + F.wave + jj * 256 : gw + jj * 2 * NGW;
        f32x4 v[2][4], xv[2][4]; float s[2] = {0.f, 0.f};
#pragma unroll
        for (int rr = 0; rr < 2; ++rr) { const size_t m = (size_t)(m0 + rr * R2);
            const GAS v2u* mr = (const GAS v2u*)(F.MIX + m * DM) + F.lane; const GAS v2u* xr = (const GAS v2u*)(F.XN + m * DM) + F.lane;
#pragma unroll
            for (int j = 0; j < 4; ++j) { const v2u w = __builtin_nontemporal_load(mr + 64 * j); const v2u xw = __builtin_nontemporal_load(xr + 64 * j); xv[rr][j] = (f32x4){bflo(xw.x), bfhi(xw.x), bflo(xw.y), bfhi(xw.y)}; v[rr][j] = (f32x4){bflo(w.x), bfhi(w.x), bflo(w.y), bfhi(w.y)}; } }
#pragma unroll
        for (int rr = 0; rr < 2; ++rr)
#pragma unroll
            for (int j = 0; j < 4; ++j) s[rr] += (v[rr][j].x * v[rr][j].x + v[rr][j].y * v[rr][j].y) + (v[rr][j].z * v[rr][j].z + v[rr][j].w * v[rr][j].w);
        float rs[2], s2[2] = {0.f, 0.f};
#pragma unroll
        for (int rr = 0; rr < 2; ++rr) rs[rr] = 1.0f / sqrtf(wave_sum(s[rr]) * (1.f / DM) + RMS_EPS);
#pragma unroll
        for (int rr = 0; rr < 2; ++rr) { const size_t m = (size_t)(m0 + rr * R2); GAS v2u* x1row = (GAS v2u*)(F.X1B + m * DM) + F.lane;
#pragma unroll
            for (int j = 0; j < 4; ++j) { const f32x4 g = gg[j]; v[rr][j] = xv[rr][j] + v[rr][j] * rs[rr] * g; v2u w; w.x = pk2(v[rr][j].x, v[rr][j].y); w.y = pk2(v[rr][j].z, v[rr][j].w); x1row[64 * j] = w;
                s2[rr] += (v[rr][j].x * v[rr][j].x + v[rr][j].y * v[rr][j].y) + (v[rr][j].z * v[rr][j].z + v[rr][j].w * v[rr][j].w); } }
#pragma unroll
        for (int rr = 0; rr < 2; ++rr) { const size_t m = (size_t)(m0 + rr * R2); const float rs2 = 1.0f / sqrtf(wave_sum(s2[rr]) * (1.f / DM) + RMS_EPS);
            if (F.lane == 0) F.RS2[m] = rs2; }
    }
}
__device__ __forceinline__ void p9_final(Frame& F) {
    const int gw = F.vcu * NWAVES + F.wave, NGW = F.G * NWAVES; const bool BL = (F.G == 256); const int R2 = BL ? SEQ / 2 : NGW;
    const GAS f32x4* g1 = (const GAS f32x4*)F.g_post2 + F.lane;
    f32x4 gg[4];
#pragma unroll
    for (int j = 0; j < 4; ++j) gg[j] = g1[64 * j];
    for (int jj = 0; jj < M / (2 * NGW); ++jj) { const int m0 = BL ? (F.vcu >> 5) * SEQ + (F.vcu & 31) * NWAVES + F.wave + jj * 256 : gw + jj * 2 * NGW;
        f32x4 v[2][4]; v2u xw[2][4]; float s[2] = {0.f, 0.f};
#pragma unroll
        for (int rr = 0; rr < 2; ++rr) { const size_t m = (size_t)(m0 + rr * R2);
            const GAS v2u* fr = (const GAS v2u*)(F.FB + m * DM) + F.lane; const GAS v2u* x1row = (const GAS v2u*)(F.X1B + m * DM) + F.lane;
#pragma unroll
            for (int j = 0; j < 4; ++j) { const v2u w = __builtin_nontemporal_load(fr + 64 * j); xw[rr][j] = __builtin_nontemporal_load(x1row + 64 * j); v[rr][j] = (f32x4){bflo(w.x), bfhi(w.x), bflo(w.y), bfhi(w.y)}; } }
#pragma unroll
        for (int rr = 0; rr < 2; ++rr)
#pragma unroll
            for (int j = 0; j < 4; ++j) s[rr] += (v[rr][j].x * v[rr][j].x + v[rr][j].y * v[rr][j].y) + (v[rr][j].z * v[rr][j].z + v[rr][j].w * v[rr][j].w);
#pragma unroll
        for (int rr = 0; rr < 2; ++rr) { const size_t m = (size_t)(m0 + rr * R2); const float rs = 1.0f / sqrtf(wave_sum(s[rr]) * (1.f / DM) + RMS_EPS);
            GAS f32x4* orow = (GAS f32x4*)(F.out + m * DM) + F.lane;
#pragma unroll
            for (int j = 0; j < 4; ++j) { const f32x4 g = gg[j]; const f32x4 x1 = (f32x4){bflo(xw[rr][j].x), bfhi(xw[rr][j].x), bflo(xw[rr][j].y), bfhi(xw[rr][j].y)}; orow[64 * j] = x1 + v[rr][j] * rs * g; } }
    }
}

namespace moba2 {
constexpr int NSLOT = 3, SLOTB = 16384;
constexpr int L_RING = 0;
constexpr int L_OST = NSLOT * SLOTB;
constexpr int L_QST = L_OST + NWAVES * 4096;
constexpr int TXMAX = 1343, TLEN = TXMAX + 65;
constexpr int L_TB = L_QST + NWAVES * 4096;
constexpr int L_LIST = L_TB + 2 * TLEN * 4;
constexpr int L_SEL = L_LIST + 15360;
constexpr int L_WSF = L_SEL + 10240;
constexpr int L_CNT = L_WSF + NWAVES * 256;
constexpr int L_RTAB = L_CNT + 512;
constexpr int L_MISC = L_RTAB + 384;
constexpr int L_END = L_MISC + 64;
static_assert(L_END <= LDS_BARST, "attention LDS map");
__device__ __forceinline__ int crow(int r, int hi) { return (r & 3) + 8 * (r >> 2) + 4 * hi; }
typedef short v4i16_t __attribute__((ext_vector_type(4)));
__device__ __forceinline__ s16x4 vtr(const LAS unsigned char* p) { return __builtin_bit_cast(s16x4, __builtin_amdgcn_ds_read_tr16_b64_v4i16((LAS v4i16_t*)p)); }
typedef float f32x2_t __attribute__((ext_vector_type(2))); typedef __bf16 bf16x2_t __attribute__((ext_vector_type(2)));
__device__ __forceinline__ unsigned cvtpk(float lo, float hi) { f32x2_t v = {lo, hi}; bf16x2_t b = __builtin_convertvector(v, bf16x2_t); return __builtin_bit_cast(unsigned, b); }

__device__ __forceinline__ void unit(Frame& F, int b, int h, int lo, int hi_blk) {
    LAS unsigned char* lds = F.lds;
    LAS float* tb = (LAS float*)(lds + L_TB); LAS unsigned short* list = (LAS unsigned short*)(lds + L_LIST); LAS unsigned* selw = (LAS unsigned*)(lds + L_SEL);
    LAS float* wsf = (LAS float*)(lds + L_WSF) + F.wave * 64;
    LAS int* cnt = (LAS int*)(lds + L_CNT); LAS int* off = cnt + 32; LAS int* cur = cnt + 64; LAS unsigned* rtab = (LAS unsigned*)(lds + L_RTAB); LAS int* misc = (LAS int*)(lds + L_MISC);
    const int lane = F.lane, r32 = lane & 31, hi = lane >> 5, tid = F.tid, w = F.wave;
    const int nblk = hi_blk - lo, nq = nblk * MBLK;
    const size_t tokb = (size_t)b * SEQ;
    bf16* PO = (bf16*)F.out; float* PL = (float*)F.part;
    if (tid < 96) cnt[tid] = 0;
    { constexpr int NTB = (2 * TLEN + 511) / 512; float tv[NTB];
#pragma unroll
      for (int k = 0; k < NTB; ++k) { const int e = tid + 512 * k, sft = e >= TLEN ? 1 : 0, x = e - sft * TLEN + sft; int d = TXMAX - x; d = d < 0 ? 0 : (d > 1023 ? 1023 : d); tv[k] = F.T5[h * 1024 + d]; }
      __builtin_amdgcn_sched_barrier(0);
#pragma unroll
      for (int k = 0; k < NTB; ++k) { const int e = tid + 512 * k, sft = e >= TLEN ? 1 : 0, x = e - sft * TLEN + sft, d = TXMAX - x; if (e < 2 * TLEN) tb[e] = d < 0 ? -INFINITY : tv[k]; } }
    __syncthreads();
    {
        bf16x8 kmh[4], kml[4];
        f32x4 kav[4], kbv[4];
#pragma unroll
        for (int d0 = 0; d0 < 4; ++d0) { const float* kmp = F.KM + ((size_t)(b * NBLK + r32) * 512 + h * 64 + d0 * 16 + hi * 8); kav[d0] = *(const GAS f32x4*)kmp; kbv[d0] = *(const GAS f32x4*)(kmp + 4); }
        __builtin_amdgcn_sched_barrier(0);
#pragma unroll
        for (int d0 = 0; d0 < 4; ++d0) {
            const f32x4 ka = kav[d0], kb = kbv[d0];
            const float kf[8] = {ka.x, ka.y, ka.z, ka.w, kb.x, kb.y, kb.z, kb.w}; unsigned hb[8], lb[8];
#pragma unroll
            for (int e = 0; e < 8; ++e) { hb[e] = f2bf(kf[e]); lb[e] = f2bf(kf[e] - __uint_as_float(hb[e] << 16)); }
            v4u hw, lw; hw.x = hb[0] | (hb[1] << 16); hw.y = hb[2] | (hb[3] << 16); hw.z = hb[4] | (hb[5] << 16); hw.w = hb[6] | (hb[7] << 16);
            lw.x = lb[0] | (lb[1] << 16); lw.y = lb[2] | (lb[3] << 16); lw.z = lb[4] | (lb[5] << 16); lw.w = lb[6] | (lb[7] << 16);
            kmh[d0] = __builtin_bit_cast(bf16x8, hw); kml[d0] = __builtin_bit_cast(bf16x8, lw);
        }
        const bf16* qsel = F.PROJ + (tokb + (size_t)lo * MBLK + r32) * PPITCH + C_Q + h * 64 + hi * 8;
        bf16x8 qc[4];
#pragma unroll
        for (int d0 = 0; d0 < 4; ++d0) qc[d0] = *(const GAS bf16x8*)(qsel + (size_t)(w * 32) * PPITCH + d0 * 16);
#pragma unroll 1
        for (int tq = w; tq < nq / 32; tq += NWAVES) {
            const int i = lo + (tq >> 3); const int qu = tq * 32 + r32;
            const int tn = (tq + NWAVES < nq / 32) ? tq + NWAVES : tq;
            bf16x8 qn[4];
#pragma unroll
            for (int d0 = 0; d0 < 4; ++d0) qn[d0] = *(const GAS bf16x8*)(qsel + (size_t)(tn * 32) * PPITCH + d0 * 16);
            __builtin_amdgcn_sched_barrier(0);
            f32x16 g = f32x16{};
#pragma unroll
            for (int d0 = 0; d0 < 4; ++d0) { const bf16x8 qf = qc[d0];
                g = __builtin_amdgcn_mfma_f32_32x32x16_bf16(kmh[d0], qf, g, 0, 0, 0); g = __builtin_amdgcn_mfma_f32_32x32x16_bf16(kml[d0], qf, g, 0, 0, 0); }
#pragma unroll
            for (int d0 = 0; d0 < 4; ++d0) qc[d0] = qn[d0];
            float v0 = -INFINITY, v1 = -INFINITY, v2 = -INFINITY; int j0 = 0, j1 = 0, j2 = 0;
#define MOBA_INS(xg_, jj_) do { const float xg = (xg_); const int jj = (jj_); const bool c0 = xg > v0, c1 = xg > v1, c2 = xg > v2; \
            const float nv2 = c1 ? v1 : (c2 ? xg : v2), nv1 = c0 ? v0 : (c1 ? xg : v1), nv0 = c0 ? xg : v0; \
            const int nj2 = c1 ? j1 : (c2 ? jj : j2), nj1 = c0 ? j0 : (c1 ? jj : j1), nj0 = c0 ? jj : j0; \
            v0 = nv0; v1 = nv1; v2 = nv2; j0 = nj0; j1 = nj1; j2 = nj2; } while (0)
#pragma unroll
            for (int r = 0; r < 16; ++r) { const int jc = crow(r, hi); MOBA_INS(jc < i ? g[r] : -INFINITY, jc); }
            { const float u0 = __shfl_xor(v0, 32), u1 = __shfl_xor(v1, 32), u2 = __shfl_xor(v2, 32); const int k0 = __shfl_xor(j0, 32), k1 = __shfl_xor(j1, 32), k2 = __shfl_xor(j2, 32);
              MOBA_INS(u0, k0); MOBA_INS(u1, k1); MOBA_INS(u2, k2); }
#undef MOBA_INS
            if (hi == 0) {
                const int nsel = i < 3 ? i : 3;
                selw[qu] = (unsigned)j0 | ((unsigned)j1 << 5) | ((unsigned)j2 << 10);
                if (nsel > 0) __hip_atomic_fetch_add(cnt + j0, 1, __ATOMIC_RELAXED, __HIP_MEMORY_SCOPE_WORKGROUP);
                if (nsel > 1) __hip_atomic_fetch_add(cnt + j1, 1, __ATOMIC_RELAXED, __HIP_MEMORY_SCOPE_WORKGROUP);
                if (nsel > 2) __hip_atomic_fetch_add(cnt + j2, 1, __ATOMIC_RELAXED, __HIP_MEMORY_SCOPE_WORKGROUP);
            }
        }
    }
    __syncthreads();
    if (w == 0) {
        const int c = lane < 32 ? cnt[lane & 31] : 0; const int nt = (c + 31) >> 5, nr = (nt + 7) >> 3;
        int inc = c, incr = nr;
#pragma unroll
        for (int o2 = 1; o2 < 32; o2 <<= 1) { const int t = __shfl_up(inc, o2), t2 = __shfl_up(incr, o2); if ((lane & 31) >= o2) { inc += t; incr += t2; } }
        if (lane < 32) { off[lane] = inc - c; cur[lane] = inc - c;
            for (int r = 0; r < nr; ++r) rtab[nblk + incr - nr + r] = (unsigned)lane | ((unsigned)(r * 8) << 8) | ((unsigned)nt << 16); }
        if (lane < nblk) rtab[lane] = (unsigned)(lo + lane) | 0x80000000u;
        if (lane == 31) misc[0] = nblk + incr;
    }
    __syncthreads();
    for (int qu = tid; qu < nq; qu += 512) {
        const int i = lo + (qu >> 8); const int nsel = i < 3 ? i : 3; const unsigned s = selw[qu];
        if (nsel > 0) { const int p = __hip_atomic_fetch_add(cur + (s & 31), 1, __ATOMIC_RELAXED, __HIP_MEMORY_SCOPE_WORKGROUP); list[p] = (unsigned short)(qu | (0 << 12)); }
        if (nsel > 1) { const int p = __hip_atomic_fetch_add(cur + ((s >> 5) & 31), 1, __ATOMIC_RELAXED, __HIP_MEMORY_SCOPE_WORKGROUP); list[p] = (unsigned short)(qu | (1 << 12)); }
        if (nsel > 2) { const int p = __hip_atomic_fetch_add(cur + ((s >> 10) & 31), 1, __ATOMIC_RELAXED, __HIP_MEMORY_SCOPE_WORKGROUP); list[p] = (unsigned short)(qu | (2 << 12)); }
    }
    __syncthreads();
    const int nrounds = __builtin_amdgcn_readfirstlane(misc[0]), NT = nrounds * 4;
    const char* kvh = (const char*)(F.PROJ + tokb * PPITCH + h * 64);
    const int kkey = 8 * w + (lane >> 3), kch = (lane & 7) ^ ((kkey >> 1) & 7);
    const int vkey = 16 * (w & 3) + (lane >> 2);
    const unsigned ksrc_off = (unsigned)(kkey * PPITCH + C_K + kch * 8) * 2u, vsrc_off = (unsigned)(vkey * PPITCH + C_V + (w >> 2) * 32 + (lane & 3) * 8) * 2u;
    const unsigned lds0 = (unsigned)(uintptr_t)lds;
#define MOBA_GLDS(gsrc_, dst_) do { unsigned keep_; asm volatile("s_mov_b32 %0, m0\n\ts_mov_b32 m0, %2\n\ts_nop 0\n\tglobal_load_lds_dwordx4 %1, off\n\ts_mov_b32 m0, %0" : "=&s"(keep_) : "v"(gsrc_), "s"(dst_) : "memory"); } while (0)
#define MOBA_GLDS_NT(gsrc_, dst_) do { unsigned keep_; asm volatile("s_mov_b32 %0, m0\n\ts_mov_b32 m0, %2\n\ts_nop 0\n\tglobal_load_lds_dwordx4 %1, off nt\n\ts_mov_b32 m0, %0" : "=&s"(keep_) : "v"(gsrc_), "s"(dst_) : "memory"); } while (0)
#define MOBA_DMA(jj_, kt_, sl_) do { const char* tb_ = kvh + (size_t)((jj_) * MBLK + (kt_) * 64) * (PPITCH * 2); \
        const unsigned kd_ = (unsigned)__builtin_amdgcn_readfirstlane(lds0 + L_RING + (sl_) * SLOTB + w * 1024), vd_ = (unsigned)__builtin_amdgcn_readfirstlane(lds0 + L_RING + (sl_) * SLOTB + 8192 + w * 1024); \
        MOBA_GLDS(tb_ + ksrc_off, kd_); MOBA_GLDS(tb_ + vsrc_off, vd_); } while (0)
    const int koff = r32 * 128, ksw = (r32 >> 1) & 7;
    const int voff = (4 * hi + ((lane & 15) >> 2)) * 64 + ((lane >> 4) & 1) * 32 + (lane & 3) * 8;
    LAS unsigned char* ost = lds + L_OST + w * 4096;
    LAS int* prow_s = (LAS int*)(wsf + 32);
    bool active = false, near = false, stored_prev = false; int dq = 0, kt_max = 3, jcur = 0, jnext = 0;
    bool n_active = false, n_near = false; int n_dq = 0, n_prow = -1, n_ktmax = 3;
    bf16x8 qf[4]; float mhat = 0.f, l = 0.f, c0 = 0.f, bfar = 0.f; f32x16 o[2]; bool first = true;
    o[0] = f32x16{}; o[1] = f32x16{};
    const unsigned qst0 = lds0 + L_QST + w * 4096; const LAS unsigned char* qst = lds + L_QST + w * 4096;
    bf16* trash = (bf16*)(F.part + 16 * MiB) + (size_t)(blockIdx.x * NWAVES + w) * 2048;
    const char* qbase = (const char*)(F.PROJ + (tokb + (size_t)lo * MBLK) * PPITCH + C_Q + h * 64) + (lane & 7) * 16;
    const int prow_base = (int)(((tokb + (size_t)lo * MBLK) * NH + h) * 4);
#define MOBA_PREP(R_) do { const unsigned re = (unsigned)__builtin_amdgcn_readfirstlane((int)rtab[(R_)]); const int j = re & 31; const bool own = (re >> 31) != 0; int qu, slot, base = 0, lim = 0; bool vld; \
        jnext = j; \
        if (own) { n_active = true; vld = true; qu = (j - lo) * MBLK + w * 32 + r32; slot = 3; n_near = true; n_ktmax = w >> 1; n_dq = w * 32 + r32; } \
        else { const int t0 = (re >> 8) & 255, nt = (re >> 16) & 255; const int tile = t0 + w; n_active = tile < nt; \
            const int cj = __builtin_amdgcn_readfirstlane(cnt[j]), pos = tile * 32 + r32; vld = n_active && pos < cj; base = __builtin_amdgcn_readfirstlane(off[j]) + (n_active ? tile * 32 : 0); lim = n_active ? cj - tile * 32 : 1; \
            const unsigned le = list[base + (vld ? r32 : 0)]; qu = le & 4095; slot = le >> 12; \
            const int i = lo + (qu >> 8); n_ktmax = 3; n_dq = (i - j) * MBLK + (qu & 255); n_near = __any((j + 5 > i) && n_active) != 0; } \
        n_prow = vld ? prow_base + qu * (NH * 4) + slot : -1; \
        _Pragma("unroll") for (int n_ = 0; n_ < 4; ++n_) { const int rho = 8 * n_ + (lane >> 3); int qr; \
            if (own) qr = (j - lo) * MBLK + w * 32 + rho; else qr = list[base + (rho < lim ? rho : 0)] & 4095; \
            const char* src = qbase + (unsigned)qr * (unsigned)(PPITCH * 2); \
            const unsigned qd_ = (unsigned)__builtin_amdgcn_readfirstlane(qst0 + n_ * 1024); MOBA_GLDS_NT(src, qd_); } } while (0)
    MOBA_PREP(0); jcur = jnext;
    MOBA_DMA(jcur, 0, 0); MOBA_DMA(jcur, 1, 1);
    asm volatile("s_waitcnt vmcnt(0)" ::: "memory");
#pragma unroll 1
    for (int T = 0; T < NT; ++T) {
        const int kt = T & 3;
        if (kt == 2) asm volatile("s_waitcnt vmcnt(2) lgkmcnt(0)" ::: "memory");
        else if (kt == 3) asm volatile("s_waitcnt vmcnt(6) lgkmcnt(0)" ::: "memory");
        else if (__builtin_amdgcn_readfirstlane((int)stored_prev)) asm volatile("s_waitcnt vmcnt(7) lgkmcnt(0)" ::: "memory");
        else asm volatile("s_waitcnt vmcnt(2) lgkmcnt(0)" ::: "memory");
        __builtin_amdgcn_s_barrier(); asm volatile("" ::: "memory");
        if (kt == 2) { const int Rn = (T >> 2) + 1; MOBA_PREP(Rn < nrounds ? Rn : nrounds - 1); }
        { const int sl = (T + 2) % NSLOT; if (kt < 2) MOBA_DMA(jcur, kt + 2, sl); else MOBA_DMA(jnext, kt - 2, sl); }
        if (kt == 0) {
            active = n_active; near = n_near; dq = n_dq; kt_max = n_ktmax;
            if (hi == 0) prow_s[r32] = n_prow;
#pragma unroll
            for (int d0 = 0; d0 < 4; ++d0) qf[d0] = *(const LAS bf16x8*)(qst + r32 * 128 + (2 * d0 + hi) * 16);
            bfar = near ? 0.f : tb[TXMAX - 1023]; mhat = 0.f; l = 0.f; c0 = bfar; first = true; o[0] = f32x16{}; o[1] = f32x16{};
        }
        if (kt == 3) jcur = jnext;
        if (kt == 1) stored_prev = false;
        if (active && kt <= kt_max) {
            const LAS unsigned char* buf = lds + L_RING + (T % NSLOT) * SLOTB;
            bf16x8 ka[4], kb[4];
#pragma unroll
            for (int d0 = 0; d0 < 4; ++d0) { const int co = ((2 * d0 + hi) ^ ksw) * 16; ka[d0] = *(const LAS bf16x8*)(buf + koff + co); kb[d0] = *(const LAS bf16x8*)(buf + 4096 + koff + co); }
            f32x16 p0, p1;
#pragma unroll
            for (int r = 0; r < 16; ++r) { p0[r] = c0; p1[r] = c0; }
            __builtin_amdgcn_s_setprio(1);
#pragma unroll
            for (int d0 = 0; d0 < 4; ++d0) { p0 = __builtin_amdgcn_mfma_f32_32x32x16_bf16(ka[d0], qf[d0], p0, 0, 0, 0); p1 = __builtin_amdgcn_mfma_f32_32x32x16_bf16(kb[d0], qf[d0], p1, 0, 0, 0); }
            __builtin_amdgcn_s_setprio(0);
            s16x4 va[8], vc[8];
#pragma unroll
            for (int n = 0; n < 4; ++n) { const LAS unsigned char* vb = buf + 8192 + n * 1024 + voff; va[n] = vtr(vb); vc[n] = vtr(vb + 512); }
            __builtin_amdgcn_sched_barrier(0);
            if (near) {
                int D0 = dq - 64 * kt - 4 * hi; D0 = D0 > 1279 ? 1279 : D0;
                const int x0 = TXMAX - D0, sft = x0 & 1;
                const LAS float* tp = tb + sft * TLEN + (x0 - sft);
#pragma unroll
                for (int g4 = 0; g4 < 4; ++g4) {
                    const f32x2 a0 = *(const LAS f32x2*)(tp + 8 * g4), a1 = *(const LAS f32x2*)(tp + 8 * g4 + 2), b0 = *(const LAS f32x2*)(tp + 32 + 8 * g4), b1 = *(const LAS f32x2*)(tp + 32 + 8 * g4 + 2);
                    p0[4 * g4] += a0.x; p0[4 * g4 + 1] += a0.y; p0[4 * g4 + 2] += a1.x; p0[4 * g4 + 3] += a1.y;
                    p1[4 * g4] += b0.x; p1[4 * g4 + 1] += b0.y; p1[4 * g4 + 2] += b1.x; p1[4 * g4 + 3] += b1.y; }
            }
            float rm;
            { float ma = __builtin_fmaxf(p0[0], p1[0]), mb = __builtin_fmaxf(p0[1], p1[1]);
#pragma unroll
              for (int r = 2; r < 16; r += 2) { asm("v_max3_f32 %0, %1, %2, %3" : "=v"(ma) : "v"(ma), "v"(p0[r]), "v"(p1[r])); asm("v_max3_f32 %0, %1, %2, %3" : "=v"(mb) : "v"(mb), "v"(p0[r + 1]), "v"(p1[r + 1])); }
              rm = __builtin_fmaxf(ma, mb); }
            rm = fmaxf(rm, __shfl_xor(rm, 32));
            if (first || __any(rm > 8.0f)) {
                const float dl = first ? rm : fmaxf(rm, 0.f);
                mhat += dl;
#pragma unroll
                for (int r = 0; r < 16; ++r) { p0[r] -= dl; p1[r] -= dl; }
                const float f = __builtin_amdgcn_exp2f(-dl); l *= f;
                if (!first) {
                    if (hi == 0) wsf[r32] = f;
#pragma unroll
                    for (int r = 0; r < 16; ++r) { const float fr = wsf[crow(r, hi)]; o[0][r] *= fr; o[1][r] *= fr; }
                }
                c0 = bfar - mhat; first = false;
            }
            float sacc = 0.f;
#pragma unroll
            for (int r = 0; r < 16; ++r) { p0[r] = __builtin_amdgcn_exp2f(p0[r]); p1[r] = __builtin_amdgcn_exp2f(p1[r]); sacc += p0[r] + p1[r]; }
            l += sacc;
            v4u pw[4];
            pw[0].x = cvtpk(p0[0], p0[1]); pw[0].y = cvtpk(p0[2], p0[3]); pw[0].z = cvtpk(p0[4], p0[5]); pw[0].w = cvtpk(p0[6], p0[7]);
            pw[1].x = cvtpk(p0[8], p0[9]); pw[1].y = cvtpk(p0[10], p0[11]); pw[1].z = cvtpk(p0[12], p0[13]); pw[1].w = cvtpk(p0[14], p0[15]);
            pw[2].x = cvtpk(p1[0], p1[1]); pw[2].y = cvtpk(p1[2], p1[3]); pw[2].z = cvtpk(p1[4], p1[5]); pw[2].w = cvtpk(p1[6], p1[7]);
            pw[3].x = cvtpk(p1[8], p1[9]); pw[3].y = cvtpk(p1[10], p1[11]); pw[3].z = cvtpk(p1[12], p1[13]); pw[3].w = cvtpk(p1[14], p1[15]);
#pragma unroll
            for (int n = 4; n < 8; ++n) { const LAS unsigned char* vb = buf + 8192 + n * 1024 + voff; va[n] = vtr(vb); vc[n] = vtr(vb + 512); }
            __builtin_amdgcn_s_setprio(1);
#pragma unroll
            for (int d0 = 0; d0 < 2; ++d0)
#pragma unroll
                for (int s = 0; s < 4; ++s) { const int n = d0 * 4 + s;
                    const bf16x8 vf = (bf16x8){va[n][0], va[n][1], va[n][2], va[n][3], vc[n][0], vc[n][1], vc[n][2], vc[n][3]};
                    o[d0] = __builtin_amdgcn_mfma_f32_32x32x16_bf16(__builtin_bit_cast(bf16x8, pw[s]), vf, o[d0], 0, 0, 0); }
            __builtin_amdgcn_s_setprio(0);
        }
        if (kt == 3 && active) {
            l += __shfl_xor(l, 32);
            LAS unsigned* so = (LAS unsigned*)ost;
#pragma unroll
            for (int r = 0; r < 16; ++r) so[crow(r, hi) * 32 + r32] = cvtpk(o[0][r], o[1][r]);
#pragma unroll
            for (int it = 0; it < 4; ++it) { const int row = it * 8 + (lane >> 3), ch = lane & 7;
                const v4u v = *(const LAS v4u*)(ost + row * 128 + ch * 16);
                const int pr = prow_s[row];
                bf16* dst = pr >= 0 ? PO + (size_t)pr * 64 + ch * 8 : trash + row * 64 + ch * 8;
                *(GAS v4u*)dst = v; }
            { const int pr = prow_s[r32]; float* pl = (hi == 0 && pr >= 0) ? PL + (size_t)pr * 2 : (float*)trash + lane * 2; *(GAS f32x2*)pl = (f32x2){mhat, l}; }
            stored_prev = true;
        }
    }
#undef MOBA_DMA
#undef MOBA_GLDS
#undef MOBA_GLDS_NT
#undef MOBA_PREP
    VM_WAIT(); LDS_WAIT(); __syncthreads();
#pragma unroll 1
    for (int id0 = tid; id0 < nq * 8; id0 += 2048) {
        f32x4 La[4], Lb[4]; v4u pv[4][4]; size_t tokv[4]; int nselv[4];
#pragma unroll
        for (int u = 0; u < 4; ++u) { const int id = id0 + 512 * u, qu = id >> 3; const int i = lo + (qu >> 8); nselv[u] = i < 3 ? i : 3;
            tokv[u] = tokb + (size_t)lo * MBLK + qu; const size_t pr = (tokv[u] * NH + h) * 4;
            La[u] = __builtin_nontemporal_load((const f32x4*)(PL + pr * 2)); Lb[u] = __builtin_nontemporal_load((const f32x4*)(PL + pr * 2 + 4));
#pragma unroll
            for (int s = 0; s < 4; ++s) pv[u][s] = __builtin_nontemporal_load((const v4u*)(PO + (pr + s) * 64 + (id & 7) * 8)); }
#pragma unroll
        for (int u = 0; u < 4; ++u) { const int id = id0 + 512 * u, ch = id & 7; const int nsel = nselv[u];
            const float Ms[4] = {La[u].x, La[u].z, Lb[u].x, Lb[u].z}, Ls[4] = {La[u].y, La[u].w, Lb[u].y, Lb[u].w}; float Mm = Ms[3];
#pragma unroll
            for (int s = 0; s < 3; ++s) if (s < nsel) Mm = fmaxf(Mm, Ms[s]);
            float acc[8]; float W = 0.f;
#pragma unroll
            for (int e = 0; e < 8; ++e) acc[e] = 0.f;
#pragma unroll
            for (int s = 0; s < 4; ++s) { if (s == 3 || s < nsel) { const float wgt = __builtin_amdgcn_exp2f(Ms[s] - Mm); W += wgt * Ls[s]; const v4u v = pv[u][s];
                acc[0] += wgt * bflo(v.x); acc[1] += wgt * bflo(v.y); acc[2] += wgt * bflo(v.z); acc[3] += wgt * bflo(v.w);
                acc[4] += wgt * bfhi(v.x); acc[5] += wgt * bfhi(v.y); acc[6] += wgt * bfhi(v.z); acc[7] += wgt * bfhi(v.w); } }
            const float rw = 1.0f / W; v2u oa, ob;
            oa.x = pk2(acc[0] * rw, acc[1] * rw); oa.y = pk2(acc[2] * rw, acc[3] * rw); ob.x = pk2(acc[4] * rw, acc[5] * rw); ob.y = pk2(acc[6] * rw, acc[7] * rw);
            bf16* orow = F.U + tokv[u] * (CW + AW) + CW + h * 64 + ch * 4;
            *(GAS v2u*)orow = oa; *(GAS v2u*)(orow + 32) = ob; }
    }
    __syncthreads();
}
__device__ __forceinline__ void phase(Frame& F) {
    const int nun = (BATCH * NH * 4 - (int)blockIdx.x + F.G - 1) / F.G;
#pragma unroll 1
    for (int n = 0; n < nun; ++n) {
        const int id = blockIdx.x + n * F.G; const int x = id & 7, k = (id >> 3) & 31; const int bh = 8 * x + (k >> 2), g = k & 3;
        const int lo = g == 0 ? 0 : (g == 1 ? 10 : (g == 2 ? 18 : 24)), hb = g == 0 ? 10 : (g == 1 ? 18 : (g == 2 ? 24 : 32));
        unit(F, bh >> 3, bh & 7, lo, hb);
    }
}
}

struct Args { const float* in[13]; float* out; unsigned char* ws; int ph_lo, ph_hi; };
__global__ void __launch_bounds__(NWAVES * 64, 2) fwd_kernel(Args args) {
    extern __shared__ __attribute__((aligned(16))) unsigned char lds[];
    Frame F;
    F.lds = (LAS unsigned char*)lds;
    F.tid = threadIdx.x; F.lane = F.tid & 63; F.wave = __builtin_amdgcn_readfirstlane(F.tid >> 6);
    F.G = gridDim.x; { const int bx = blockIdx.x; F.vcu = (F.G % 8 == 0) ? (bx % 8) * (F.G / 8) + bx / 8 : bx; }
    unsigned char* ws = args.ws;
    F.x = args.in[0]; F.g_pre1 = args.in[1]; F.w_in = args.in[2]; F.conv_w = args.in[3]; F.w_cout = args.in[4]; F.w_aout = args.in[5]; F.rel_bias = args.in[6];
    F.w_o = args.in[7]; F.g_post1 = args.in[8]; F.g_pre2 = args.in[9]; F.w1 = args.in[10]; F.w2 = args.in[11]; F.g_post2 = args.in[12]; F.out = args.out;
    F.Win_t = (bf16*)(ws + WS_WIN); F.Wc_t = (bf16*)(ws + WS_WC); F.Wa_t = (bf16*)(ws + WS_WA); F.Wo_t = (bf16*)(ws + WS_WO); F.W1_t = (bf16*)(ws + WS_W1); F.W2_t = (bf16*)(ws + WS_W2);
    F.XN = (bf16*)(ws + WS_XN); F.PROJ = (bf16*)(ws + WS_PROJ); F.U = (bf16*)(ws + WS_U); F.O = (bf16*)(ws + WS_O); F.M1 = (bf16*)args.out; F.MIX = (bf16*)(ws + WS_PROJ);
    F.HB = (bf16*)(ws + WS_H); F.FB = (bf16*)(ws + WS_PROJ); F.T5 = (float*)(ws + WS_T5); F.KM = (float*)(ws + WS_KM); F.part = ws + WS_PART; F.X1B = (bf16*)(ws + WS_U); F.convctr = (unsigned*)(ws + WS_CTL) + 1024; F.RS2 = (float*)(ws + WS_PART + 40 * MiB); F.RS1 = (float*)(ws + WS_PART + 41 * MiB); F.GT = (bf16*)(ws + WS_PROJ + 384 * MiB);
    const int lo = args.ph_lo, hi = args.ph_hi;
    { volatile LAS unsigned* st = (volatile LAS unsigned*)(F.lds + LDS_BARST); if (F.tid == 0) { st[0] = 0u; st[1] = 0u; } }
    __syncthreads();
    XcdBarrier bar = xcd_barrier_post((unsigned*)(ws + WS_CTL) + CW_BAR, (volatile LAS unsigned*)(F.lds + LDS_BARST));
    unsigned* gmask = (unsigned*)(ws + WS_CTL) + 2048;
    if (F.tid == 0) (void)__hip_atomic_fetch_or(gmask + 64 * (blockIdx.x & 7), 1u << bar.x, __ATOMIC_RELAXED, __HIP_MEMORY_SCOPE_AGENT);
    bool local = false;
#ifndef PH_MASK
#define PH_MASK 0x3ff
#endif
#define IN(k) ((((PH_MASK) >> (k)) & 1) && lo <= (k) && (k) < hi)
#define GRID_BAR(k) do { if (IN(k) && (IN((k) + 1) || ((k) == 1 && IN(3)))) { xcd_barrier(bar); } } while (0)
#define LOCAL_BAR(k) do { if (IN(k) && (IN((k) + 1) || ((k) == 1 && IN(3)))) { if (local) xcd_barrier_local(bar); else xcd_barrier(bar); } } while (0)
#ifndef REP_MASK
#define REP_MASK 0
#endif
#define RUNPH(k, ...) do { if (IN(k)) { __VA_ARGS__; if ((REP_MASK >> (k)) & 1) { xcd_barrier(bar); __VA_ARGS__; } } } while (0)
    RUNPH(0, p0_prologue(F)); GRID_BAR(0);
    if (lo == 0 && hi >= 10) {
        volatile LAS unsigned* st = (volatile LAS unsigned*)(F.lds + LDS_BARST);
        if (F.tid == 0) { unsigned ok = (gridDim.x == 256u) ? 1u : 0u, un = 0u;
#pragma unroll
            for (int k = 0; k < 8; ++k) { const unsigned m = xb_ld(gmask + 64 * k); ok &= (m != 0u && (m & (m - 1u)) == 0u) ? 1u : 0u; un |= m; }
            ok &= (__builtin_popcount(un) == 8) ? 1u : 0u; ok &= (st[0] == 32u) ? 1u : 0u;
            st[2] = ok; }
        __syncthreads();
        local = __builtin_amdgcn_readfirstlane((int)st[2]) != 0;
    }
    RUNPH(1, { pg8::Gemm g{F.XN, F.Win_t, M, NIN, DM}; pg8::StaticOrder S; S.init(M, NIN, F.G, (int)blockIdx.x);
        pg8::EpiB<pg8::EM_PROJ> E{F.PROJ, PPITCH, (const pg8::bf16_t*)F.GT, 0, 0, 0, F.KM, F.RS1};
        pg8::gemm_phase<pg8::EpiB<pg8::EM_PROJ>, pg8::StaticOrder, false, true>(F.lds, g, S, E); }); LOCAL_BAR(1);
    RUNPH(3, { moba2::phase(F); conv_tail(F); }); GRID_BAR(3);
    RUNPH(4, { pg8::Gemm g{F.U, F.Wc_t, M, DM, CW + AW}; pg8::StaticOrder S; S.init(M, DM, F.G, (int)blockIdx.x);
        pg8::EpiB<pg8::EM_GATE2> E{F.M1, DM, (const pg8::bf16_t*)F.GT, 0, 0, 0};
        pg8::gemm_phase<pg8::EpiB<pg8::EM_GATE2>, pg8::StaticOrder, true, true>(F.lds, g, S, E); }); LOCAL_BAR(4);
    RUNPH(5, { pg8::Gemm g{F.M1, F.Wo_t, M, DM, DM}; pg8::StaticOrder S; S.init(M, DM, F.G, (int)blockIdx.x);
        pg8::EpiB<pg8::EM_PLAIN> E{F.MIX, DM, nullptr, 0, 0};
        pg8::gemm_phase<pg8::EpiB<pg8::EM_PLAIN>, pg8::StaticOrder, true, true>(F.lds, g, S, E); }); GRID_BAR(5);
    RUNPH(6, p6_norms(F)); LOCAL_BAR(6);
    RUNPH(7, { pg8::Gemm g{F.X1B, F.W1_t, M, FF, DM}; pg8::StaticOrder S; S.init(M, FF, F.G, (int)blockIdx.x);
        pg8::EpiB<pg8::EM_RELU2> E{F.HB, FF, nullptr, 0, 0, 0, nullptr, F.RS2, FF / 256};
        pg8::gemm_phase<pg8::EpiB<pg8::EM_RELU2>, pg8::StaticOrder, false, true>(F.lds, g, S, E); }); LOCAL_BAR(7);
    RUNPH(8, { pg8::Gemm g{F.HB, F.W2_t, M, DM, FF}; pg8::StaticOrder S; S.init(M, DM, F.G, (int)blockIdx.x);
        pg8::EpiB<pg8::EM_PLAIN> E{F.FB, DM, nullptr, 0, 0};
        pg8::gemm_phase<pg8::EpiB<pg8::EM_PLAIN>, pg8::StaticOrder, true, true, true>(F.lds, g, S, E); }); LOCAL_BAR(8);
    if (IN(9)) { p9_final(F); }
#undef IN
#undef GRID_BAR
#undef LOCAL_BAR
}

#ifndef MK_N_LAUNCHES
#define MK_N_LAUNCHES 1
#endif
extern "C" void kernel_launch(void* const* d_in, const int* in_sizes, int n_in, void* d_out, int out_size, void* d_ws, size_t ws_size, hipStream_t stream) {
    static int grid = 0;
    if (grid == 0) {
        if (n_in != 13 || in_sizes[0] != M * DM || out_size != M * DM || ws_size < WS_END) { fprintf(stderr, "kernel_launch: unexpected shapes (n_in %d, in0 %d, out %d, ws %zu)\n", n_in, n_in > 0 ? in_sizes[0] : -1, out_size, ws_size); grid = -1; return; }
        int dev = 0, cus = 0, per_cu = 0;
        if (hipGetDevice(&dev) != hipSuccess || hipDeviceGetAttribute(&cus, hipDeviceAttributeMultiprocessorCount, dev) != hipSuccess) { grid = -1; return; }
        if (hipFuncSetAttribute((const void*)fwd_kernel, hipFuncAttributeMaxDynamicSharedMemorySize, LDS_BYTES) != hipSuccess) { fprintf(stderr, "kernel_launch: hipFuncSetAttribute failed\n"); grid = -1; return; }
        if (hipOccupancyMaxActiveBlocksPerMultiprocessor(&per_cu, (const void*)fwd_kernel, NWAVES * 64, LDS_BYTES) != hipSuccess || per_cu < 1) { fprintf(stderr, "kernel_launch: occupancy query says %d blocks per CU\n", per_cu); (void)hipGetLastError(); per_cu = 1; }
        if (per_cu > 1) per_cu = 1;
        grid = cus * per_cu;
    }
    if (grid < 0) return;
    if (hipMemsetAsync((char*)d_ws + WS_CTL, 0, CTL_ZERO_BYTES, stream) != hipSuccess) { fprintf(stderr, "kernel_launch: hipMemsetAsync failed\n"); return; }
    Args a{};
    for (int i = 0; i < 13; ++i) a.in[i] = (const float*)d_in[i];
    a.out = (float*)d_out; a.ws = (unsigned char*)d_ws;
#if MK_N_LAUNCHES == 1
    a.ph_lo = 0; a.ph_hi = N_PHASES;
    void* kargs[] = {&a};
    hipError_t e = hipLaunchCooperativeKernel((const void*)fwd_kernel, dim3(grid), dim3(NWAVES * 64), kargs, LDS_BYTES, stream);
    if (e != hipSuccess) fprintf(stderr, "kernel_launch: cooperative launch failed: %s (grid %d)\n", hipGetErrorString(e), grid);
#else
    for (int p = 0; p < N_PHASES; ++p) { a.ph_lo = p; a.ph_hi = p + 1;
        void* kargs[] = {&a};
        hipError_t e = hipLaunchCooperativeKernel((const void*)fwd_kernel, dim3(grid), dim3(NWAVES * 64), kargs, LDS_BYTES, stream);
        if (e != hipSuccess) { fprintf(stderr, "kernel_launch: launch %d failed: %s\n", p, hipGetErrorString(e)); break; } }
#endif
}
```
